# Optimizing an MI355X kernel written in HIP

```python
import math
import jax, jax.numpy as jnp
from jax import lax
import numpy as np

D_MODEL = 1024
BATCH = 16
SEQ = 2048
DEPTH = 2
DEC_BATCH = 16
DEC_SEQ = 4096
PAST_LEN = 128

DN_ALPHA = (2 * DEPTH) ** 0.25
DN_BETA = (8 * DEPTH) ** -0.25
LN_EPS = 1e-5
RMS_EPS = 1e-6

MLA_HEADS = 8
MLA_Q_RANK = 768
MLA_KV_RANK = 256
MLA_NOPE = 64
MLA_ROPE = 32
MLA_V = 64
ROPE_BASE = 10000.0
Q_BLOCK = 128

GLA_HEADS = 4
GLA_DK = 64
GLA_DV = 128
GLA_GATE_RANK = 16
GLA_TAU = 16.0
GLA_CHUNK = 64

AB_WIDTHS = (MLA_Q_RANK, MLA_KV_RANK, MLA_ROPE,
             GLA_HEADS * GLA_DK, GLA_HEADS * GLA_DK, GLA_HEADS * GLA_DV, GLA_HEADS * GLA_DV,
             GLA_GATE_RANK, GLA_GATE_RANK)
AB_IN = sum(AB_WIDTHS)
AB_OUT = MLA_HEADS * MLA_V + GLA_HEADS * GLA_DV

SGU_CHUNK = 128
SGU_HIDDEN = 6 * D_MODEL
SGU_HALF = SGU_HIDDEN // 2
SGU_GROUPS = 8
SGU_GROUP_DIM = SGU_HALF // SGU_GROUPS

FFN_HIDDEN = 2816

kernel_name = 'hybrid_mla_gla_sgu_macaron_deepnorm_encoder'


def layer_norm(x, g, b):
    xf = x.astype(jnp.float32)
    mu = jnp.mean(xf, axis=-1, keepdims=True)
    var = jnp.mean(jnp.square(xf - mu), axis=-1, keepdims=True)
    return ((xf - mu) * lax.rsqrt(var + LN_EPS) * g.astype(jnp.float32) + b.astype(jnp.float32)).astype(x.dtype)


def rms_norm(x, g):
    xf = x.astype(jnp.float32)
    ms = jnp.mean(jnp.square(xf), axis=-1, keepdims=True)
    return (xf * lax.rsqrt(ms + RMS_EPS) * g.astype(jnp.float32)).astype(x.dtype)


def split_cols(t, widths):
    out, start = [], 0
    for w in widths:
        out.append(t[..., start:start + w])
        start += w
    return out


def swiglu(h, w_gu, w_down):
    gate, up = jnp.split(h @ w_gu, 2, axis=-1)
    return (jax.nn.silu(gate) * up) @ w_down


def rope_tables(seq, dtype):
    inv_freq = 1.0 / (ROPE_BASE ** (jnp.arange(0, MLA_ROPE, 2, dtype=jnp.float32) / MLA_ROPE))
    ang = jnp.arange(seq, dtype=jnp.float32)[:, None] * inv_freq[None, :]
    return jnp.cos(ang).astype(dtype), jnp.sin(ang).astype(dtype)


def apply_rope(x, cos, sin):
    x1, x2 = jnp.split(x, 2, axis=-1)
    return jnp.concatenate([x1 * cos - x2 * sin, x1 * sin + x2 * cos], axis=-1)


def mla_attention(c_q, c_kv, k_r, q_norm, w_uq, kv_norm, w_ukv):
    B, S, _ = c_q.shape
    H = MLA_HEADS
    q = (rms_norm(c_q, q_norm) @ w_uq).reshape(B, S, H, MLA_NOPE + MLA_ROPE)
    kv = (rms_norm(c_kv, kv_norm) @ w_ukv).reshape(B, S, H, MLA_NOPE + MLA_V)
    q_nope, q_rope = q[..., :MLA_NOPE], q[..., MLA_NOPE:]
    k_nope, v = kv[..., :MLA_NOPE], kv[..., MLA_NOPE:]
    cos, sin = rope_tables(S, q.dtype)
    q_rope = apply_rope(q_rope, cos[:, None, :], sin[:, None, :])
    k_rope = apply_rope(k_r, cos, sin)
    scale = (MLA_NOPE + MLA_ROPE) ** -0.5
    nb = S // Q_BLOCK
    qn_b = jnp.moveaxis(q_nope.reshape(B, nb, Q_BLOCK, H, MLA_NOPE), 1, 0)
    qr_b = jnp.moveaxis(q_rope.reshape(B, nb, Q_BLOCK, H, MLA_ROPE), 1, 0)

    def block(args):
        qn, qr = args
        s = (jnp.einsum('bqhd,bkhd->bhqk', qn, k_nope)
             + jnp.einsum('bqhr,bkr->bhqk', qr, k_rope))
        p = jax.nn.softmax(s.astype(jnp.float32) * scale, axis=-1).astype(v.dtype)
        return jnp.einsum('bhqk,bkhd->bqhd', p, v)

    o = lax.map(block, (qn_b, qr_b))
    return jnp.moveaxis(o, 0, 1).reshape(B, S, H * MLA_V)


def gla_chunked(q, k, v, log_a, strict):
    B, S, H, DK = q.shape
    DV = v.shape[-1]
    C = GLA_CHUNK
    n = S // C
    q, k, log_a = (t.reshape(B, n, C, H, DK) for t in (q, k, log_a))
    v = v.reshape(B, n, C, H, DV)
    b = lax.cumsum(log_a, axis=2)
    b_last = b[:, :, -1:]
    q_in = q * jnp.exp(b)
    k_in = k * jnp.exp(-b)
    k_st = k * jnp.exp(b_last - b)
    mask = jnp.tril(jnp.ones((C, C), dtype=bool), k=-1 if strict else 0)
    att = jnp.where(mask, jnp.einsum('bnthd,bnshd->bnhts', q_in, k_in), 0.0)
    o_intra = jnp.einsum('bnhts,bnshe->bnthe', att, v)
    d_state = jnp.einsum('bnshd,bnshe->bnhde', k_st, v)
    decay = jnp.exp(b_last[:, :, 0])

    def step(state, inp):
        ds, dec = inp
        return dec[..., None] * state + ds, state

    s0 = jnp.zeros((B, H, DK, DV), dtype=q.dtype)
    _, s_before = lax.scan(step, s0, (jnp.moveaxis(d_state, 1, 0), jnp.moveaxis(decay, 1, 0)))
    s_before = jnp.moveaxis(s_before, 0, 1)
    o_inter = jnp.einsum('bnthd,bnhde->bnthe', q_in, s_before)
    return (o_intra + o_inter).reshape(B, S, H, DV)


def gla_bidirectional(q, k, v, r, z_f, z_b, w_gate_f, b_gate_f, w_gate_b, b_gate_b, norm_g):
    B, S, _ = q.shape
    H = GLA_HEADS
    f32 = jnp.float32
    qf = q.astype(f32).reshape(B, S, H, GLA_DK) * (GLA_DK ** -0.5)
    kf = k.astype(f32).reshape(B, S, H, GLA_DK)
    vf = v.astype(f32).reshape(B, S, H, GLA_DV)
    la_f = (jax.nn.log_sigmoid((z_f @ w_gate_f + b_gate_f).astype(f32)) / GLA_TAU).reshape(B, S, H, GLA_DK)
    la_b = (jax.nn.log_sigmoid((z_b @ w_gate_b + b_gate_b).astype(f32)) / GLA_TAU).reshape(B, S, H, GLA_DK)
    flip = lambda t: jnp.flip(t, axis=1)
    o_fwd = gla_chunked(qf, kf, vf, la_f, strict=False)
    o_bwd = flip(gla_chunked(flip(qf), flip(kf), flip(vf), flip(la_b), strict=True))
    o = rms_norm(o_fwd + o_bwd, norm_g)
    return o.reshape(B, S, H * GLA_DV).astype(r.dtype) * jax.nn.silu(r)


def mixer_ab(h, w_in, mla_q_norm, mla_w_uq, mla_kv_norm, mla_w_ukv,
             gla_w_gate_f, gla_b_gate_f, gla_w_gate_b, gla_b_gate_b, gla_norm, w_out):
    c_q, c_kv, k_r, q, k, v, r, z_f, z_b = split_cols(h @ w_in, AB_WIDTHS)
    o_a = mla_attention(c_q, c_kv, k_r, mla_q_norm, mla_w_uq, mla_kv_norm, mla_w_ukv)
    o_b = gla_bidirectional(q, k, v, r, z_f, z_b, gla_w_gate_f, gla_b_gate_f,
                            gla_w_gate_b, gla_b_gate_b, gla_norm)
    return jnp.concatenate([o_a, o_b], axis=-1) @ w_out


def mixer_c(h, w_in, ln_g, ln_b, w_s, b_s, w_out):
    B, S, _ = h.shape
    n = S // SGU_CHUNK
    u, v = jnp.split(jax.nn.gelu(h @ w_in, approximate=False), 2, axis=-1)
    v = layer_norm(v, ln_g, ln_b).reshape(B, n, SGU_CHUNK, SGU_GROUPS, SGU_GROUP_DIM)
    v = jnp.einsum('gts,bnsgc->bntgc', w_s, v) + jnp.transpose(b_s)[None, None, :, :, None]
    return (u * v.reshape(B, S, SGU_HALF)) @ w_out


def post_norm(x, f, g, b):
    return layer_norm(DN_ALPHA * x + f, g, b)


def layer_even(x, ffa_gu, ffa_down, ln1_g, ln1_b, w_in, mla_q_norm, mla_w_uq, mla_kv_norm,
               mla_w_ukv, gla_w_gate_f, gla_b_gate_f, gla_w_gate_b, gla_b_gate_b, gla_norm, w_out,
               ln2_g, ln2_b, ffb_gu, ffb_down, ln3_g, ln3_b):
    x = post_norm(x, 0.5 * swiglu(x, ffa_gu, ffa_down), ln1_g, ln1_b)
    x = post_norm(x, mixer_ab(x, w_in, mla_q_norm, mla_w_uq, mla_kv_norm, mla_w_ukv,
                              gla_w_gate_f, gla_b_gate_f, gla_w_gate_b, gla_b_gate_b,
                              gla_norm, w_out), ln2_g, ln2_b)
    return post_norm(x, 0.5 * swiglu(x, ffb_gu, ffb_down), ln3_g, ln3_b)


def layer_odd(x, ffa_gu, ffa_down, ln1_g, ln1_b, sgu_w_in, sgu_ln_g, sgu_ln_b, sgu_w_s, sgu_b_s,
              sgu_w_out, ln2_g, ln2_b, ffb_gu, ffb_down, ln3_g, ln3_b):
    x = post_norm(x, 0.5 * swiglu(x, ffa_gu, ffa_down), ln1_g, ln1_b)
    x = post_norm(x, mixer_c(x, sgu_w_in, sgu_ln_g, sgu_ln_b, sgu_w_s, sgu_b_s, sgu_w_out), ln2_g, ln2_b)
    return post_norm(x, 0.5 * swiglu(x, ffb_gu, ffb_down), ln3_g, ln3_b)


def _dense(key, fan_in, fan_out, scale=1.0):
    return jax.random.normal(key, (fan_in, fan_out), jnp.float32) * (scale * fan_in ** -0.5)


def _gain(key, shape):
    return 1.0 + 0.02 * jax.random.normal(key, shape, jnp.float32)


def _bias(key, shape, scale=0.02):
    return scale * jax.random.normal(key, shape, jnp.float32)


def setup_inputs(seed: int = 0) -> dict:
    key = jax.random.key(seed)
    ks = iter(jax.random.split(key, 64))
    d = D_MODEL
    inp = {}
    inp['x_prompt'] = jax.random.normal(next(ks), (BATCH, SEQ, d), jnp.float32)
    inp['x_sample'] = jax.random.normal(next(ks), (DEC_BATCH, DEC_SEQ, d), jnp.float32)
    inp['l0_ffa_w_gu'] = _dense(next(ks), d, 2 * FFN_HIDDEN)
    inp['l0_ffa_w_down'] = _dense(next(ks), FFN_HIDDEN, d, DN_BETA)
    inp['l0_ln1_g'] = _gain(next(ks), (d,))
    inp['l0_ln1_b'] = _bias(next(ks), (d,))
    inp['l0_w_in'] = _dense(next(ks), d, AB_IN)
    inp['l0_mla_q_norm'] = _gain(next(ks), (MLA_Q_RANK,))
    inp['l0_mla_w_uq'] = _dense(next(ks), MLA_Q_RANK, MLA_HEADS * (MLA_NOPE + MLA_ROPE))
    inp['l0_mla_kv_norm'] = _gain(next(ks), (MLA_KV_RANK,))
    inp['l0_mla_w_ukv'] = _dense(next(ks), MLA_KV_RANK, MLA_HEADS * (MLA_NOPE + MLA_V))
    inp['l0_gla_w_gate_f'] = _dense(next(ks), GLA_GATE_RANK, GLA_HEADS * GLA_DK)
    inp['l0_gla_b_gate_f'] = _bias(next(ks), (GLA_HEADS * GLA_DK,), 0.1)
    inp['l0_gla_w_gate_b'] = _dense(next(ks), GLA_GATE_RANK, GLA_HEADS * GLA_DK)
    inp['l0_gla_b_gate_b'] = _bias(next(ks), (GLA_HEADS * GLA_DK,), 0.1)
    inp['l0_gla_norm'] = _gain(next(ks), (GLA_DV,))
    inp['l0_w_out'] = _dense(next(ks), AB_OUT, d, DN_BETA)
    inp['l0_ln2_g'] = _gain(next(ks), (d,))
    inp['l0_ln2_b'] = _bias(next(ks), (d,))
    inp['l0_ffb_w_gu'] = _dense(next(ks), d, 2 * FFN_HIDDEN)
    inp['l0_ffb_w_down'] = _dense(next(ks), FFN_HIDDEN, d, DN_BETA)
    inp['l0_ln3_g'] = _gain(next(ks), (d,))
    inp['l0_ln3_b'] = _bias(next(ks), (d,))
    inp['l1_ffa_w_gu'] = _dense(next(ks), d, 2 * FFN_HIDDEN)
    inp['l1_ffa_w_down'] = _dense(next(ks), FFN_HIDDEN, d, DN_BETA)
    inp['l1_ln1_g'] = _gain(next(ks), (d,))
    inp['l1_ln1_b'] = _bias(next(ks), (d,))
    inp['l1_sgu_w_in'] = _dense(next(ks), d, SGU_HIDDEN)
    inp['l1_sgu_ln_g'] = _gain(next(ks), (SGU_HALF,))
    inp['l1_sgu_ln_b'] = _bias(next(ks), (SGU_HALF,))
    inp['l1_sgu_w_s'] = jax.random.normal(next(ks), (SGU_GROUPS, SGU_CHUNK, SGU_CHUNK), jnp.float32) * (SGU_CHUNK ** -0.5)
    inp['l1_sgu_b_s'] = _gain(next(ks), (SGU_GROUPS, SGU_CHUNK))
    inp['l1_sgu_w_out'] = _dense(next(ks), SGU_HALF, d, DN_BETA)
    inp['l1_ln2_g'] = _gain(next(ks), (d,))
    inp['l1_ln2_b'] = _bias(next(ks), (d,))
    inp['l1_ffb_w_gu'] = _dense(next(ks), d, 2 * FFN_HIDDEN)
    inp['l1_ffb_w_down'] = _dense(next(ks), FFN_HIDDEN, d, DN_BETA)
    inp['l1_ln3_g'] = _gain(next(ks), (d,))
    inp['l1_ln3_b'] = _bias(next(ks), (d,))
    return inp


def reference(x_prompt, x_sample,
              l0_ffa_w_gu, l0_ffa_w_down, l0_ln1_g, l0_ln1_b, l0_w_in, l0_mla_q_norm, l0_mla_w_uq,
              l0_mla_kv_norm, l0_mla_w_ukv, l0_gla_w_gate_f, l0_gla_b_gate_f, l0_gla_w_gate_b,
              l0_gla_b_gate_b, l0_gla_norm, l0_w_out, l0_ln2_g, l0_ln2_b, l0_ffb_w_gu, l0_ffb_w_down,
              l0_ln3_g, l0_ln3_b,
              l1_ffa_w_gu, l1_ffa_w_down, l1_ln1_g, l1_ln1_b, l1_sgu_w_in, l1_sgu_ln_g, l1_sgu_ln_b,
              l1_sgu_w_s, l1_sgu_b_s, l1_sgu_w_out, l1_ln2_g, l1_ln2_b, l1_ffb_w_gu, l1_ffb_w_down,
              l1_ln3_g, l1_ln3_b):
    even_params = (l0_ffa_w_gu, l0_ffa_w_down, l0_ln1_g, l0_ln1_b, l0_w_in, l0_mla_q_norm, l0_mla_w_uq,
                   l0_mla_kv_norm, l0_mla_w_ukv, l0_gla_w_gate_f, l0_gla_b_gate_f, l0_gla_w_gate_b,
                   l0_gla_b_gate_b, l0_gla_norm, l0_w_out, l0_ln2_g, l0_ln2_b, l0_ffb_w_gu,
                   l0_ffb_w_down, l0_ln3_g, l0_ln3_b)
    odd_params = (l1_ffa_w_gu, l1_ffa_w_down, l1_ln1_g, l1_ln1_b, l1_sgu_w_in, l1_sgu_ln_g, l1_sgu_ln_b,
                  l1_sgu_w_s, l1_sgu_b_s, l1_sgu_w_out, l1_ln2_g, l1_ln2_b, l1_ffb_w_gu, l1_ffb_w_down,
                  l1_ln3_g, l1_ln3_b)
    layer_params = (even_params, odd_params)

    def trunk(x):
        for i in range(DEPTH):
            if i % 2 == 0:
                x = layer_even(x, *layer_params[i])
            else:
                x = layer_odd(x, *layer_params[i])
        return x

    y_prompt = trunk(x_prompt)
    y_sample = trunk(x_sample)
    return (y_prompt, y_sample)
```

```cpp
#include <hip/hip_runtime.h>
#include <hip/hip_cooperative_groups.h>
#include <cstdio>
namespace cg = cooperative_groups;

#define LAS __attribute__((address_space(3)))
typedef unsigned short bf16_t;
typedef short bf16x8 __attribute__((ext_vector_type(8)));
typedef float f32x4 __attribute__((ext_vector_type(4)));
typedef float f32x2 __attribute__((ext_vector_type(2)));
typedef unsigned u32x4 __attribute__((ext_vector_type(4)));
typedef unsigned u32x2 __attribute__((ext_vector_type(2)));

#ifndef PM
#define PM 0xFFFF
#endif
#ifndef DUP
#define DUP 0
#endif
constexpr int MTOK = 98304, NPROMPT = 32768, DM = 1024, FH = 2816, LDP = 2624, SH = 3072;
constexpr size_t MiB = 1048576;
constexpr size_t WS_FFN = 0;
constexpr size_t WS_WIN = 66 * MiB;
constexpr size_t WS_UQ = WS_WIN + 5767168;
constexpr size_t WS_UKN = WS_UQ + 1179648;
constexpr size_t WS_UV = WS_UKN + 262144;
constexpr size_t WS_WOUT = WS_UV + 262144;
constexpr size_t WS_SIN = WS_WOUT + 2097152;
constexpr size_t WS_SOUT = WS_SIN + 12582912;
constexpr size_t WS_WS = WS_SOUT + 6291456;
constexpr size_t WS_ROPE = WS_WS + 262144;
constexpr size_t WS_SMALL = WS_ROPE + 524288;
constexpr int SM_LN = 0, SM_WGF = 12288, SM_BGF = 16384, SM_WGB = 16640, SM_BGB = 20736, SM_GN = 20992, SM_LNG = 21120, SM_LNB = 24192, SM_BS = 27264;
constexpr size_t WS_XB = 96 * MiB;
constexpr size_t WS_R = 288 * MiB;
constexpr size_t WS_ST = 780 * MiB;
constexpr size_t WS_DEC = 972 * MiB;
constexpr size_t WS_SSQ = 976 * MiB;
constexpr size_t WS_STATS = 864 * MiB;
constexpr size_t WS_BAR = 983 * MiB;
constexpr size_t WS_CNT = WS_BAR + 4096;
constexpr size_t BAR_ZERO_BYTES = 4096 + 6 * 384 * 2 * 64;
constexpr size_t WS_SLOT = 984 * MiB;
constexpr size_t DO_Q = 0, DO_KN = 144 * MiB, DO_VT = 240 * MiB, DO_KR = 336 * MiB;

struct Params { const float* in[39]; float* out; unsigned char* ws; };

__device__ __forceinline__ int ltid() { int t = threadIdx.x; asm volatile("" : "+v"(t)); return t; }
__device__ __forceinline__ int lbid() { int t = blockIdx.x; asm volatile("" : "+s"(t)); return t; }
__device__ __forceinline__ float bflo(unsigned w) { return __uint_as_float(w << 16); }
__device__ __forceinline__ float bfhi(unsigned w) { return __uint_as_float(w & 0xffff0000u); }
typedef __bf16 bf16v2 __attribute__((ext_vector_type(2)));
__device__ __forceinline__ unsigned pk(float lo, float hi) { const f32x2 v = {lo, hi}; const bf16v2 b = __builtin_convertvector(v, bf16v2); return __builtin_bit_cast(unsigned, b); }
__device__ __forceinline__ float fexp2(float x) { return __builtin_amdgcn_exp2f(x); }
__device__ __forceinline__ float frcp(float x) { return __builtin_amdgcn_rcpf(x); }
__device__ __forceinline__ float silu(float x) { return x * frcp(1.0f + fexp2(-1.4426950408889634f * x)); }
__device__ __forceinline__ f32x2 gelu_pk(f32x2 v) {
    const f32x2 av = __builtin_elementwise_abs(v), d = av * 0.2316418882f + 1.0f;
    f32x2 t; t.x = frcp(d.x); t.y = frcp(d.y);
    f32x2 q = t * 0.5307027145f + (-0.7265760135f); q = q * t + 0.7107068705f; q = q * t + (-0.142248368f); q = q * t + 0.127414796f; q = q * t;
    const f32x2 s = (v * v) * (-0.72134752044f);
    f32x2 e; e.x = fexp2(s.x); e.y = fexp2(s.y);
    const f32x2 m = v * (q * e), r = v - m;
    f32x2 o; o.x = v.x < 0.f ? m.x : r.x; o.y = v.y < 0.f ? m.y : r.y; return o;
}
__device__ __forceinline__ f32x4 gelu4(f32x4 v) { f32x2 a = gelu_pk((f32x2){v[0], v[1]}), b = gelu_pk((f32x2){v[2], v[3]}); return (f32x4){a.x, a.y, b.x, b.y}; }
__device__ __forceinline__ int tok_pos(int row) { return row < NPROMPT ? (row & 2047) : (row & 4095); }

namespace pg8 {
constexpr int BM = 256, BK = 64, HALF = 128, HTB = HALF * BK * 2, STAGE_BYTES = 8 * HTB, NXCD = 8, WGM = 8;
__device__ __forceinline__ int lds_byte(int r, int c) { const int st = (r >> 4) * 2 + (c >> 5), rr = r & 15, cc = c & 31, ob = rr * 64 + cc * 2; return st * 1024 + (ob ^ (((ob >> 9) & 1) << 5)); }
__device__ __forceinline__ void stage_rc(int b, int& R, int& C) { const int st = b / 1024, sb = b % 1024, swz = sb ^ (((sb >> 9) & 1) << 5); R = (st >> 1) * 16 + swz / 64; C = (st & 1) * 32 + (swz % 64) / 2; }
__device__ __forceinline__ int perm32(int rho) { const int n = rho >> 4, i = rho & 15; return 8 * (i >> 2) + 4 * n + (i & 3); }
struct Unit { int pm, pn; };
struct Gemm { const bf16_t* A; const bf16_t* Bt; int lda, ldb, M, N, K; };
struct StaticOrder {
    int nM, nN, nwg, G, c;
    __device__ void init(int M, int N, int G_, int c_) { nM = M / BM; nN = N / BM; nwg = nM * nN; G = G_; c = c_; }
    __device__ bool next(int i, Unit& u) const {
        const long L = (long)i * G + c; if (L >= nwg) return false;
        int wgid = (int)L; { const int q = nwg / NXCD, r = nwg % NXCD, xcd = wgid % NXCD, off = wgid / NXCD; wgid = (xcd < r ? xcd * (q + 1) : r * (q + 1) + (xcd - r) * q) + off; }
        const int nig = WGM * nN, gid = wgid / nig, fm = gid * WGM, gsz = (nM - fm) < WGM ? (nM - fm) : WGM;
        u.pm = fm + ((wgid % nig) % gsz); u.pn = (wgid % nig) / gsz; return true;
    }
};
template <class Epi>
__device__ __forceinline__ void gemm_phase(LAS unsigned char* lds, const Gemm g, const StaticOrder& S, const Epi& E) {
    const int tid = ltid(), wid = __builtin_amdgcn_readfirstlane(tid >> 6), lane = tid & 63, wr = wid >> 2, wc = wid & 3, fr = lane & 15, fq = lane >> 4;
    int K = g.K, lda = g.lda, ldb = g.ldb; asm volatile("" : "+s"(K), "+s"(lda), "+s"(ldb));
    const int nt = K / BK;
    unsigned voffA[2], voffB[2];
#pragma unroll
    for (int i = 0; i < 2; ++i) { int R, C; stage_rc(tid * 16 + i * 8192, R, C); const int Rb = Epi::PERM ? ((R & ~31) + perm32(R & 31)) : R;
        voffA[i] = (unsigned)(R * lda + C) * 2u; voffB[i] = (unsigned)(Rb * ldb + C) * 2u; }
    const size_t kstep = (size_t)(BK * 2);
    const size_t hstepA = (size_t)HALF * lda * 2, hstepB = (size_t)HALF * ldb * 2;
    const size_t tstepA = 2 * hstepA, tstepB = 2 * hstepB;
    const unsigned ldsw = (unsigned)wid * 1024u;
    const int aoff = lds_byte(wr * 64 + fr, fq * 8), boff = lds_byte(wc * 32 + fr, fq * 8);
#define PG8_SA(b, h) (((b) * 2 + (h)) * HTB)
#define PG8_SB(b, h) ((4 + (b) * 2 + (h)) * HTB)
#define PG8_STAGE(bufoff, gbase, voff) do { _Pragma("unroll") for (int _i = 0; _i < 2; ++_i) \
        __builtin_amdgcn_global_load_lds((const unsigned*)((const char*)(gbase) + (voff)[_i]), (LAS unsigned*)(lds + (bufoff) + ldsw + _i * 8192), 16, 0, 0); } while (0)
#define PG8_LDA(dst, b, h) do { _Pragma("unroll") for (int m = 0; m < 4; ++m) _Pragma("unroll") for (int k = 0; k < 2; ++k) dst[m][k] = *(const LAS bf16x8*)(lds + PG8_SA(b, h) + aoff + m * 2048 + k * 1024); } while (0)
#define PG8_LDB(dst, b, h) do { _Pragma("unroll") for (int n = 0; n < 2; ++n) _Pragma("unroll") for (int k = 0; k < 2; ++k) dst[n][k] = *(const LAS bf16x8*)(lds + PG8_SB(b, h) + boff + n * 2048 + k * 1024); } while (0)
#define PG8_MMA(ai, bj, At, Bt) do { __builtin_amdgcn_s_setprio(1); _Pragma("unroll") for (int m = 0; m < 4; ++m) _Pragma("unroll") for (int n = 0; n < 2; ++n) _Pragma("unroll") for (int k = 0; k < 2; ++k) \
        acc[ai][bj][m][n] = __builtin_amdgcn_mfma_f32_16x16x32_bf16(Bt[n][k], At[m][k], acc[ai][bj][m][n], 0, 0, 0); __builtin_amdgcn_s_setprio(0); } while (0)
#define PG8_WAIT_V(n) asm volatile("s_waitcnt vmcnt(" #n ")" ::: "memory")
#define PG8_WAIT_L(n) asm volatile("s_waitcnt lgkmcnt(" #n ")" ::: "memory")
#define PG8_BAR __builtin_amdgcn_s_barrier()
#define PG8_SCHED __builtin_amdgcn_sched_barrier(0)
    Unit cur, nxt; int ui = 0;
    if (!S.next(0, cur)) return;
    f32x4 acc[2][2][4][2];
#pragma unroll
    for (int a = 0; a < 2; ++a)
#pragma unroll
        for (int b = 0; b < 2; ++b)
#pragma unroll
            for (int m = 0; m < 4; ++m)
#pragma unroll
                for (int n = 0; n < 2; ++n) acc[a][b][m][n] = (f32x4){0.f, 0.f, 0.f, 0.f};
    bf16x8 At[4][2], B0[2][2], B1[2][2];
    const char* cA = (const char*)g.A + (size_t)cur.pm * tstepA; const char* cB = (const char*)g.Bt + (size_t)cur.pn * tstepB;
    PG8_STAGE(PG8_SB(0, 0), cB, voffB); PG8_STAGE(PG8_SA(0, 0), cA, voffA); PG8_STAGE(PG8_SB(0, 1), cB + hstepB, voffB); PG8_STAGE(PG8_SA(0, 1), cA + hstepA, voffA);
    if (wr == 1) PG8_BAR;
    PG8_WAIT_V(4); PG8_BAR;
    PG8_STAGE(PG8_SB(1, 0), cB + kstep, voffB); PG8_STAGE(PG8_SA(1, 0), cA + kstep, voffA); PG8_STAGE(PG8_SB(1, 1), cB + hstepB + kstep, voffB);
    PG8_WAIT_V(6); PG8_BAR;
    for (;;) {
        const bool has_next = S.next(ui + 1, nxt);
        const char* nA = has_next ? (const char*)g.A + (size_t)nxt.pm * tstepA : cA; const char* nB = has_next ? (const char*)g.Bt + (size_t)nxt.pn * tstepB : cB;
        for (int t = 0; t < nt; t += 2) {
            const bool last = (t == nt - 2);
            const char* a1 = cA + (size_t)(t + 1) * kstep;
            const char* a2 = last ? nA : cA + (size_t)(t + 2) * kstep; const char* b2 = last ? nB : cB + (size_t)(t + 2) * kstep;
            const char* a3 = a2 + kstep; const char* b3 = b2 + kstep;
            PG8_LDB(B0, 0, 0); PG8_SCHED; PG8_LDA(At, 0, 0); PG8_STAGE(PG8_SA(1, 1), a1 + hstepA, voffA);
            PG8_WAIT_L(8); PG8_BAR; PG8_WAIT_L(0); PG8_MMA(0, 0, At, B0); PG8_BAR; PG8_SCHED;
            PG8_LDB(B1, 0, 1); PG8_STAGE(PG8_SB(0, 0), b2, voffB);
            PG8_BAR; PG8_WAIT_L(0); PG8_MMA(0, 1, At, B1); PG8_BAR;
            PG8_LDA(At, 0, 1); PG8_STAGE(PG8_SA(0, 0), a2, voffA);
            PG8_BAR; PG8_WAIT_L(0); PG8_MMA(1, 0, At, B0); PG8_BAR; PG8_SCHED;
            PG8_STAGE(PG8_SB(0, 1), b2 + hstepB, voffB);
            PG8_WAIT_V(6); PG8_BAR; PG8_MMA(1, 1, At, B1); PG8_BAR;
            PG8_LDB(B0, 1, 0); PG8_SCHED; PG8_LDA(At, 1, 0); PG8_STAGE(PG8_SA(0, 1), a2 + hstepA, voffA);
            PG8_WAIT_L(8); PG8_BAR; PG8_WAIT_L(0); PG8_MMA(0, 0, At, B0); PG8_BAR; PG8_SCHED;
            PG8_LDB(B1, 1, 1); PG8_STAGE(PG8_SB(1, 0), b3, voffB);
            PG8_BAR; PG8_WAIT_L(0); PG8_MMA(0, 1, At, B1); PG8_BAR;
            PG8_LDA(At, 1, 1); PG8_STAGE(PG8_SA(1, 0), a3, voffA);
            PG8_BAR; PG8_WAIT_L(0); PG8_MMA(1, 0, At, B0); PG8_BAR; PG8_SCHED;
            PG8_STAGE(PG8_SB(1, 1), b3 + hstepB, voffB);
            PG8_WAIT_V(6); PG8_BAR; PG8_MMA(1, 1, At, B1); PG8_BAR;
        }
        E(acc, cur, wr, wc, fr, fq);
        if (!has_next) break;
#pragma unroll
        for (int a = 0; a < 2; ++a)
#pragma unroll
            for (int b = 0; b < 2; ++b)
#pragma unroll
                for (int m = 0; m < 4; ++m)
#pragma unroll
                    for (int n = 0; n < 2; ++n) acc[a][b][m][n] = (f32x4){0.f, 0.f, 0.f, 0.f};
        cur = nxt; cA = nA; cB = nB; ++ui;
    }
    PG8_WAIT_V(0);
    if (wr == 0) PG8_BAR;
    PG8_BAR;
#undef PG8_SA
#undef PG8_SB
#undef PG8_STAGE
#undef PG8_LDA
#undef PG8_LDB
#undef PG8_MMA
#undef PG8_WAIT_V
#undef PG8_WAIT_L
#undef PG8_BAR
#undef PG8_SCHED
}
}
using pg8::Unit;
typedef f32x4 AccT[2][2][4][2];

struct EpiSwiglu {
    static constexpr bool PERM = true; bf16_t* H;
    __device__ __forceinline__ void operator()(const AccT& acc, const Unit& u, int wr, int wc, int fr, int fq) const {
        const int row0 = u.pm * 256 + wr * 64 + fr, col0 = u.pn * 128 + wc * 32 + 8 * fq;
#pragma unroll
        for (int ai = 0; ai < 2; ++ai)
#pragma unroll
            for (int m = 0; m < 4; ++m) { const f32x4 g0 = acc[ai][0][m][0], g1 = acc[ai][0][m][1], u0 = acc[ai][1][m][0], u1 = acc[ai][1][m][1];
                u32x4 w; w.x = pk(silu(g0[0]) * u0[0], silu(g0[1]) * u0[1]); w.y = pk(silu(g0[2]) * u0[2], silu(g0[3]) * u0[3]);
                w.z = pk(silu(g1[0]) * u1[0], silu(g1[1]) * u1[1]); w.w = pk(silu(g1[2]) * u1[2], silu(g1[3]) * u1[3]);
                *(u32x4*)(H + (size_t)(row0 + ai * 128 + m * 16) * FH + col0) = w; }
    }
};
struct EpiPre {
    static constexpr bool PERM = false; const bf16_t* XB; float* PRE; float cs;
    __device__ __forceinline__ void operator()(const AccT& acc, const Unit& u, int wr, int wc, int fr, int fq) const {
        const int row0 = u.pm * 256 + wr * 64 + fr, col0 = u.pn * 256 + wc * 32 + 4 * fq;
#pragma unroll
        for (int ai = 0; ai < 2; ++ai)
#pragma unroll
            for (int m = 0; m < 4; ++m) { const size_t ro = (size_t)(row0 + ai * 128 + m * 16) * DM + col0;
#pragma unroll
                for (int bj = 0; bj < 2; ++bj)
#pragma unroll
                    for (int n = 0; n < 2; ++n) { const u32x2 xw = *(const u32x2*)(XB + ro + bj * 128 + n * 16); const f32x4 a = acc[ai][bj][m][n];
                        f32x4 o; o[0] = 1.41421356237f * bflo(xw.x) + cs * a[0]; o[1] = 1.41421356237f * bfhi(xw.x) + cs * a[1]; o[2] = 1.41421356237f * bflo(xw.y) + cs * a[2]; o[3] = 1.41421356237f * bfhi(xw.y) + cs * a[3];
                        *(f32x4*)(PRE + ro + bj * 128 + n * 16) = o; } }
    }
};
struct EpiLn {
    static constexpr bool PERM = true; bf16_t* XB; float* X32; bool res32, last; const float* G; const float* B; float cs; unsigned long long* SLOT; unsigned* CNT;
    __device__ __forceinline__ void operator()(AccT& acc, const Unit& u, int wr, int wc, int fr, int fq) const {
        const int row0 = u.pm * 256 + wr * 64 + fr, col0 = u.pn * 256 + wc * 32 + 8 * fq; const float AL = 1.41421356237f;
#pragma unroll
        for (int h2 = 0; h2 < 4; ++h2) { const int ai = h2 >> 1, mb = (h2 & 1) * 2;
            f32x4 xr[2][2][2];
            if (res32) {
#pragma unroll
                for (int mm = 0; mm < 2; ++mm)
#pragma unroll
                    for (int bj = 0; bj < 2; ++bj) { const float* xp = X32 + (size_t)(row0 + ai * 128 + (mb + mm) * 16) * DM + col0 + bj * 128; xr[mm][bj][0] = *(const f32x4*)xp; xr[mm][bj][1] = *(const f32x4*)(xp + 4); }
            } else {
#pragma unroll
                for (int mm = 0; mm < 2; ++mm)
#pragma unroll
                    for (int bj = 0; bj < 2; ++bj) { const u32x4 x = *(const u32x4*)(XB + (size_t)(row0 + ai * 128 + (mb + mm) * 16) * DM + col0 + bj * 128);
                        xr[mm][bj][0] = (f32x4){bflo(x.x), bfhi(x.x), bflo(x.y), bfhi(x.y)}; xr[mm][bj][1] = (f32x4){bflo(x.z), bfhi(x.z), bflo(x.w), bfhi(x.w)}; }
            }
#pragma unroll
            for (int mm = 0; mm < 2; ++mm) { const int m = mb + mm; const int row = row0 + ai * 128 + m * 16; float s1 = 0.f, s2 = 0.f;
#pragma unroll
                for (int bj = 0; bj < 2; ++bj) { const f32x4 v0 = xr[mm][bj][0] * AL + acc[ai][bj][m][0] * cs, v1 = xr[mm][bj][1] * AL + acc[ai][bj][m][1] * cs;
                    acc[ai][bj][m][0] = v0; acc[ai][bj][m][1] = v1;
                    s1 += ((v0[0] + v0[1]) + (v0[2] + v0[3])) + ((v1[0] + v1[1]) + (v1[2] + v1[3]));
                    s2 += (v0[0] * v0[0] + v0[1] * v0[1]) + (v0[2] * v0[2] + v0[3] * v0[3]) + (v1[0] * v1[0] + v1[1] * v1[1]) + (v1[2] * v1[2] + v1[3] * v1[3]); }
                s1 += __shfl_xor(s1, 16); s1 += __shfl_xor(s1, 32); s2 += __shfl_xor(s2, 16); s2 += __shfl_xor(s2, 32);
                if (fq == 0) __hip_atomic_store(SLOT + (size_t)row * 16 + u.pn * 4 + wc, ((unsigned long long)__float_as_uint(s2) << 32) | (unsigned long long)__float_as_uint(s1), __ATOMIC_RELAXED, __HIP_MEMORY_SCOPE_AGENT); }
            asm volatile("" ::: "memory");
        }
        asm volatile("s_waitcnt vmcnt(0)" ::: "memory");
        unsigned* cnt = CNT + ((size_t)u.pm * 2 + wr) * 16;
        if ((fr | fq) == 0) __hip_atomic_fetch_add(cnt, 1u, __ATOMIC_RELAXED, __HIP_MEMORY_SCOPE_AGENT);
        while ((unsigned)__builtin_amdgcn_readfirstlane((int)__hip_atomic_load(cnt, __ATOMIC_RELAXED, __HIP_MEMORY_SCOPE_AGENT)) < 16u) __builtin_amdgcn_s_sleep(1);
        __builtin_amdgcn_fence(__ATOMIC_ACQUIRE, "workgroup"); asm volatile("" ::: "memory");
        f32x4 gv[2][2], bv[2][2];
#pragma unroll
        for (int bt = 0; bt < 3; ++bt) { const int rb = bt * 3, nr = bt == 2 ? 2 : 3;
            unsigned long long sw[3][4];
#pragma unroll
            for (int k = 0; k < 3; ++k) if (k < nr) { const int r8 = rb + k; const unsigned long long* sp = SLOT + (size_t)(row0 + (r8 >> 2) * 128 + (r8 & 3) * 16) * 16 + 4 * fq;
#pragma unroll
                for (int i = 0; i < 4; ++i) sw[k][i] = __hip_atomic_load(sp + i, __ATOMIC_RELAXED, __HIP_MEMORY_SCOPE_AGENT); }
            if (bt == 0) {
#pragma unroll
                for (int bj = 0; bj < 2; ++bj)
#pragma unroll
                    for (int n = 0; n < 2; ++n) { gv[bj][n] = *(const f32x4*)(G + col0 + bj * 128 + 4 * n); bv[bj][n] = *(const f32x4*)(B + col0 + bj * 128 + 4 * n); } }
#pragma unroll
            for (int k = 0; k < 3; ++k) if (k < nr) { const int r8 = rb + k, ai = r8 >> 2, m = r8 & 3; const int row = row0 + ai * 128 + m * 16; float t1 = 0.f, t2 = 0.f;
#pragma unroll
                for (int i = 0; i < 4; ++i) { const unsigned long long w = sw[k][i]; t1 += __uint_as_float((unsigned)w); t2 += __uint_as_float((unsigned)(w >> 32)); }
                t1 += __shfl_xor(t1, 16); t1 += __shfl_xor(t1, 32); t2 += __shfl_xor(t2, 16); t2 += __shfl_xor(t2, 32);
                const float mean = t1 * (1.0f / 1024.0f), var = t2 * (1.0f / 1024.0f) - mean * mean, rstd = rsqrtf(fmaxf(var, 0.f) + 1e-5f);
#pragma unroll
                for (int bj = 0; bj < 2; ++bj) { const f32x4 y0 = (acc[ai][bj][m][0] - mean) * rstd * gv[bj][0] + bv[bj][0], y1 = (acc[ai][bj][m][1] - mean) * rstd * gv[bj][1] + bv[bj][1];
                    *(f32x4*)(X32 + (size_t)row * DM + col0 + bj * 128) = y0; *(f32x4*)(X32 + (size_t)row * DM + col0 + bj * 128 + 4) = y1;
                    if (!last) { u32x4 w; w.x = pk(y0[0], y0[1]); w.y = pk(y0[2], y0[3]); w.z = pk(y1[0], y1[1]); w.w = pk(y1[2], y1[3]); *(u32x4*)(XB + (size_t)row * DM + col0 + bj * 128) = w; } } }
            asm volatile("" ::: "memory");
        }
    }
};
struct EpiWin {
    static constexpr bool PERM = true; bf16_t* P; float* SSQ;
    __device__ __forceinline__ void operator()(const AccT& acc, const Unit& u, int wr, int wc, int fr, int fq) const {
        const int row0 = u.pm * 256 + wr * 64 + fr, col0 = u.pn * 256 + wc * 32 + 8 * fq;
#pragma unroll
        for (int ai = 0; ai < 2; ++ai)
#pragma unroll
            for (int m = 0; m < 4; ++m) { const int row = row0 + ai * 128 + m * 16; float s = 0.f;
#pragma unroll
                for (int bj = 0; bj < 2; ++bj) { f32x4 v0 = acc[ai][bj][m][0], v1 = acc[ai][bj][m][1]; const int c = col0 + bj * 128;
                    s += (v0[0] * v0[0] + v0[1] * v0[1]) + (v0[2] * v0[2] + v0[3] * v0[3]) + (v1[0] * v1[0] + v1[1] * v1[1]) + (v1[2] * v1[2] + v1[3] * v1[3]);
                    if (c < LDP) { u32x4 w; w.x = pk(v0[0], v0[1]); w.y = pk(v0[2], v0[3]); w.z = pk(v1[0], v1[1]); w.w = pk(v1[2], v1[3]); *(u32x4*)(P + (size_t)row * LDP + c) = w; } }
                if (u.pn < 4) { s += __shfl_xor(s, 16); s += __shfl_xor(s, 32); if (fq == 0) SSQ[(size_t)row * 16 + u.pn * 4 + wc] = s; } }
    }
};
struct EpiQ {
    static constexpr bool PERM = false; bf16_t* Q; const float* SSQ; const f32x2* ROPE;
    __device__ __forceinline__ void operator()(const AccT& acc, const Unit& u, int wr, int wc, int fr, int fq) const {
        const int row0 = u.pm * 256 + wr * 64 + fr; const float QS = 0.10206207261596577f * 1.4426950408889634f;
#pragma unroll
        for (int ai = 0; ai < 2; ++ai)
#pragma unroll
            for (int m = 0; m < 4; ++m) { const int row = row0 + ai * 128 + m * 16;
                const f32x4 s0 = *(const f32x4*)(SSQ + (size_t)row * 16), s1 = *(const f32x4*)(SSQ + (size_t)row * 16 + 4), s2 = *(const f32x4*)(SSQ + (size_t)row * 16 + 8);
                const float ss = ((s0[0] + s0[1]) + (s0[2] + s0[3])) + ((s1[0] + s1[1]) + (s1[2] + s1[3])) + ((s2[0] + s2[1]) + (s2[2] + s2[3]));
                const float rs = rsqrtf(ss * (1.0f / 768.0f) + 1e-6f) * QS; const int pos = tok_pos(row);
#pragma unroll
                for (int bj = 0; bj < 2; ++bj) { const int cg = u.pn * 256 + bj * 128 + wc * 32; f32x4 a0 = acc[ai][bj][m][0] * rs, a1 = acc[ai][bj][m][1] * rs;
                    if ((cg % 96) == 64) { const f32x4 t0 = *(const f32x4*)(ROPE + (size_t)pos * 16 + 4 * fq), t1 = *(const f32x4*)(ROPE + (size_t)pos * 16 + 4 * fq + 2);
                        const float cs[4] = {t0[0], t0[2], t1[0], t1[2]}, sn[4] = {t0[1], t0[3], t1[1], t1[3]}; f32x4 o0, o1;
#pragma unroll
                        for (int j = 0; j < 4; ++j) { o0[j] = a0[j] * cs[j] - a1[j] * sn[j]; o1[j] = a0[j] * sn[j] + a1[j] * cs[j]; }
                        a0 = o0; a1 = o1; }
                    u32x2 w0, w1; w0.x = pk(a0[0], a0[1]); w0.y = pk(a0[2], a0[3]); w1.x = pk(a1[0], a1[1]); w1.y = pk(a1[2], a1[3]);
                    *(u32x2*)(Q + (size_t)row * 768 + cg + 4 * fq) = w0; *(u32x2*)(Q + (size_t)row * 768 + cg + 16 + 4 * fq) = w1; }
                asm volatile("" ::: "memory"); }
    }
};
struct EpiKN {
    static constexpr bool PERM = true; bf16_t* KN; const float* SSQ;
    __device__ __forceinline__ void operator()(const AccT& acc, const Unit& u, int wr, int wc, int fr, int fq) const {
        const int row0 = u.pm * 256 + wr * 64 + fr, col0 = u.pn * 256 + wc * 32 + 8 * fq;
#pragma unroll
        for (int ai = 0; ai < 2; ++ai)
#pragma unroll
            for (int m = 0; m < 4; ++m) { const int row = row0 + ai * 128 + m * 16; const f32x4 s3 = *(const f32x4*)(SSQ + (size_t)row * 16 + 12);
                const float rs = rsqrtf(((s3[0] + s3[1]) + (s3[2] + s3[3])) * (1.0f / 256.0f) + 1e-6f);
#pragma unroll
                for (int bj = 0; bj < 2; ++bj) { const f32x4 v0 = acc[ai][bj][m][0] * rs, v1 = acc[ai][bj][m][1] * rs;
                    u32x4 w; w.x = pk(v0[0], v0[1]); w.y = pk(v0[2], v0[3]); w.z = pk(v1[0], v1[1]); w.w = pk(v1[2], v1[3]); *(u32x4*)(KN + (size_t)row * 512 + col0 + bj * 128) = w; }
                asm volatile("" ::: "memory"); }
    }
};
struct EpiVT {
    static constexpr bool PERM = true; bf16_t* VT; const float* SSQ;
    __device__ __forceinline__ void operator()(const AccT& acc, const Unit& u, int wr, int wc, int fr, int fq) const {
        const int f0 = u.pm * 256 + wr * 64 + fr, tok0 = u.pn * 256 + wc * 32 + 8 * fq;
#pragma unroll
        for (int bj = 0; bj < 2; ++bj) {
            float rs[8];
#pragma unroll
            for (int i = 0; i < 8; ++i) { const f32x4 s3 = *(const f32x4*)(SSQ + (size_t)(tok0 + bj * 128 + i) * 16 + 12); rs[i] = rsqrtf(((s3[0] + s3[1]) + (s3[2] + s3[3])) * (1.0f / 256.0f) + 1e-6f); }
            asm volatile("" ::: "memory");
#pragma unroll
            for (int ai = 0; ai < 2; ++ai)
#pragma unroll
                for (int m = 0; m < 4; ++m) { const int f = f0 + ai * 128 + m * 16; const f32x4 v0 = acc[ai][bj][m][0], v1 = acc[ai][bj][m][1];
                    u32x4 w; w.x = pk(v0[0] * rs[0], v0[1] * rs[1]); w.y = pk(v0[2] * rs[2], v0[3] * rs[3]); w.z = pk(v1[0] * rs[4], v1[1] * rs[5]); w.w = pk(v1[2] * rs[6], v1[3] * rs[7]);
                    *(u32x4*)(VT + (size_t)f * MTOK + tok0 + bj * 128) = w; }
            asm volatile("" ::: "memory");
        }
    }
};
struct EpiSguV {
    static constexpr bool PERM = true; bf16_t* V; f32x2* STATS;
    __device__ __forceinline__ void operator()(const AccT& acc, const Unit& u, int wr, int wc, int fr, int fq) const {
        const int row0 = u.pm * 256 + wr * 64 + fr, col0 = u.pn * 256 + wc * 32 + 8 * fq;
#pragma unroll
        for (int ai = 0; ai < 2; ++ai)
#pragma unroll
            for (int m = 0; m < 4; ++m) { const int row = row0 + ai * 128 + m * 16; float s1 = 0.f, s2 = 0.f;
#pragma unroll
                for (int bj = 0; bj < 2; ++bj) { const f32x4 v0 = gelu4(acc[ai][bj][m][0]), v1 = gelu4(acc[ai][bj][m][1]);
                    s1 += ((v0[0] + v0[1]) + (v0[2] + v0[3])) + ((v1[0] + v1[1]) + (v1[2] + v1[3]));
                    s2 += (v0[0] * v0[0] + v0[1] * v0[1]) + (v0[2] * v0[2] + v0[3] * v0[3]) + (v1[0] * v1[0] + v1[1] * v1[1]) + (v1[2] * v1[2] + v1[3] * v1[3]);
                    u32x4 w; w.x = pk(v0[0], v0[1]); w.y = pk(v0[2], v0[3]); w.z = pk(v1[0], v1[1]); w.w = pk(v1[2], v1[3]); *(u32x4*)(V + (size_t)row * SH + col0 + bj * 128) = w; }
                s1 += __shfl_xor(s1, 16); s1 += __shfl_xor(s1, 32); s2 += __shfl_xor(s2, 16); s2 += __shfl_xor(s2, 32);
                if (fq == 0) STATS[(size_t)row * 48 + u.pn * 4 + wc] = (f32x2){s1, s2}; }
    }
};
struct EpiSguU {
    static constexpr bool PERM = true; bf16_t* V;
    __device__ __forceinline__ void operator()(const AccT& acc, const Unit& u, int wr, int wc, int fr, int fq) const {
        const int row0 = u.pm * 256 + wr * 64 + fr, col0 = u.pn * 256 + wc * 32 + 8 * fq;
#pragma unroll
        for (int ai = 0; ai < 2; ++ai)
#pragma unroll
            for (int m = 0; m < 4; ++m) { const int row = row0 + ai * 128 + m * 16;
#pragma unroll
                for (int bj = 0; bj < 2; ++bj) { bf16_t* ptr = V + (size_t)row * SH + col0 + bj * 128; const u32x4 vv = *(const u32x4*)ptr;
                    const f32x4 v0 = gelu4(acc[ai][bj][m][0]), v1 = gelu4(acc[ai][bj][m][1]);
                    u32x4 w; w.x = pk(v0[0] * bflo(vv.x), v0[1] * bfhi(vv.x)); w.y = pk(v0[2] * bflo(vv.y), v0[3] * bfhi(vv.y)); w.z = pk(v1[0] * bflo(vv.z), v1[1] * bfhi(vv.z)); w.w = pk(v1[2] * bflo(vv.w), v1[3] * bfhi(vv.w));
                    *(u32x4*)ptr = w; } }
    }
};

template <class Epi> __device__ __forceinline__ void run_gemm(LAS unsigned char* lds, const bf16_t* A, int lda, const bf16_t* Bt, int ldb, int M, int N, int K, const Epi& E) {
    pg8::Gemm g; g.A = A; g.Bt = Bt; g.lda = lda; g.ldb = ldb; g.M = M; g.N = N; g.K = K;
    pg8::StaticOrder S; S.init(M, N, (int)gridDim.x, lbid());
    pg8::gemm_phase<Epi>(lds, g, S, E);
}

__device__ __forceinline__ int mapcol(int mode, int nd) {
    switch (mode) {
        case 1: { const int t = nd >> 8, w = nd & 255; return (w >= 128 ? FH : 0) + t * 128 + (w & 127); }
        case 2: return nd < LDP ? nd : -1;
        case 3: return (nd >> 6) * 128 + (nd & 63);
        case 4: return (nd >> 6) * 128 + 64 + (nd & 63);
        default: return nd;
    }
}
__device__ __forceinline__ void convert_T(LAS unsigned char* lds, const float* src, int ldsrc, int K, int Ndst, bf16_t* dst, int mode, const float* kscale) {
    LAS float* tile = (LAS float*)lds;
    const int tid = ltid(), ntk = K / 64, ntn = Ndst / 256;
    for (int idx = lbid(); idx < ntk * ntn; idx += gridDim.x) {
        const int tk = idx % ntk, tn = idx / ntk;
        const int r0 = tid >> 6, c4 = (tid & 63) * 4; const int ns = mapcol(mode, tn * 256 + c4);
        f32x4 v[8];
#pragma unroll
        for (int i = 0; i < 8; ++i) { const int k = tk * 64 + r0 + 8 * i; v[i] = (f32x4){0.f, 0.f, 0.f, 0.f}; if (ns >= 0) v[i] = *(const f32x4*)(src + (size_t)k * ldsrc + ns); if (kscale) v[i] = v[i] * kscale[k]; }
#pragma unroll
        for (int i = 0; i < 8; ++i) *(LAS f32x4*)(tile + (r0 + 8 * i) * 260 + c4) = v[i];
        __syncthreads();
        const int n = tid >> 1, kh = (tid & 1) * 32;
#pragma unroll
        for (int q = 0; q < 4; ++q) { float x[8];
#pragma unroll
            for (int i = 0; i < 8; ++i) x[i] = tile[(kh + 8 * q + i) * 260 + n];
            u32x4 w; w.x = pk(x[0], x[1]); w.y = pk(x[2], x[3]); w.z = pk(x[4], x[5]); w.w = pk(x[6], x[7]);
            *(u32x4*)(dst + (size_t)(tn * 256 + n) * K + tk * 64 + kh + 8 * q) = w; }
        __syncthreads();
    }
}
#define PIN(k) (p.in[lidx(k)])
__device__ __forceinline__ int lidx(int k) { asm volatile("" : "+s"(k)); return k; }
__device__ __forceinline__ void copyf(float* dst, const float* src, size_t n, size_t gt, size_t nth) { if (gt < n) dst[gt] = src[gt]; }
__device__ __forceinline__ void phase0(LAS unsigned char* lds, const Params& p) {
    unsigned char* ws = p.ws;
    const size_t gt = (size_t)lbid() * 512 + ltid(), nth = (size_t)gridDim.x * 512;
    { bf16_t* XB = (bf16_t*)(ws + WS_XB); const size_t n4 = (size_t)MTOK * DM / 4, np4 = (size_t)NPROMPT * DM / 4; const f32x4* xp = (const f32x4*)PIN(0); const f32x4* xs = (const f32x4*)PIN(1);
      size_t i = gt;
      for (; i + 3 * nth < n4; i += 4 * nth) { f32x4 v[4];
#pragma unroll
          for (int u = 0; u < 4; ++u) { const size_t j = i + u * nth; v[u] = j < np4 ? xp[j] : xs[j - np4]; }
#pragma unroll
          for (int u = 0; u < 4; ++u) { u32x2 w; w.x = pk(v[u][0], v[u][1]); w.y = pk(v[u][2], v[u][3]); ((u32x2*)XB)[i + u * nth] = w; ((f32x4*)p.out)[i + u * nth] = v[u]; } }
      for (; i < n4; i += nth) { const f32x4 v = i < np4 ? xp[i] : xs[i - np4]; u32x2 w; w.x = pk(v[0], v[1]); w.y = pk(v[2], v[3]); ((u32x2*)XB)[i] = w; ((f32x4*)p.out)[i] = v; } }
    { bf16_t* W = (bf16_t*)(ws + WS_WS); const float* wsrc = PIN(30); for (size_t i = gt; i < 8 * 128 * 128 / 2; i += nth) { ((unsigned*)W)[i] = pk(wsrc[2 * i], wsrc[2 * i + 1]); }
      f32x2* R = (f32x2*)(ws + WS_ROPE); for (size_t i = gt; i < 4096 * 16; i += nth) { const int pos = (int)(i >> 4), j = (int)(i & 15);
          const float inv = 1.0f / powf(10000.0f, (float)(2 * j) / 32.0f); const float ang = (float)pos * inv; R[i] = (f32x2){cosf(ang), sinf(ang)}; } }
    { float* SMp = (float*)(ws + WS_SMALL);
#pragma unroll 1
      for (int k = 0; k < 6; ++k) { const int gi = k == 0 ? 4 : k == 1 ? 17 : k == 2 ? 21 : k == 3 ? 25 : k == 4 ? 33 : 37; copyf(SMp + SM_LN + k * 2048, PIN(gi), 1024, gt, nth); copyf(SMp + SM_LN + k * 2048 + 1024, PIN(gi + 1), 1024, gt, nth); }
      copyf(SMp + SM_WGF, PIN(11), 4096, gt, nth); copyf(SMp + SM_WGB, PIN(13), 4096, gt, nth); copyf(SMp + SM_BGF, PIN(12), 256, gt, nth); copyf(SMp + SM_BGB, PIN(14), 256, gt, nth);
      copyf(SMp + SM_GN, PIN(15), 128, gt, nth); copyf(SMp + SM_LNG, PIN(28), 3072, gt, nth); copyf(SMp + SM_LNB, PIN(29), 3072, gt, nth); copyf(SMp + SM_BS, PIN(31), 1024, gt, nth); }
#pragma unroll 1
    for (int f = 0; f < 4; ++f) { const int gi = f == 0 ? 2 : f == 1 ? 19 : f == 2 ? 23 : 35;
        convert_T(lds, PIN(gi), 2 * FH, DM, 2 * FH, (bf16_t*)(ws + WS_FFN + (size_t)f * 17301504), 1, nullptr);
        convert_T(lds, PIN(gi + 1), DM, FH, DM, (bf16_t*)(ws + WS_FFN + (size_t)f * 17301504 + 11534336), 0, nullptr);
    }
    convert_T(lds, PIN(6), LDP, DM, 2816, (bf16_t*)(ws + WS_WIN), 2, nullptr);
    convert_T(lds, PIN(8), 768, 768, 768, (bf16_t*)(ws + WS_UQ), 0, PIN(7));
    convert_T(lds, PIN(10), 1024, 256, 512, (bf16_t*)(ws + WS_UKN), 3, PIN(9));
    convert_T(lds, PIN(10), 1024, 256, 512, (bf16_t*)(ws + WS_UV), 4, PIN(9));
    convert_T(lds, PIN(16), DM, DM, DM, (bf16_t*)(ws + WS_WOUT), 0, nullptr);
    convert_T(lds, PIN(27), 2 * SH, DM, 2 * SH, (bf16_t*)(ws + WS_SIN), 0, nullptr);
    convert_T(lds, PIN(32), DM, SH, DM, (bf16_t*)(ws + WS_SOUT), 0, nullptr);
}

__device__ __forceinline__ void ln_phase(const float* pre, const float* g, const float* b, bf16_t* xb, float* outf) {
    const int wid = ltid() >> 6, lane = ltid() & 63;
    f32x4 gv[4], bv[4];
#pragma unroll
    for (int i = 0; i < 4; ++i) { gv[i] = *(const f32x4*)(g + 4 * lane + 256 * i); bv[i] = *(const f32x4*)(b + 4 * lane + 256 * i); }
    const int nw = gridDim.x * 8;
    for (int row = lbid() * 8 + wid; row < MTOK; row += 2 * nw) {
        const int row2 = row + nw; const bool has2 = row2 < MTOK;
        const float* pr = pre + (size_t)row * DM; const float* pr2 = pre + (size_t)(has2 ? row2 : row) * DM; f32x4 v[4], w[4]; float s = 0.f, s2 = 0.f;
#pragma unroll
        for (int i = 0; i < 4; ++i) { v[i] = *(const f32x4*)(pr + 4 * lane + 256 * i); w[i] = *(const f32x4*)(pr2 + 4 * lane + 256 * i); }
#pragma unroll
        for (int i = 0; i < 4; ++i) { s += (v[i][0] + v[i][1]) + (v[i][2] + v[i][3]); s2 += (w[i][0] + w[i][1]) + (w[i][2] + w[i][3]); }
#pragma unroll
        for (int o = 32; o >= 1; o >>= 1) { s += __shfl_xor(s, o); s2 += __shfl_xor(s2, o); }
        const float mean = s * (1.0f / 1024.0f), mean2 = s2 * (1.0f / 1024.0f); float q = 0.f, q2 = 0.f;
#pragma unroll
        for (int i = 0; i < 4; ++i) { v[i] = v[i] - mean; q += (v[i][0] * v[i][0] + v[i][1] * v[i][1]) + (v[i][2] * v[i][2] + v[i][3] * v[i][3]);
                                      w[i] = w[i] - mean2; q2 += (w[i][0] * w[i][0] + w[i][1] * w[i][1]) + (w[i][2] * w[i][2] + w[i][3] * w[i][3]); }
#pragma unroll
        for (int o = 32; o >= 1; o >>= 1) { q += __shfl_xor(q, o); q2 += __shfl_xor(q2, o); }
        const float rstd = rsqrtf(q * (1.0f / 1024.0f) + 1e-5f), rstd2 = rsqrtf(q2 * (1.0f / 1024.0f) + 1e-5f);
#pragma unroll
        for (int i = 0; i < 4; ++i) { const f32x4 y = v[i] * rstd * gv[i] + bv[i];
            if (xb) { u32x2 t; t.x = pk(y[0], y[1]); t.y = pk(y[2], y[3]); *(u32x2*)(xb + (size_t)row * DM + 4 * lane + 256 * i) = t; }
            if (outf) *(f32x4*)(outf + (size_t)row * DM + 4 * lane + 256 * i) = y; }
        if (has2) {
#pragma unroll
            for (int i = 0; i < 4; ++i) { const f32x4 y = w[i] * rstd2 * gv[i] + bv[i];
                if (xb) { u32x2 t; t.x = pk(y[0], y[1]); t.y = pk(y[2], y[3]); *(u32x2*)(xb + (size_t)row2 * DM + 4 * lane + 256 * i) = t; }
                if (outf) *(f32x4*)(outf + (size_t)row2 * DM + 4 * lane + 256 * i) = y; } }
    }
}

__device__ __forceinline__ void kr_pass(const bf16_t* P, const f32x2* ROPE, bf16_t* KR) {
    const size_t gt = (size_t)lbid() * 512 + ltid(), nth = (size_t)gridDim.x * 512;
    for (size_t i = gt; i < (size_t)MTOK * 16; i += nth) { const int row = (int)(i >> 4), j = (int)(i & 15); const int pos = tok_pos(row);
        const bf16_t* pr = P + (size_t)row * LDP + 1024; const float x1 = bflo((unsigned)pr[j]), x2 = bflo((unsigned)pr[j + 16]); const f32x2 cs = ROPE[(size_t)pos * 16 + j];
        KR[(size_t)row * 32 + j] = (bf16_t)(pk(x1 * cs.x - x2 * cs.y, 0.f) & 0xffffu); KR[(size_t)row * 32 + 16 + j] = (bf16_t)(pk(x1 * cs.y + x2 * cs.x, 0.f) & 0xffffu); }
}

#define MFMA16(a, b, c) __builtin_amdgcn_mfma_f32_16x16x32_bf16((a), (b), (c), 0, 0, 0)
__device__ __forceinline__ bf16x8 mk8(u32x2 lo, u32x2 hi) { u32x4 w; w.x = lo.x; w.y = lo.y; w.z = hi.x; w.w = hi.y; return __builtin_bit_cast(bf16x8, w); }
__device__ __forceinline__ bf16x8 pack8(f32x4 a, f32x4 b) { u32x4 w; w.x = pk(a[0], a[1]); w.y = pk(a[2], a[3]); w.z = pk(b[0], b[1]); w.w = pk(b[2], b[3]); return __builtin_bit_cast(bf16x8, w); }

__device__ __forceinline__ void attn_phase(LAS unsigned char* lds, const bf16_t* Q, const bf16_t* KN, const bf16_t* KR, const bf16_t* VT, bf16_t* O) {
    const int tid = ltid(), wid = tid >> 6, lane = tid & 63, fr = lane & 15, fq = lane >> 4;
    const int G = gridDim.x; const int L = (G % 8 == 0) ? ((lbid() & 7) * (G >> 3) + (lbid() >> 3)) : lbid();
    constexpr int KBYTES = 128 * 208, BUF = KBYTES + 64 * 272;
    for (int it = L; it < 3072; it += G) {
        int h, S, row0, qb;
        if (it < 2048) { const int pair = it >> 4; qb = it & 15; h = pair & 7; S = 4096; row0 = NPROMPT + (pair >> 3) * 4096; }
        else { const int j = it - 2048, pair = j >> 3; qb = j & 7; h = pair & 7; S = 2048; row0 = (pair >> 3) * 2048; }
        const int qrow0 = row0 + qb * 256 + wid * 32;
        bf16x8 Qf[2][3];
#pragma unroll
        for (int qf = 0; qf < 2; ++qf)
#pragma unroll
            for (int ks = 0; ks < 3; ++ks) Qf[qf][ks] = *(const bf16x8*)(Q + (size_t)(qrow0 + 16 * qf + fr) * 768 + h * 96 + 32 * ks + 8 * fq);
        f32x4 Oacc[2][4];
#pragma unroll
        for (int qf = 0; qf < 2; ++qf)
#pragma unroll
            for (int nb = 0; nb < 4; ++nb) Oacc[qf][nb] = (f32x4){0.f, 0.f, 0.f, 0.f};
        float mi[2] = {-1e30f, -1e30f}, li[2] = {0.f, 0.f};
        const int nt = S / 128;
        const bf16_t* ksrc[3]; int kstep[3], kdst[3]; const bf16_t* vsrc[2]; int vdst[2];
#pragma unroll
        for (int i = 0; i < 3; ++i) { const int pp = tid + 512 * i, key = pp / 12, part = pp % 12;
            ksrc[i] = part < 8 ? KN + (size_t)(row0 + key) * 512 + h * 64 + part * 8 : KR + (size_t)(row0 + key) * 32 + (part - 8) * 8;
            kstep[i] = part < 8 ? 128 * 512 : 128 * 32; kdst[i] = key * 208 + part * 16; }
#pragma unroll
        for (int i = 0; i < 2; ++i) { const int pp = tid + 512 * i, dv = pp >> 4, seg = pp & 15;
            vsrc[i] = VT + (size_t)(h * 64 + dv) * MTOK + row0 + seg * 8; vdst[i] = KBYTES + dv * 272 + seg * 16; }
        u32x4 rk[3], rv[2];
#pragma unroll
        for (int i = 0; i < 3; ++i) rk[i] = *(const u32x4*)ksrc[i];
#pragma unroll
        for (int i = 0; i < 2; ++i) rv[i] = *(const u32x4*)vsrc[i];
#pragma unroll
        for (int i = 0; i < 3; ++i) *(LAS u32x4*)(lds + kdst[i]) = rk[i];
#pragma unroll
        for (int i = 0; i < 2; ++i) *(LAS u32x4*)(lds + vdst[i]) = rv[i];
        __syncthreads();
        for (int t = 0; t < nt; ++t) {
            const bool pf = (t + 1 < nt);
            if (pf) {
#pragma unroll
                for (int i = 0; i < 3; ++i) rk[i] = *(const u32x4*)(ksrc[i] + (size_t)(t + 1) * kstep[i]);
#pragma unroll
                for (int i = 0; i < 2; ++i) rv[i] = *(const u32x4*)(vsrc[i] + (size_t)(t + 1) * 128);
            }
#pragma unroll 1
            for (int sub = 0; sub < 2; ++sub) {
                LAS unsigned char* kb_ = lds + (t & 1) * BUF + sub * (64 * 208); LAS unsigned char* vb_ = lds + (t & 1) * BUF + KBYTES + sub * 128;
                bf16x8 Pf[2][2];
                {
                    bf16x8 Kf[4][3];
#pragma unroll
                    for (int kb = 0; kb < 4; ++kb)
#pragma unroll
                        for (int ks = 0; ks < 3; ++ks) Kf[kb][ks] = *(const LAS bf16x8*)(kb_ + (16 * kb + fr) * 208 + (32 * ks + 8 * fq) * 2);
#pragma unroll
                    for (int qf = 0; qf < 2; ++qf) {
                        f32x4 s[4];
#pragma unroll
                        for (int kb = 0; kb < 4; ++kb) { s[kb] = (f32x4){0.f, 0.f, 0.f, 0.f};
#pragma unroll
                            for (int ks = 0; ks < 3; ++ks) s[kb] = MFMA16(Kf[kb][ks], Qf[qf][ks], s[kb]); }
                        float mx = -1e30f;
#pragma unroll
                        for (int kb = 0; kb < 4; ++kb) mx = fmaxf(mx, fmaxf(fmaxf(s[kb][0], s[kb][1]), fmaxf(s[kb][2], s[kb][3])));
                        mx = fmaxf(mx, __shfl_xor(mx, 16)); mx = fmaxf(mx, __shfl_xor(mx, 32));
                        const float mn = fmaxf(mi[qf], mx), al = fexp2(mi[qf] - mn); mi[qf] = mn;
                        float ps = 0.f;
#pragma unroll
                        for (int kb = 0; kb < 4; ++kb)
#pragma unroll
                            for (int j = 0; j < 4; ++j) { const float pv = fexp2(s[kb][j] - mn); s[kb][j] = pv; ps += pv; }
                        li[qf] = li[qf] * al + ps;
#pragma unroll
                        for (int nb = 0; nb < 4; ++nb) Oacc[qf][nb] = Oacc[qf][nb] * al;
                        Pf[qf][0] = pack8(s[0], s[1]); Pf[qf][1] = pack8(s[2], s[3]);
                    }
                }
#pragma unroll
                for (int nb = 0; nb < 4; ++nb)
#pragma unroll
                    for (int c = 0; c < 2; ++c) {
                        const u32x2 lo = *(const LAS u32x2*)(vb_ + (16 * nb + fr) * 272 + (32 * c + 4 * fq) * 2), hi = *(const LAS u32x2*)(vb_ + (16 * nb + fr) * 272 + (32 * c + 16 + 4 * fq) * 2);
                        const bf16x8 Vf = mk8(lo, hi);
#pragma unroll
                        for (int qf = 0; qf < 2; ++qf) Oacc[qf][nb] = MFMA16(Vf, Pf[qf][c], Oacc[qf][nb]);
                    }
            }
            if (pf) { LAS unsigned char* nb_ = lds + ((t + 1) & 1) * BUF;
#pragma unroll
                for (int i = 0; i < 3; ++i) *(LAS u32x4*)(nb_ + kdst[i]) = rk[i];
#pragma unroll
                for (int i = 0; i < 2; ++i) *(LAS u32x4*)(nb_ + vdst[i]) = rv[i]; }
            __syncthreads();
        }
#pragma unroll
        for (int qf = 0; qf < 2; ++qf) { float l = li[qf]; l += __shfl_xor(l, 16); l += __shfl_xor(l, 32); const float inv = 1.0f / l; const int row = qrow0 + 16 * qf + fr;
#pragma unroll
            for (int nb = 0; nb < 4; ++nb) { const f32x4 o = Oacc[qf][nb] * inv; u32x2 w; w.x = pk(o[0], o[1]); w.y = pk(o[2], o[3]); *(u32x2*)(O + (size_t)row * LDP + h * 64 + 16 * nb + 4 * fq) = w; } }
    }
}

constexpr int GL_QF = 0, GL_KF = 9216, GL_QB = 18432, GL_KB = 27648, GL_KSF = 36864, GL_KSB = 46080, GL_VT = 55296, GL_RED = 73728;
constexpr int GL_W = 74752;
__device__ __forceinline__ void gla_stage_w(LAS unsigned char* lds, const float* SMp) {
    const int tid = ltid(); LAS float* w = (LAS float*)(lds + GL_W);
    for (int i = tid; i < 4096; i += 512) { w[i] = SMp[SM_WGF + i]; w[4096 + i] = SMp[SM_WGB + i]; }
    if (tid < 256) { w[8192 + tid] = SMp[SM_BGF + tid]; w[8448 + tid] = SMp[SM_BGB + tid]; }
    __syncthreads();
}
__device__ __forceinline__ float dpp_add(float x, float v, const int ctrl, const int row_mask) {
    return x; }
#define DPP_STEP(x, ctrl, rmask) x = x + __int_as_float(__builtin_amdgcn_update_dpp(0, __float_as_int(x), ctrl, rmask, 0xf, false))
__device__ __forceinline__ float wave_incl_scan(float x, int lane) {
    DPP_STEP(x, 0x111, 0xf); DPP_STEP(x, 0x112, 0xf); DPP_STEP(x, 0x114, 0xf); DPP_STEP(x, 0x118, 0xf);
    DPP_STEP(x, 0x142, 0xa); DPP_STEP(x, 0x143, 0xc);
    return x;
}
__device__ __forceinline__ float logsig(float x) { return fminf(x, 0.f) - __logf(1.0f + __expf(-fabsf(x))); }
__device__ __forceinline__ void gla_prep(LAS unsigned char* lds, const bf16_t* P, int c, int h, float* DEC, bool wdec) {
    const int tid = ltid(), wid = tid >> 6, lane = tid & 63;
    const bf16_t* prow = P + (size_t)(c * 64 + lane) * LDP;
    float zf[16], zb[16];
    { const u32x4 a = *(const u32x4*)(prow + 2592), b = *(const u32x4*)(prow + 2600), c2 = *(const u32x4*)(prow + 2608), d = *(const u32x4*)(prow + 2616);
      const unsigned wa[8] = {a.x, a.y, a.z, a.w, b.x, b.y, b.z, b.w}, wb[8] = {c2.x, c2.y, c2.z, c2.w, d.x, d.y, d.z, d.w};
#pragma unroll
      for (int i = 0; i < 8; ++i) { zf[2 * i] = bflo(wa[i]); zf[2 * i + 1] = bfhi(wa[i]); zb[2 * i] = bflo(wb[i]); zb[2 * i + 1] = bfhi(wb[i]); } }
    float qv[8], kv[8];
    { const u32x4 a = *(const u32x4*)(prow + 1056 + h * 64 + 8 * wid), b = *(const u32x4*)(prow + 1312 + h * 64 + 8 * wid);
      const unsigned wa[4] = {a.x, a.y, a.z, a.w}, wb[4] = {b.x, b.y, b.z, b.w};
#pragma unroll
      for (int i = 0; i < 4; ++i) { qv[2 * i] = bflo(wa[i]) * 0.125f; qv[2 * i + 1] = bfhi(wa[i]) * 0.125f; kv[2 * i] = bflo(wb[i]); kv[2 * i + 1] = bfhi(wb[i]); } }
    float af[8], ab[8];
    { const LAS float* wl = (const LAS float*)(lds + GL_W) + h * 64 + 8 * wid;
      const f32x4 b0 = *(const LAS f32x4*)(wl + 8192), b1 = *(const LAS f32x4*)(wl + 8196), b2 = *(const LAS f32x4*)(wl + 8448), b3 = *(const LAS f32x4*)(wl + 8452);
#pragma unroll
      for (int i = 0; i < 4; ++i) { af[i] = b0[i]; af[4 + i] = b1[i]; ab[i] = b2[i]; ab[4 + i] = b3[i]; }
#pragma unroll
      for (int r = 0; r < 16; ++r) { const f32x4 f0 = *(const LAS f32x4*)(wl + r * 256), f1 = *(const LAS f32x4*)(wl + r * 256 + 4), g0 = *(const LAS f32x4*)(wl + 4096 + r * 256), g1 = *(const LAS f32x4*)(wl + 4096 + r * 256 + 4);
#pragma unroll
          for (int i = 0; i < 4; ++i) { af[i] += zf[r] * f0[i]; af[4 + i] += zf[r] * f1[i]; ab[i] += zb[r] * g0[i]; ab[4 + i] += zb[r] * g1[i]; } } }
    float oqf[8], okf[8], oqb[8], okb[8]; float tsf = 0.f, tsb = 0.f;
#pragma unroll
    for (int dd = 0; dd < 8; ++dd) {
        const int d = 8 * wid + dd;
        const float laf = logsig(af[dd]) * 0.0625f, lab = logsig(ab[dd]) * 0.0625f;
        const float pf = wave_incl_scan(laf, lane), pb = wave_incl_scan(lab, lane);
        const float totf = __shfl(pf, 63), totb = __shfl(pb, 63);
        const float sb = totb - pb + lab;
        if (!wdec) {
            oqf[dd] = qv[dd] * __expf(pf); okf[dd] = kv[dd] * __expf(-pf);
            oqb[dd] = qv[dd] * __expf(sb); okb[dd] = kv[dd] * __expf(-sb);
        } else {
            const float ksf = kv[dd] * __expf(totf - pf), ksb = kv[dd] * __expf(totb - sb);
            *(LAS bf16_t*)(lds + GL_KSF + (d * 72 + lane) * 2) = (bf16_t)(pk(ksf, 0.f) & 0xffffu);
            *(LAS bf16_t*)(lds + GL_KSB + (d * 72 + lane) * 2) = (bf16_t)(pk(ksb, 0.f) & 0xffffu);
            tsf = (lane == dd) ? totf : tsf; tsb = (lane == dd) ? totb : tsb;
        }
    }
    if (wdec && lane < 8) { DEC[((size_t)(c * 4 + h) * 2 + 0) * 64 + 8 * wid + lane] = __expf(tsf); DEC[((size_t)(c * 4 + h) * 2 + 1) * 64 + 8 * wid + lane] = __expf(tsb); }
    if (!wdec) { u32x4 w; const int off = (lane * 72 + 8 * wid) * 2;
      w.x = pk(oqf[0], oqf[1]); w.y = pk(oqf[2], oqf[3]); w.z = pk(oqf[4], oqf[5]); w.w = pk(oqf[6], oqf[7]); *(LAS u32x4*)(lds + GL_QF + off) = w;
      w.x = pk(okf[0], okf[1]); w.y = pk(okf[2], okf[3]); w.z = pk(okf[4], okf[5]); w.w = pk(okf[6], okf[7]); *(LAS u32x4*)(lds + GL_KF + off) = w;
      w.x = pk(oqb[0], oqb[1]); w.y = pk(oqb[2], oqb[3]); w.z = pk(oqb[4], oqb[5]); w.w = pk(oqb[6], oqb[7]); *(LAS u32x4*)(lds + GL_QB + off) = w;
      w.x = pk(okb[0], okb[1]); w.y = pk(okb[2], okb[3]); w.z = pk(okb[4], okb[5]); w.w = pk(okb[6], okb[7]); *(LAS u32x4*)(lds + GL_KB + off) = w; }
    { const int tp = tid >> 4, eg = tid & 15; const bf16_t* v0 = P + (size_t)(c * 64 + 2 * tp) * LDP + 1568 + h * 128 + 8 * eg;
      const u32x4 a = *(const u32x4*)v0, b = *(const u32x4*)(v0 + LDP); const unsigned wa[4] = {a.x, a.y, a.z, a.w}, wb[4] = {b.x, b.y, b.z, b.w};
      const int pcol = (4 * ((tp >> 2) ^ (eg & 7)) + (tp & 3)) * 4;
#pragma unroll
      for (int i = 0; i < 4; ++i) { *(LAS unsigned*)(lds + GL_VT + (8 * eg + 2 * i) * 144 + pcol) = (wa[i] & 0xffffu) | (wb[i] << 16);
                                    *(LAS unsigned*)(lds + GL_VT + (8 * eg + 2 * i + 1) * 144 + pcol) = (wa[i] >> 16) | (wb[i] & 0xffff0000u); } }
    __syncthreads();
}
__device__ __forceinline__ void gla_phaseA(LAS unsigned char* lds, const float* SMp, const bf16_t* P, bf16_t* ST, float* DEC) {
    const int tid = ltid(), wid = tid >> 6, lane = tid & 63, fr = lane & 15, fq = lane >> 4;
    gla_stage_w(lds, SMp);
    for (int it = lbid(); it < 1536 * 4; it += gridDim.x) {
        const int c = it >> 2, h = it & 3;
        gla_prep(lds, P, c, h, DEC, true);
        const int dir = wid >> 2, db = wid & 3; const int KS = dir ? GL_KSB : GL_KSF;
        bf16x8 a[2];
#pragma unroll
        for (int ks = 0; ks < 2; ++ks) a[ks] = *(const LAS bf16x8*)(lds + KS + ((16 * db + fr) * 72 + 32 * ks + 8 * fq) * 2);
        bf16_t* st = ST + ((size_t)(c * 4 + h) * 2 + dir) * 8192;
#pragma unroll
        for (int eb = 0; eb < 8; ++eb) { f32x4 acc = (f32x4){0.f, 0.f, 0.f, 0.f};
#pragma unroll
            for (int ks = 0; ks < 2; ++ks) { const int r = 16 * eb + fr; const bf16x8 b = *(const LAS bf16x8*)(lds + GL_VT + r * 144 + (((4 * ks + fq) ^ ((r >> 3) & 7)) * 16)); acc = MFMA16(a[ks], b, acc); }
            u32x2 w; w.x = pk(acc[0], acc[1]); w.y = pk(acc[2], acc[3]); *(u32x2*)(st + (16 * eb + fr) * 64 + 16 * db + 4 * fq) = w; }
        __syncthreads();
    }
}
__device__ __forceinline__ void gla_scan(bf16_t* ST, const float* DEC) {
    const int total = 32 * 8192;
    for (int tix = lbid() * 512 + ltid(); tix < total; tix += gridDim.x * 512) {
        const int piece = tix & 1023, dir = (tix >> 10) & 1, h = (tix >> 11) & 3, b = tix >> 13;
        const int N = b < 16 ? 32 : 64, c0 = b < 16 ? b * 32 : 512 + (b - 16) * 64, d0 = (piece & 7) * 8;
        float S[8];
#pragma unroll
        for (int i = 0; i < 8; ++i) S[i] = 0.f;
        for (int n = 0; n < N; n += 4) {
            u32x4 raw[4]; f32x4 e0[4], e1[4]; u32x4* ptr[4];
#pragma unroll
            for (int u = 0; u < 4; ++u) { const int c = dir ? c0 + N - 1 - (n + u) : c0 + n + u; const size_t base = (size_t)(c * 4 + h) * 2 + dir;
                ptr[u] = (u32x4*)(ST + base * 8192 + piece * 8); raw[u] = *ptr[u]; e0[u] = *(const f32x4*)(DEC + base * 64 + d0); e1[u] = *(const f32x4*)(DEC + base * 64 + d0 + 4); }
#pragma unroll
            for (int u = 0; u < 4; ++u) {
                u32x4 w; w.x = pk(S[0], S[1]); w.y = pk(S[2], S[3]); w.z = pk(S[4], S[5]); w.w = pk(S[6], S[7]); *ptr[u] = w;
                S[0] = e0[u][0] * S[0] + bflo(raw[u].x); S[1] = e0[u][1] * S[1] + bfhi(raw[u].x); S[2] = e0[u][2] * S[2] + bflo(raw[u].y); S[3] = e0[u][3] * S[3] + bfhi(raw[u].y);
                S[4] = e1[u][0] * S[4] + bflo(raw[u].z); S[5] = e1[u][1] * S[5] + bfhi(raw[u].z); S[6] = e1[u][2] * S[6] + bflo(raw[u].w); S[7] = e1[u][3] * S[7] + bfhi(raw[u].w); }
        }
    }
}
__device__ __forceinline__ void gla_phaseC(LAS unsigned char* lds, const float* SMp, bf16_t* P, const bf16_t* ST) {
    const int tid = ltid(), wid = tid >> 6, lane = tid & 63, fr = lane & 15, fq = lane >> 4;
    const float* gnorm = SMp + SM_GN;
    gla_stage_w(lds, SMp);
    for (int it = lbid(); it < 1536 * 4; it += gridDim.x) {
        const int c = it >> 2, h = it & 3;
        gla_prep(lds, P, c, h, nullptr, false);
        const int tb = wid & 3, eh = wid >> 2;
        f32x4 acc[4];
#pragma unroll
        for (int i = 0; i < 4; ++i) acc[i] = (f32x4){0.f, 0.f, 0.f, 0.f};
#pragma unroll
        for (int dir = 0; dir < 2; ++dir) {
            const int Qs = dir ? GL_QB : GL_QF, Ks = dir ? GL_KB : GL_KF;
            bf16x8 qf[2];
#pragma unroll
            for (int ks = 0; ks < 2; ++ks) qf[ks] = *(const LAS bf16x8*)(lds + Qs + ((16 * tb + fr) * 72 + 32 * ks + 8 * fq) * 2);
            f32x4 as[4];
#pragma unroll
            for (int sb = 0; sb < 4; ++sb) { as[sb] = (f32x4){0.f, 0.f, 0.f, 0.f};
#pragma unroll
                for (int ks = 0; ks < 2; ++ks) { const bf16x8 kf = *(const LAS bf16x8*)(lds + Ks + ((16 * sb + fr) * 72 + 32 * ks + 8 * fq) * 2); as[sb] = MFMA16(kf, qf[ks], as[sb]); }
#pragma unroll
                for (int j = 0; j < 4; ++j) { const int si = 16 * sb + 4 * fq + j, ti = 16 * tb + fr; const bool keep = dir ? (si > ti) : (si <= ti); as[sb][j] = keep ? as[sb][j] : 0.f; } }
            bf16x8 Pf[2]; Pf[0] = pack8(as[0], as[1]); Pf[1] = pack8(as[2], as[3]);
            const bf16_t* st = ST + ((size_t)(c * 4 + h) * 2 + dir) * 8192;
#pragma unroll
            for (int i = 0; i < 4; ++i) { const int e0 = 16 * (4 * eh + i) + fr;
#pragma unroll
                for (int cc = 0; cc < 2; ++cc) { const int sw = (e0 >> 3) & 7; const u32x2 lo = *(const LAS u32x2*)(lds + GL_VT + e0 * 144 + (((4 * cc + (fq >> 1)) ^ sw) * 16) + 8 * (fq & 1)), hi = *(const LAS u32x2*)(lds + GL_VT + e0 * 144 + (((4 * cc + 2 + (fq >> 1)) ^ sw) * 16) + 8 * (fq & 1));
                    acc[i] = MFMA16(mk8(lo, hi), Pf[cc], acc[i]); }
#pragma unroll
                for (int ks = 0; ks < 2; ++ks) { const bf16x8 sf = *(const bf16x8*)(st + e0 * 64 + 32 * ks + 8 * fq); acc[i] = MFMA16(sf, qf[ks], acc[i]); } }
        }
        float ss = 0.f;
#pragma unroll
        for (int i = 0; i < 4; ++i) ss += (acc[i][0] * acc[i][0] + acc[i][1] * acc[i][1]) + (acc[i][2] * acc[i][2] + acc[i][3] * acc[i][3]);
        ss += __shfl_xor(ss, 16); ss += __shfl_xor(ss, 32);
        LAS float* red = (LAS float*)(lds + GL_RED);
        if (fq == 0) red[eh * 64 + 16 * tb + fr] = ss;
        __syncthreads();
        const float tot = red[16 * tb + fr] + red[64 + 16 * tb + fr];
        const float rs = rsqrtf(tot * (1.0f / 128.0f) + 1e-6f);
        const int row = c * 64 + 16 * tb + fr; bf16_t* prow = P + (size_t)row * LDP;
#pragma unroll
        for (int i = 0; i < 4; ++i) { const int e = 16 * (4 * eh + i) + 4 * fq; const f32x4 g = *(const f32x4*)(gnorm + e); const u32x2 rr = *(const u32x2*)(prow + 2080 + h * 128 + e);
            const float o0 = acc[i][0] * rs * g[0] * silu(bflo(rr.x)), o1 = acc[i][1] * rs * g[1] * silu(bfhi(rr.x)), o2 = acc[i][2] * rs * g[2] * silu(bflo(rr.y)), o3 = acc[i][3] * rs * g[3] * silu(bfhi(rr.y));
            u32x2 w; w.x = pk(o0, o1); w.y = pk(o2, o3); *(u32x2*)(prow + 512 + h * 128 + e) = w; }
        __syncthreads();
    }
}

__device__ __forceinline__ void sgu_phase(LAS unsigned char* lds, bf16_t* V, const f32x2* STATS, const float* lng, const float* lnb, const bf16_t* Ws, const float* bs) {
    const int tid = ltid(), wid = tid >> 6, lane = tid & 63, fr = lane & 15, fq = lane >> 4;
    LAS float* MU = (LAS float*)(lds + 104448); LAS float* RS = (LAS float*)(lds + 104960);
    for (int unit = lbid(); unit < 6144; unit += gridDim.x) {
        const int ck = unit >> 3, g = unit & 7, cbase = g * 384, row0 = ck * 128;
        const int t0 = 16 * wid;
        bf16x8 Wf[4];
#pragma unroll
        for (int ks = 0; ks < 4; ++ks) Wf[ks] = *(const bf16x8*)(Ws + (size_t)(g * 128 + t0 + fr) * 128 + 32 * ks + 8 * fq);
        const float bias = bs[g * 128 + t0 + fr];
        if (tid < 128) { const f32x4* sp = (const f32x4*)(STATS + (size_t)(row0 + tid) * 48); float s1 = 0.f, s2 = 0.f;
#pragma unroll
            for (int i = 0; i < 24; ++i) { const f32x4 v = sp[i]; s1 += v[0] + v[2]; s2 += v[1] + v[3]; }
            const float mean = s1 * (1.0f / 3072.0f), var = s2 * (1.0f / 3072.0f) - mean * mean; MU[tid] = mean; RS[tid] = rsqrtf(fmaxf(var, 0.f) + 1e-5f); }
        __syncthreads();
#pragma unroll
        for (int i = 0; i < 6; ++i) { const int id = tid + 512 * i, rest = id >> 6, cg = (rest % 6) * 8 + (id & 7), tp = (rest / 6) * 8 + ((id >> 3) & 7); const int c = cbase + 8 * cg, r0 = row0 + 2 * tp;
            const int pcol = (4 * ((tp >> 2) ^ (cg & 7)) + (tp & 3)) * 4;
            const u32x4 a = *(const u32x4*)(V + (size_t)r0 * SH + c), b = *(const u32x4*)(V + (size_t)(r0 + 1) * SH + c);
            const f32x4 g0 = *(const f32x4*)(lng + c), g1 = *(const f32x4*)(lng + c + 4), b0 = *(const f32x4*)(lnb + c), b1 = *(const f32x4*)(lnb + c + 4);
            const float mu0 = MU[2 * tp], rs0 = RS[2 * tp], mu1 = MU[2 * tp + 1], rs1 = RS[2 * tp + 1];
            const unsigned wa[4] = {a.x, a.y, a.z, a.w}, wb[4] = {b.x, b.y, b.z, b.w}; const float gg[8] = {g0[0], g0[1], g0[2], g0[3], g1[0], g1[1], g1[2], g1[3]}, bb[8] = {b0[0], b0[1], b0[2], b0[3], b1[0], b1[1], b1[2], b1[3]};
#pragma unroll
            for (int e = 0; e < 4; ++e) {
                const float x0 = (bflo(wa[e]) - mu0) * rs0 * gg[2 * e] + bb[2 * e], x1 = (bflo(wb[e]) - mu1) * rs1 * gg[2 * e] + bb[2 * e];
                const float y0 = (bfhi(wa[e]) - mu0) * rs0 * gg[2 * e + 1] + bb[2 * e + 1], y1 = (bfhi(wb[e]) - mu1) * rs1 * gg[2 * e + 1] + bb[2 * e + 1];
                *(LAS unsigned*)(lds + (8 * cg + 2 * e) * 272 + pcol) = pk(x0, x1); *(LAS unsigned*)(lds + (8 * cg + 2 * e + 1) * 272 + pcol) = pk(y0, y1); } }
        __syncthreads();
        bf16_t* orow = V + (size_t)(row0 + t0 + fr) * SH + cbase + 4 * fq;
#pragma unroll
        for (int cb = 0; cb < 24; ++cb) { f32x4 acc = (f32x4){0.f, 0.f, 0.f, 0.f};
#pragma unroll
            for (int ks = 0; ks < 4; ++ks) { const int r = 16 * cb + fr; const bf16x8 a = *(const LAS bf16x8*)(lds + r * 272 + (((4 * ks + fq) ^ ((r >> 3) & 7)) * 16)); acc = MFMA16(a, Wf[ks], acc); }
            u32x2 w; w.x = pk(acc[0] + bias, acc[1] + bias); w.y = pk(acc[2] + bias, acc[3] + bias); *(u32x2*)(orow + 16 * cb) = w; }
        __syncthreads();
    }
}

#define ON(k) (((PM) >> (k)) & 1)
enum { K_G1 = 0, K_G2, K_LN, K_G3, K_G45, K_ATT, K_GLAC, K_MIX0, K_G7, K_SGU, K_G8, K_MIX1, K_G5A, K_G5B, K_GLAA };
constexpr int NSTEPS = 20;
__device__ __forceinline__ void step_info(int st, int& kind, int& arg, bool& sync) {
    sync = true;
    switch (st) {
        case 0: kind = K_G1; arg = 0; break; case 1: kind = K_G2; arg = 0; break;
        case 2: kind = K_G3; arg = 0; break;
        case 3: kind = K_G45; arg = 0; sync = false; break; case 4: kind = K_G5A; arg = 0; sync = false; break; case 5: kind = K_G5B; arg = 0; sync = false; break; case 6: kind = K_GLAA; arg = 0; break;
        case 7: kind = K_ATT; arg = 0; break; case 8: kind = K_GLAC; arg = 0; break; case 9: kind = K_MIX0; arg = 0; break;
        case 10: kind = K_G1; arg = 1; break; case 11: kind = K_G2; arg = 1; break;
        case 12: kind = K_G1; arg = 2; break; case 13: kind = K_G2; arg = 2; break;
        case 14: kind = K_G7; arg = 0; break; case 15: kind = K_SGU; arg = 0; break; case 16: kind = K_G8; arg = 0; break; case 17: kind = K_MIX1; arg = 0; break;
        case 18: kind = K_G1; arg = 3; break; default: kind = K_G2; arg = 3; break;
    }
}

__device__ __forceinline__ void grid_barrier(unsigned* bar, unsigned target) {
    asm volatile("s_waitcnt vmcnt(0) lgkmcnt(0)" ::: "memory");
    __syncthreads();
    if (threadIdx.x == 0) {
        __builtin_amdgcn_fence(__ATOMIC_RELEASE, "agent");
        asm volatile("s_waitcnt vmcnt(0)" ::: "memory");
        __hip_atomic_fetch_add(bar, 1u, __ATOMIC_RELAXED, __HIP_MEMORY_SCOPE_AGENT);
        while (__hip_atomic_load(bar, __ATOMIC_RELAXED, __HIP_MEMORY_SCOPE_AGENT) < target) __builtin_amdgcn_s_sleep(1);
        __builtin_amdgcn_fence(__ATOMIC_ACQUIRE, "agent");
        asm volatile("s_waitcnt vmcnt(0)" ::: "memory");
    }
    __syncthreads();
}
#define GSYNC(base) do { ++nbar; grid_barrier((unsigned*)((base) + WS_BAR), nbar * gridDim.x); } while (0)
__global__ void __launch_bounds__(512, 2) mega(Params p) {
    extern __shared__ __attribute__((aligned(16))) unsigned char shm[];
    LAS unsigned char* lds = (LAS unsigned char*)shm;
    cg::grid_group grid = cg::this_grid();
    if (ON(15)) phase0(lds, p);
    unsigned nbar = 0;
    grid.sync(); __builtin_amdgcn_fence(__ATOMIC_ACQUIRE, "agent"); asm volatile("s_waitcnt vmcnt(0)" ::: "memory");
#pragma unroll 1
    for (int st = 0; st < NSTEPS; ++st) {
        size_t zoff = 0; asm volatile("" : "+s"(zoff));
        unsigned char* ws = p.ws + zoff; unsigned char* dout = (unsigned char*)p.out + zoff;
        bf16_t* XB = (bf16_t*)(ws + WS_XB); bf16_t* R = (bf16_t*)(ws + WS_R); float* PRE = (float*)dout;
        bf16_t* ST = (bf16_t*)(ws + WS_ST); float* DEC = (float*)(ws + WS_DEC); float* SSQ = (float*)(ws + WS_SSQ); f32x2* STATS = (f32x2*)(ws + WS_STATS);
        bf16_t* Qb = (bf16_t*)(dout + DO_Q); bf16_t* KN = (bf16_t*)(dout + DO_KN); bf16_t* VT = (bf16_t*)(dout + DO_VT); bf16_t* KR = (bf16_t*)(dout + DO_KR);
        const f32x2* ROPE = (const f32x2*)(ws + WS_ROPE); const float* SMp = (const float*)(ws + WS_SMALL);
        int kind, arg; bool dosync; step_info(st, kind, arg, dosync);
        switch (kind) {
            case K_G1: if (ON(K_G1)) { EpiSwiglu E; E.H = R; const int rep = ((DUP & 4) && arg == 0) ? 2 : 1; for (int rr = 0; rr < rep; ++rr) run_gemm(lds, XB, DM, (const bf16_t*)(ws + WS_FFN + (size_t)arg * 17301504), DM, MTOK, 2 * FH, DM, E); } break;
            case K_G2: case K_MIX0: case K_MIX1: if (ON(K_G2)) { EpiLn E;
                const bf16_t* Bt; int lda, K, inst; float cs;
                if (kind == K_G2) { Bt = (const bf16_t*)(ws + WS_FFN + (size_t)arg * 17301504 + 11534336); lda = FH; K = FH; cs = 0.5f; inst = arg == 0 ? 0 : arg == 1 ? 2 : arg == 2 ? 3 : 5; }
                else if (kind == K_MIX0) { Bt = (const bf16_t*)(ws + WS_WOUT); lda = LDP; K = DM; cs = 1.0f; inst = 1; }
                else { Bt = (const bf16_t*)(ws + WS_SOUT); lda = SH; K = SH; cs = 1.0f; inst = 4; }
                E.XB = XB; E.X32 = PRE; E.res32 = inst != 1; E.last = inst == 5; E.G = SMp + SM_LN + inst * 2048; E.B = E.G + 1024; E.cs = cs;
                E.SLOT = (unsigned long long*)(ws + WS_SLOT); E.CNT = (unsigned*)(ws + WS_CNT) + (size_t)inst * 384 * 2 * 16;
                run_gemm(lds, R, lda, Bt, K, MTOK, DM, K, E); } break;
            case K_G3: if (ON(K_G3)) { EpiWin E; E.P = R; E.SSQ = SSQ; run_gemm(lds, XB, DM, (const bf16_t*)(ws + WS_WIN), DM, MTOK, 2816, DM, E); } break;
            case K_G45: if (ON(K_G45)) { kr_pass(R, ROPE, KR);
                EpiQ E; E.Q = Qb; E.SSQ = SSQ; E.ROPE = ROPE; run_gemm(lds, R, LDP, (const bf16_t*)(ws + WS_UQ), 768, MTOK, 768, 768, E); } break;
            case K_G5A: if (ON(K_G5A)) { EpiKN E; E.KN = KN; E.SSQ = SSQ; run_gemm(lds, R + 768, LDP, (const bf16_t*)(ws + WS_UKN), 256, MTOK, 512, 256, E); } break;
            case K_G5B: if (ON(K_G5B)) { EpiVT E; E.VT = VT; E.SSQ = SSQ; run_gemm(lds, (const bf16_t*)(ws + WS_UV), 256, R + 768, LDP, 512, MTOK, 256, E); } break;
            case K_GLAA: if (ON(K_GLAA)) { __syncthreads(); gla_phaseA(lds, SMp, R, ST, DEC); if (DUP & 2) gla_phaseA(lds, SMp, R, ST, DEC); } break;
            case K_ATT: if (ON(K_ATT)) { attn_phase(lds, Qb, KN, KR, VT, R); if (DUP & 1) { __syncthreads(); attn_phase(lds, Qb, KN, KR, VT, R); } gla_scan(ST, DEC); } break;
            case K_GLAC: if (ON(K_GLAC)) { gla_phaseC(lds, SMp, R, ST); if (DUP & 2) gla_phaseC(lds, SMp, R, ST); } break;
            case K_G7: if (ON(K_G7)) { EpiSguV E; E.V = R; E.STATS = STATS; run_gemm(lds, XB, DM, (const bf16_t*)(ws + WS_SIN) + (size_t)SH * DM, DM, MTOK, SH, DM, E); } break;
            case K_SGU: if (ON(K_SGU)) { sgu_phase(lds, R, STATS, SMp + SM_LNG, SMp + SM_LNB, (const bf16_t*)(ws + WS_WS), SMp + SM_BS); } break;
            case K_G8: if (ON(K_G8)) { EpiSguU E; E.V = R; run_gemm(lds, XB, DM, (const bf16_t*)(ws + WS_SIN), DM, MTOK, SH, DM, E); } break;
            default: break;
        }
        if (dosync) GSYNC(ws);
    }
}

constexpr int LDS_BYTES = 131072;
extern "C" void kernel_launch(void* const* d_in, const int* in_sizes, int n_in, void* d_out, int out_size, void* d_ws, size_t ws_size, hipStream_t stream) {
    static int grid_blocks = 0;
    if (!grid_blocks) {
        int dev = 0, cus = 0, per_cu = 0;
        (void)hipGetDevice(&dev);
        (void)hipDeviceGetAttribute(&cus, hipDeviceAttributeMultiprocessorCount, dev);
        (void)hipFuncSetAttribute((const void*)mega, hipFuncAttributeMaxDynamicSharedMemorySize, LDS_BYTES);
        (void)hipOccupancyMaxActiveBlocksPerMultiprocessor(&per_cu, (const void*)mega, 512, LDS_BYTES);
        if (per_cu < 1) per_cu = 1;
        grid_blocks = cus * per_cu;
        if (grid_blocks > 256) grid_blocks = 256;
    }
    Params p{};
    for (int i = 0; i < 39; ++i) p.in[i] = (const float*)d_in[i];
    p.out = (float*)d_out; p.ws = (unsigned char*)d_ws;
    (void)hipMemsetAsync((char*)d_ws + WS_BAR, 0, BAR_ZERO_BYTES, stream);
    void* args[] = {&p};
    hipError_t e = hipLaunchCooperativeKernel((const void*)mega, dim3(grid_blocks), dim3(512), args, LDS_BYTES, stream);
    if (e != hipSuccess) fprintf(stderr, "cooperative launch failed: %s (grid %d)\n", hipGetErrorString(e), grid_blocks);
}
```

```cpp
#include <hip/hip_runtime.h>
#include <hip/hip_cooperative_groups.h>
#include <cstdio>
namespace cg = cooperative_groups;

#define LAS __attribute__((address_space(3)))
typedef unsigned short bf16_t;
typedef short bf16x8 __attribute__((ext_vector_type(8)));
typedef float f32x4 __attribute__((ext_vector_type(4)));
typedef float f32x2 __attribute__((ext_vector_type(2)));
typedef unsigned u32x4 __attribute__((ext_vector_type(4)));
typedef unsigned u32x2 __attribute__((ext_vector_type(2)));

#ifndef PM
#define PM 0xFFFF
#endif
#ifndef DUP
#define DUP 0
#endif
constexpr int MTOK = 98304, NPROMPT = 32768, DM = 1024, FH = 2816, LDP = 2624, SH = 3072;
constexpr size_t MiB = 1048576;
constexpr size_t WS_FFN = 0;
constexpr size_t WS_WIN = 66 * MiB;
constexpr size_t WS_UQ = WS_WIN + 5767168;
constexpr size_t WS_UKN = WS_UQ + 1179648;
constexpr size_t WS_UV = WS_UKN + 262144;
constexpr size_t WS_WOUT = WS_UV + 262144;
constexpr size_t WS_SIN = WS_WOUT + 2097152;
constexpr size_t WS_SOUT = WS_SIN + 12582912;
constexpr size_t WS_WS = WS_SOUT + 6291456;
constexpr size_t WS_ROPE = WS_WS + 262144;
constexpr size_t WS_SMALL = WS_ROPE + 524288;
constexpr int SM_LN = 0, SM_WGF = 12288, SM_BGF = 16384, SM_WGB = 16640, SM_BGB = 20736, SM_GN = 20992, SM_LNG = 21120, SM_LNB = 24192, SM_BS = 27264;
constexpr size_t WS_XB = 96 * MiB;
constexpr size_t WS_R = 288 * MiB;
constexpr size_t WS_ST = 780 * MiB;
constexpr size_t WS_DEC = 972 * MiB;
constexpr size_t WS_SSQ = 976 * MiB;
constexpr size_t WS_STATS = 864 * MiB;
constexpr size_t WS_BAR = 983 * MiB;
constexpr size_t WS_CNT = WS_BAR + 4096;
constexpr size_t BAR_ZERO_BYTES = 4096 + 6 * 384 * 2 * 64;
constexpr size_t WS_SLOT = 984 * MiB;
constexpr size_t DO_Q = 0, DO_KN = 144 * MiB, DO_VT = 240 * MiB, DO_KR = 336 * MiB;

struct Params { const float* in[39]; float* out; unsigned char* ws; };

__device__ __forceinline__ int ltid() { int t = threadIdx.x; asm volatile("" : "+v"(t)); return t; }
__device__ __forceinline__ int lbid() { int t = blockIdx.x; asm volatile("" : "+s"(t)); return t; }
__device__ __forceinline__ float bflo(unsigned w) { return __uint_as_float(w << 16); }
__device__ __forceinline__ float bfhi(unsigned w) { return __uint_as_float(w & 0xffff0000u); }
typedef __bf16 bf16v2 __attribute__((ext_vector_type(2)));
__device__ __forceinline__ unsigned pk(float lo, float hi) { const f32x2 v = {lo, hi}; const bf16v2 b = __builtin_convertvector(v, bf16v2); return __builtin_bit_cast(unsigned, b); }
__device__ __forceinline__ float fexp2(float x) { return __builtin_amdgcn_exp2f(x); }
__device__ __forceinline__ float frcp(float x) { return __builtin_amdgcn_rcpf(x); }
__device__ __forceinline__ float silu(float x) { return x * frcp(1.0f + fexp2(-1.4426950408889634f * x)); }
__device__ __forceinline__ f32x2 gelu_pk(f32x2 v) {
    const f32x2 av = __builtin_elementwise_abs(v), d = av * 0.2316418882f + 1.0f;
    f32x2 t; t.x = frcp(d.x); t.y = frcp(d.y);
    f32x2 q = t * 0.5307027145f + (-0.7265760135f); q = q * t + 0.7107068705f; q = q * t + (-0.142248368f); q = q * t + 0.127414796f; q = q * t;
    const f32x2 s = (v * v) * (-0.72134752044f);
    f32x2 e; e.x = fexp2(s.x); e.y = fexp2(s.y);
    const f32x2 m = v * (q * e), r = v - m;
    f32x2 o; o.x = v.x < 0.f ? m.x : r.x; o.y = v.y < 0.f ? m.y : r.y; return o;
}
__device__ __forceinline__ f32x4 gelu4(f32x4 v) { f32x2 a = gelu_pk((f32x2){v[0], v[1]}), b = gelu_pk((f32x2){v[2], v[3]}); return (f32x4){a.x, a.y, b.x, b.y}; }
__device__ __forceinline__ int tok_pos(int row) { return row < NPROMPT ? (row & 2047) : (row & 4095); }

namespace pg8 {
constexpr int BM = 256, BK = 64, HALF = 128, HTB = HALF * BK * 2, STAGE_BYTES = 8 * HTB, NXCD = 8, WGM = 8;
__device__ __forceinline__ int lds_byte(int r, int c) { const int st = (r >> 4) * 2 + (c >> 5), rr = r & 15, cc = c & 31, ob = rr * 64 + cc * 2; return st * 1024 + (ob ^ (((ob >> 9) & 1) << 5)); }
__device__ __forceinline__ void stage_rc(int b, int& R, int& C) { const int st = b / 1024, sb = b % 1024, swz = sb ^ (((sb >> 9) & 1) << 5); R = (st >> 1) * 16 + swz / 64; C = (st & 1) * 32 + (swz % 64) / 2; }
__device__ __forceinline__ int perm32(int rho) { const int n = rho >> 4, i = rho & 15; return 8 * (i >> 2) + 4 * n + (i & 3); }
struct Unit { int pm, pn; };
struct Gemm { const bf16_t* A; const bf16_t* Bt; int lda, ldb, M, N, K; };
struct StaticOrder {
    int nM, nN, nwg, G, c;
    __device__ void init(int M, int N, int G_, int c_) { nM = M / BM; nN = N / BM; nwg = nM * nN; G = G_; c = c_; }
    __device__ bool next(int i, Unit& u) const {
        const long L = (long)i * G + c; if (L >= nwg) return false;
        int wgid = (int)L; { const int q = nwg / NXCD, r = nwg % NXCD, xcd = wgid % NXCD, off = wgid / NXCD; wgid = (xcd < r ? xcd * (q + 1) : r * (q + 1) + (xcd - r) * q) + off; }
        const int nig = WGM * nN, gid = wgid / nig, fm = gid * WGM, gsz = (nM - fm) < WGM ? (nM - fm) : WGM;
        u.pm = fm + ((wgid % nig) % gsz); u.pn = (wgid % nig) / gsz; return true;
    }
};
template <class Epi>
__device__ __forceinline__ void gemm_phase(LAS unsigned char* lds, const Gemm g, const StaticOrder& S, const Epi& E) {
    const int tid = ltid(), wid = __builtin_amdgcn_readfirstlane(tid >> 6), lane = tid & 63, wr = wid >> 2, wc = wid & 3, fr = lane & 15, fq = lane >> 4;
    int K = g.K, lda = g.lda, ldb = g.ldb; asm volatile("" : "+s"(K), "+s"(lda), "+s"(ldb));
    const int nt = K / BK;
    unsigned voffA[2], voffB[2];
#pragma unroll
    for (int i = 0; i < 2; ++i) { int R, C; stage_rc(tid * 16 + i * 8192, R, C); const int Rb = Epi::PERM ? ((R & ~31) + perm32(R & 31)) : R;
        voffA[i] = (unsigned)(R * lda + C) * 2u; voffB[i] = (unsigned)(Rb * ldb + C) * 2u; }
    const size_t kstep = (size_t)(BK * 2);
    const size_t hstepA = (size_t)HALF * lda * 2, hstepB = (size_t)HALF * ldb * 2;
    const size_t tstepA = 2 * hstepA, tstepB = 2 * hstepB;
    const unsigned ldsw = (unsigned)wid * 1024u;
    const int aoff = lds_byte(wr * 64 + fr, fq * 8), boff = lds_byte(wc * 32 + fr, fq * 8);
#define PG8_SA(b, h) (((b) * 2 + (h)) * HTB)
#define PG8_SB(b, h) ((4 + (b) * 2 + (h)) * HTB)
#define PG8_STAGE(bufoff, gbase, voff) do { _Pragma("unroll") for (int _i = 0; _i < 2; ++_i) \
        __builtin_amdgcn_global_load_lds((const unsigned*)((const char*)(gbase) + (voff)[_i]), (LAS unsigned*)(lds + (bufoff) + ldsw + _i * 8192), 16, 0, 0); } while (0)
#define PG8_LDA(dst, b, h) do { _Pragma("unroll") for (int m = 0; m < 4; ++m) _Pragma("unroll") for (int k = 0; k < 2; ++k) dst[m][k] = *(const LAS bf16x8*)(lds + PG8_SA(b, h) + aoff + m * 2048 + k * 1024); } while (0)
#define PG8_LDB(dst, b, h) do { _Pragma("unroll") for (int n = 0; n < 2; ++n) _Pragma("unroll") for (int k = 0; k < 2; ++k) dst[n][k] = *(const LAS bf16x8*)(lds + PG8_SB(b, h) + boff + n * 2048 + k * 1024); } while (0)
#define PG8_MMA(ai, bj, At, Bt) do { __builtin_amdgcn_s_setprio(1); _Pragma("unroll") for (int m = 0; m < 4; ++m) _Pragma("unroll") for (int n = 0; n < 2; ++n) _Pragma("unroll") for (int k = 0; k < 2; ++k) \
        acc[ai][bj][m][n] = __builtin_amdgcn_mfma_f32_16x16x32_bf16(Bt[n][k], At[m][k], acc[ai][bj][m][n], 0, 0, 0); __builtin_amdgcn_s_setprio(0); } while (0)
#define PG8_WAIT_V(n) asm volatile("s_waitcnt vmcnt(" #n ")" ::: "memory")
#define PG8_WAIT_L(n) asm volatile("s_waitcnt lgkmcnt(" #n ")" ::: "memory")
#define PG8_BAR __builtin_amdgcn_s_barrier()
#define PG8_SCHED __builtin_amdgcn_sched_barrier(0)
    Unit cur, nxt; int ui = 0;
    if (!S.next(0, cur)) return;
    f32x4 acc[2][2][4][2];
#pragma unroll
    for (int a = 0; a < 2; ++a)
#pragma unroll
        for (int b = 0; b < 2; ++b)
#pragma unroll
            for (int m = 0; m < 4; ++m)
#pragma unroll
                for (int n = 0; n < 2; ++n) acc[a][b][m][n] = (f32x4){0.f, 0.f, 0.f, 0.f};
    bf16x8 At[4][2], B0[2][2], B1[2][2];
    const char* cA = (const char*)g.A + (size_t)cur.pm * tstepA; const char* cB = (const char*)g.Bt + (size_t)cur.pn * tstepB;
    PG8_STAGE(PG8_SB(0, 0), cB, voffB); PG8_STAGE(PG8_SA(0, 0), cA, voffA); PG8_STAGE(PG8_SB(0, 1), cB + hstepB, voffB); PG8_STAGE(PG8_SA(0, 1), cA + hstepA, voffA);
    if (wr == 1) PG8_BAR;
    PG8_WAIT_V(4); PG8_BAR;
    PG8_STAGE(PG8_SB(1, 0), cB + kstep, voffB); PG8_STAGE(PG8_SA(1, 0), cA + kstep, voffA); PG8_STAGE(PG8_SB(1, 1), cB + hstepB + kstep, voffB);
    PG8_WAIT_V(6); PG8_BAR;
    for (;;) {
        const bool has_next = S.next(ui + 1, nxt);
        const char* nA = has_next ? (const char*)g.A + (size_t)nxt.pm * tstepA : cA; const char* nB = has_next ? (const char*)g.Bt + (size_t)nxt.pn * tstepB : cB;
        for (int t = 0; t < nt; t += 2) {
            const bool last = (t == nt - 2);
            const char* a1 = cA + (size_t)(t + 1) * kstep;
            const char* a2 = last ? nA : cA + (size_t)(t + 2) * kstep; const char* b2 = last ? nB : cB + (size_t)(t + 2) * kstep;
            const char* a3 = a2 + kstep; const char* b3 = b2 + kstep;
            PG8_LDB(B0, 0, 0); PG8_SCHED; PG8_LDA(At, 0, 0); PG8_STAGE(PG8_SA(1, 1), a1 + hstepA, voffA);
            PG8_WAIT_L(8); PG8_BAR; PG8_WAIT_L(0); PG8_MMA(0, 0, At, B0); PG8_BAR; PG8_SCHED;
            PG8_LDB(B1, 0, 1); PG8_STAGE(PG8_SB(0, 0), b2, voffB);
            PG8_BAR; PG8_WAIT_L(0); PG8_MMA(0, 1, At, B1); PG8_BAR;
            PG8_LDA(At, 0, 1); PG8_STAGE(PG8_SA(0, 0), a2, voffA);
            PG8_BAR; PG8_WAIT_L(0); PG8_MMA(1, 0, At, B0); PG8_BAR; PG8_SCHED;
            PG8_STAGE(PG8_SB(0, 1), b2 + hstepB, voffB);
            PG8_WAIT_V(6); PG8_BAR; PG8_MMA(1, 1, At, B1); PG8_BAR;
            PG8_LDB(B0, 1, 0); PG8_SCHED; PG8_LDA(At, 1, 0); PG8_STAGE(PG8_SA(0, 1), a2 + hstepA, voffA);
            PG8_WAIT_L(8); PG8_BAR; PG8_WAIT_L(0); PG8_MMA(0, 0, At, B0); PG8_BAR; PG8_SCHED;
            PG8_LDB(B1, 1, 1); PG8_STAGE(PG8_SB(1, 0), b3, voffB);
            PG8_BAR; PG8_WAIT_L(0); PG8_MMA(0, 1, At, B1); PG8_BAR;
            PG8_LDA(At, 1, 1); PG8_STAGE(PG8_SA(1, 0), a3, voffA);
            PG8_BAR; PG8_WAIT_L(0); PG8_MMA(1, 0, At, B0); PG8_BAR; PG8_SCHED;
            PG8_STAGE(PG8_SB(1, 1), b3 + hstepB, voffB);
            PG8_WAIT_V(6); PG8_BAR; PG8_MMA(1, 1, At, B1); PG8_BAR;
        }
        E(acc, cur, wr, wc, fr, fq);
        if (!has_next) break;
#pragma unroll
        for (int a = 0; a < 2; ++a)
#pragma unroll
            for (int b = 0; b < 2; ++b)
#pragma unroll
                for (int m = 0; m < 4; ++m)
#pragma unroll
                    for (int n = 0; n < 2; ++n) acc[a][b][m][n] = (f32x4){0.f, 0.f, 0.f, 0.f};
        cur = nxt; cA = nA; cB = nB; ++ui;
    }
    PG8_WAIT_V(0);
    if (wr == 0) PG8_BAR;
    PG8_BAR;
#undef PG8_SA
#undef PG8_SB
#undef PG8_STAGE
#undef PG8_LDA
#undef PG8_LDB
#undef PG8_MMA
#undef PG8_WAIT_V
#undef PG8_WAIT_L
#undef PG8_BAR
#undef PG8_SCHED
}
}
using pg8::Unit;
typedef f32x4 AccT[2][2][4][2];

struct EpiSwiglu {
    static constexpr bool PERM = true; bf16_t* H;
    __device__ __forceinline__ void operator()(const AccT& acc, const Unit& u, int wr, int wc, int fr, int fq) const {
        const int row0 = u.pm * 256 + wr * 64 + fr, col0 = u.pn * 128 + wc * 32 + 8 * fq;
#pragma unroll
        for (int ai = 0; ai < 2; ++ai)
#pragma unroll
            for (int m = 0; m < 4; ++m) { const f32x4 g0 = acc[ai][0][m][0], g1 = acc[ai][0][m][1], u0 = acc[ai][1][m][0], u1 = acc[ai][1][m][1];
                u32x4 w; w.x = pk(silu(g0[0]) * u0[0], silu(g0[1]) * u0[1]); w.y = pk(silu(g0[2]) * u0[2], silu(g0[3]) * u0[3]);
                w.z = pk(silu(g1[0]) * u1[0], silu(g1[1]) * u1[1]); w.w = pk(silu(g1[2]) * u1[2], silu(g1[3]) * u1[3]);
                *(u32x4*)(H + (size_t)(row0 + ai * 128 + m * 16) * FH + col0) = w; }
    }
};
struct EpiPre {
    static constexpr bool PERM = false; const bf16_t* XB; float* PRE; float cs;
    __device__ __forceinline__ void operator()(const AccT& acc, const Unit& u, int wr, int wc, int fr, int fq) const {
        const int row0 = u.pm * 256 + wr * 64 + fr, col0 = u.pn * 256 + wc * 32 + 4 * fq;
#pragma unroll
        for (int ai = 0; ai < 2; ++ai)
#pragma unroll
            for (int m = 0; m < 4; ++m) { const size_t ro = (size_t)(row0 + ai * 128 + m * 16) * DM + col0;
#pragma unroll
                for (int bj = 0; bj < 2; ++bj)
#pragma unroll
                    for (int n = 0; n < 2; ++n) { const u32x2 xw = *(const u32x2*)(XB + ro + bj * 128 + n * 16); const f32x4 a = acc[ai][bj][m][n];
                        f32x4 o; o[0] = 1.41421356237f * bflo(xw.x) + cs * a[0]; o[1] = 1.41421356237f * bfhi(xw.x) + cs * a[1]; o[2] = 1.41421356237f * bflo(xw.y) + cs * a[2]; o[3] = 1.41421356237f * bfhi(xw.y) + cs * a[3];
                        *(f32x4*)(PRE + ro + bj * 128 + n * 16) = o; } }
    }
};
struct EpiLn {
    static constexpr bool PERM = true; bf16_t* XB; float* OUTF; const float* G; const float* B; float cs; unsigned long long* SLOT; unsigned* CNT;
    __device__ __forceinline__ void operator()(AccT& acc, const Unit& u, int wr, int wc, int fr, int fq) const {
        const int row0 = u.pm * 256 + wr * 64 + fr, col0 = u.pn * 256 + wc * 32 + 8 * fq; const float AL = 1.41421356237f;
#pragma unroll
        for (int ai = 0; ai < 2; ++ai) {
            u32x4 xw[4][2];
#pragma unroll
            for (int m = 0; m < 4; ++m)
#pragma unroll
                for (int bj = 0; bj < 2; ++bj) xw[m][bj] = *(const u32x4*)(XB + (size_t)(row0 + ai * 128 + m * 16) * DM + col0 + bj * 128);
#pragma unroll
            for (int m = 0; m < 4; ++m) { const int row = row0 + ai * 128 + m * 16; float s1 = 0.f, s2 = 0.f;
#pragma unroll
                for (int bj = 0; bj < 2; ++bj) { const u32x4 x = xw[m][bj]; const f32x4 a0 = acc[ai][bj][m][0], a1 = acc[ai][bj][m][1]; f32x4 v0, v1;
                    v0[0] = AL * bflo(x.x) + cs * a0[0]; v0[1] = AL * bfhi(x.x) + cs * a0[1]; v0[2] = AL * bflo(x.y) + cs * a0[2]; v0[3] = AL * bfhi(x.y) + cs * a0[3];
                    v1[0] = AL * bflo(x.z) + cs * a1[0]; v1[1] = AL * bfhi(x.z) + cs * a1[1]; v1[2] = AL * bflo(x.w) + cs * a1[2]; v1[3] = AL * bfhi(x.w) + cs * a1[3];
                    acc[ai][bj][m][0] = v0; acc[ai][bj][m][1] = v1;
                    s1 += ((v0[0] + v0[1]) + (v0[2] + v0[3])) + ((v1[0] + v1[1]) + (v1[2] + v1[3]));
                    s2 += (v0[0] * v0[0] + v0[1] * v0[1]) + (v0[2] * v0[2] + v0[3] * v0[3]) + (v1[0] * v1[0] + v1[1] * v1[1]) + (v1[2] * v1[2] + v1[3] * v1[3]); }
                s1 += __shfl_xor(s1, 16); s1 += __shfl_xor(s1, 32); s2 += __shfl_xor(s2, 16); s2 += __shfl_xor(s2, 32);
                if (fq == 0) __hip_atomic_store(SLOT + (size_t)row * 16 + u.pn * 4 + wc, ((unsigned long long)__float_as_uint(s2) << 32) | (unsigned long long)__float_as_uint(s1), __ATOMIC_RELAXED, __HIP_MEMORY_SCOPE_AGENT); }
            asm volatile("" ::: "memory");
        }
        asm volatile("s_waitcnt vmcnt(0)" ::: "memory");
        unsigned* cnt = CNT + ((size_t)u.pm * 2 + wr) * 16;
        if ((fr | fq) == 0) __hip_atomic_fetch_add(cnt, 1u, __ATOMIC_RELAXED, __HIP_MEMORY_SCOPE_AGENT);
        while ((unsigned)__builtin_amdgcn_readfirstlane((int)__hip_atomic_load(cnt, __ATOMIC_RELAXED, __HIP_MEMORY_SCOPE_AGENT)) < 16u) __builtin_amdgcn_s_sleep(1);
        __builtin_amdgcn_fence(__ATOMIC_ACQUIRE, "workgroup"); asm volatile("" ::: "memory");
        f32x4 gv[2][2], bv[2][2];
#pragma unroll
        for (int bt = 0; bt < 3; ++bt) { const int rb = bt * 3, nr = bt == 2 ? 2 : 3;
            unsigned long long sw[3][4];
#pragma unroll
            for (int k = 0; k < 3; ++k) if (k < nr) { const int r8 = rb + k; const unsigned long long* sp = SLOT + (size_t)(row0 + (r8 >> 2) * 128 + (r8 & 3) * 16) * 16 + 4 * fq;
#pragma unroll
                for (int i = 0; i < 4; ++i) sw[k][i] = __hip_atomic_load(sp + i, __ATOMIC_RELAXED, __HIP_MEMORY_SCOPE_AGENT); }
            if (bt == 0) {
#pragma unroll
                for (int bj = 0; bj < 2; ++bj)
#pragma unroll
                    for (int n = 0; n < 2; ++n) { gv[bj][n] = *(const f32x4*)(G + col0 + bj * 128 + 4 * n); bv[bj][n] = *(const f32x4*)(B + col0 + bj * 128 + 4 * n); } }
#pragma unroll
            for (int k = 0; k < 3; ++k) if (k < nr) { const int r8 = rb + k, ai = r8 >> 2, m = r8 & 3; const int row = row0 + ai * 128 + m * 16; float t1 = 0.f, t2 = 0.f;
#pragma unroll
                for (int i = 0; i < 4; ++i) { const unsigned long long w = sw[k][i]; t1 += __uint_as_float((unsigned)w); t2 += __uint_as_float((unsigned)(w >> 32)); }
                t1 += __shfl_xor(t1, 16); t1 += __shfl_xor(t1, 32); t2 += __shfl_xor(t2, 16); t2 += __shfl_xor(t2, 32);
                const float mean = t1 * (1.0f / 1024.0f), var = t2 * (1.0f / 1024.0f) - mean * mean, rstd = rsqrtf(fmaxf(var, 0.f) + 1e-5f);
#pragma unroll
                for (int bj = 0; bj < 2; ++bj) { const f32x4 y0 = (acc[ai][bj][m][0] - mean) * rstd * gv[bj][0] + bv[bj][0], y1 = (acc[ai][bj][m][1] - mean) * rstd * gv[bj][1] + bv[bj][1];
                    if (OUTF) { *(f32x4*)(OUTF + (size_t)row * DM + col0 + bj * 128) = y0; *(f32x4*)(OUTF + (size_t)row * DM + col0 + bj * 128 + 4) = y1; }
                    else { u32x4 w; w.x = pk(y0[0], y0[1]); w.y = pk(y0[2], y0[3]); w.z = pk(y1[0], y1[1]); w.w = pk(y1[2], y1[3]); *(u32x4*)(XB + (size_t)row * DM + col0 + bj * 128) = w; } } }
            asm volatile("" ::: "memory");
        }
    }
};
struct EpiWin {
    static constexpr bool PERM = true; bf16_t* P; float* SSQ;
    __device__ __forceinline__ void operator()(const AccT& acc, const Unit& u, int wr, int wc, int fr, int fq) const {
        const int row0 = u.pm * 256 + wr * 64 + fr, col0 = u.pn * 256 + wc * 32 + 8 * fq;
#pragma unroll
        for (int ai = 0; ai < 2; ++ai)
#pragma unroll
            for (int m = 0; m < 4; ++m) { const int row = row0 + ai * 128 + m * 16; float s = 0.f;
#pragma unroll
                for (int bj = 0; bj < 2; ++bj) { f32x4 v0 = acc[ai][bj][m][0], v1 = acc[ai][bj][m][1]; const int c = col0 + bj * 128;
                    s += (v0[0] * v0[0] + v0[1] * v0[1]) + (v0[2] * v0[2] + v0[3] * v0[3]) + (v1[0] * v1[0] + v1[1] * v1[1]) + (v1[2] * v1[2] + v1[3] * v1[3]);
                    if (c < LDP) { u32x4 w; w.x = pk(v0[0], v0[1]); w.y = pk(v0[2], v0[3]); w.z = pk(v1[0], v1[1]); w.w = pk(v1[2], v1[3]); *(u32x4*)(P + (size_t)row * LDP + c) = w; } }
                if (u.pn < 4) { s += __shfl_xor(s, 16); s += __shfl_xor(s, 32); if (fq == 0) SSQ[(size_t)row * 16 + u.pn * 4 + wc] = s; } }
    }
};
struct EpiQ {
    static constexpr bool PERM = false; bf16_t* Q; const float* SSQ; const f32x2* ROPE;
    __device__ __forceinline__ void operator()(const AccT& acc, const Unit& u, int wr, int wc, int fr, int fq) const {
        const int row0 = u.pm * 256 + wr * 64 + fr; const float QS = 0.10206207261596577f * 1.4426950408889634f;
#pragma unroll
        for (int ai = 0; ai < 2; ++ai)
#pragma unroll
            for (int m = 0; m < 4; ++m) { const int row = row0 + ai * 128 + m * 16;
                const f32x4 s0 = *(const f32x4*)(SSQ + (size_t)row * 16), s1 = *(const f32x4*)(SSQ + (size_t)row * 16 + 4), s2 = *(const f32x4*)(SSQ + (size_t)row * 16 + 8);
                const float ss = ((s0[0] + s0[1]) + (s0[2] + s0[3])) + ((s1[0] + s1[1]) + (s1[2] + s1[3])) + ((s2[0] + s2[1]) + (s2[2] + s2[3]));
                const float rs = rsqrtf(ss * (1.0f / 768.0f) + 1e-6f) * QS; const int pos = tok_pos(row);
#pragma unroll
                for (int bj = 0; bj < 2; ++bj) { const int cg = u.pn * 256 + bj * 128 + wc * 32; f32x4 a0 = acc[ai][bj][m][0] * rs, a1 = acc[ai][bj][m][1] * rs;
                    if ((cg % 96) == 64) { const f32x4 t0 = *(const f32x4*)(ROPE + (size_t)pos * 16 + 4 * fq), t1 = *(const f32x4*)(ROPE + (size_t)pos * 16 + 4 * fq + 2);
                        const float cs[4] = {t0[0], t0[2], t1[0], t1[2]}, sn[4] = {t0[1], t0[3], t1[1], t1[3]}; f32x4 o0, o1;
#pragma unroll
                        for (int j = 0; j < 4; ++j) { o0[j] = a0[j] * cs[j] - a1[j] * sn[j]; o1[j] = a0[j] * sn[j] + a1[j] * cs[j]; }
                        a0 = o0; a1 = o1; }
                    u32x2 w0, w1; w0.x = pk(a0[0], a0[1]); w0.y = pk(a0[2], a0[3]); w1.x = pk(a1[0], a1[1]); w1.y = pk(a1[2], a1[3]);
                    *(u32x2*)(Q + (size_t)row * 768 + cg + 4 * fq) = w0; *(u32x2*)(Q + (size_t)row * 768 + cg + 16 + 4 * fq) = w1; }
                asm volatile("" ::: "memory"); }
    }
};
struct EpiKN {
    static constexpr bool PERM = true; bf16_t* KN; const float* SSQ;
    __device__ __forceinline__ void operator()(const AccT& acc, const Unit& u, int wr, int wc, int fr, int fq) const {
        const int row0 = u.pm * 256 + wr * 64 + fr, col0 = u.pn * 256 + wc * 32 + 8 * fq;
#pragma unroll
        for (int ai = 0; ai < 2; ++ai)
#pragma unroll
            for (int m = 0; m < 4; ++m) { const int row = row0 + ai * 128 + m * 16; const f32x4 s3 = *(const f32x4*)(SSQ + (size_t)row * 16 + 12);
                const float rs = rsqrtf(((s3[0] + s3[1]) + (s3[2] + s3[3])) * (1.0f / 256.0f) + 1e-6f);
#pragma unroll
                for (int bj = 0; bj < 2; ++bj) { const f32x4 v0 = acc[ai][bj][m][0] * rs, v1 = acc[ai][bj][m][1] * rs;
                    u32x4 w; w.x = pk(v0[0], v0[1]); w.y = pk(v0[2], v0[3]); w.z = pk(v1[0], v1[1]); w.w = pk(v1[2], v1[3]); *(u32x4*)(KN + (size_t)row * 512 + col0 + bj * 128) = w; }
                asm volatile("" ::: "memory"); }
    }
};
struct EpiVT {
    static constexpr bool PERM = true; bf16_t* VT; const float* SSQ;
    __device__ __forceinline__ void operator()(const AccT& acc, const Unit& u, int wr, int wc, int fr, int fq) const {
        const int f0 = u.pm * 256 + wr * 64 + fr, tok0 = u.pn * 256 + wc * 32 + 8 * fq;
#pragma unroll
        for (int bj = 0; bj < 2; ++bj) {
            float rs[8];
#pragma unroll
            for (int i = 0; i < 8; ++i) { const f32x4 s3 = *(const f32x4*)(SSQ + (size_t)(tok0 + bj * 128 + i) * 16 + 12); rs[i] = rsqrtf(((s3[0] + s3[1]) + (s3[2] + s3[3])) * (1.0f / 256.0f) + 1e-6f); }
            asm volatile("" ::: "memory");
#pragma unroll
            for (int ai = 0; ai < 2; ++ai)
#pragma unroll
                for (int m = 0; m < 4; ++m) { const int f = f0 + ai * 128 + m * 16; const f32x4 v0 = acc[ai][bj][m][0], v1 = acc[ai][bj][m][1];
                    u32x4 w; w.x = pk(v0[0] * rs[0], v0[1] * rs[1]); w.y = pk(v0[2] * rs[2], v0[3] * rs[3]); w.z = pk(v1[0] * rs[4], v1[1] * rs[5]); w.w = pk(v1[2] * rs[6], v1[3] * rs[7]);
                    *(u32x4*)(VT + (size_t)f * MTOK + tok0 + bj * 128) = w; }
            asm volatile("" ::: "memory");
        }
    }
};
struct EpiSguV {
    static constexpr bool PERM = true; bf16_t* V; f32x2* STATS;
    __device__ __forceinline__ void operator()(const AccT& acc, const Unit& u, int wr, int wc, int fr, int fq) const {
        const int row0 = u.pm * 256 + wr * 64 + fr, col0 = u.pn * 256 + wc * 32 + 8 * fq;
#pragma unroll
        for (int ai = 0; ai < 2; ++ai)
#pragma unroll
            for (int m = 0; m < 4; ++m) { const int row = row0 + ai * 128 + m * 16; float s1 = 0.f, s2 = 0.f;
#pragma unroll
                for (int bj = 0; bj < 2; ++bj) { const f32x4 v0 = gelu4(acc[ai][bj][m][0]), v1 = gelu4(acc[ai][bj][m][1]);
                    s1 += ((v0[0] + v0[1]) + (v0[2] + v0[3])) + ((v1[0] + v1[1]) + (v1[2] + v1[3]));
                    s2 += (v0[0] * v0[0] + v0[1] * v0[1]) + (v0[2] * v0[2] + v0[3] * v0[3]) + (v1[0] * v1[0] + v1[1] * v1[1]) + (v1[2] * v1[2] + v1[3] * v1[3]);
                    u32x4 w; w.x = pk(v0[0], v0[1]); w.y = pk(v0[2], v0[3]); w.z = pk(v1[0], v1[1]); w.w = pk(v1[2], v1[3]); *(u32x4*)(V + (size_t)row * SH + col0 + bj * 128) = w; }
                s1 += __shfl_xor(s1, 16); s1 += __shfl_xor(s1, 32); s2 += __shfl_xor(s2, 16); s2 += __shfl_xor(s2, 32);
                if (fq == 0) STATS[(size_t)row * 48 + u.pn * 4 + wc] = (f32x2){s1, s2}; }
    }
};
struct EpiSguU {
    static constexpr bool PERM = true; bf16_t* V;
    __device__ __forceinline__ void operator()(const AccT& acc, const Unit& u, int wr, int wc, int fr, int fq) const {
        const int row0 = u.pm * 256 + wr * 64 + fr, col0 = u.pn * 256 + wc * 32 + 8 * fq;
#pragma unroll
        for (int ai = 0; ai < 2; ++ai)
#pragma unroll
            for (int m = 0; m < 4; ++m) { const int row = row0 + ai * 128 + m * 16;
#pragma unroll
                for (int bj = 0; bj < 2; ++bj) { bf16_t* ptr = V + (size_t)row * SH + col0 + bj * 128; const u32x4 vv = *(const u32x4*)ptr;
                    const f32x4 v0 = gelu4(acc[ai][bj][m][0]), v1 = gelu4(acc[ai][bj][m][1]);
                    u32x4 w; w.x = pk(v0[0] * bflo(vv.x), v0[1] * bfhi(vv.x)); w.y = pk(v0[2] * bflo(vv.y), v0[3] * bfhi(vv.y)); w.z = pk(v1[0] * bflo(vv.z), v1[1] * bfhi(vv.z)); w.w = pk(v1[2] * bflo(vv.w), v1[3] * bfhi(vv.w));
                    *(u32x4*)ptr = w; } }
    }
};

template <class Epi> __device__ __forceinline__ void run_gemm(LAS unsigned char* lds, const bf16_t* A, int lda, const bf16_t* Bt, int ldb, int M, int N, int K, const Epi& E) {
    pg8::Gemm g; g.A = A; g.Bt = Bt; g.lda = lda; g.ldb = ldb; g.M = M; g.N = N; g.K = K;
    pg8::StaticOrder S; S.init(M, N, (int)gridDim.x, lbid());
    pg8::gemm_phase<Epi>(lds, g, S, E);
}

__device__ __forceinline__ int mapcol(int mode, int nd) {
    switch (mode) {
        case 1: { const int t = nd >> 8, w = nd & 255; return (w >= 128 ? FH : 0) + t * 128 + (w & 127); }
        case 2: return nd < LDP ? nd : -1;
        case 3: return (nd >> 6) * 128 + (nd & 63);
        case 4: return (nd >> 6) * 128 + 64 + (nd & 63);
        default: return nd;
    }
}
__device__ __forceinline__ void convert_T(LAS unsigned char* lds, const float* src, int ldsrc, int K, int Ndst, bf16_t* dst, int mode, const float* kscale) {
    LAS float* tile = (LAS float*)lds;
    const int tid = ltid(), ntk = K / 64, ntn = Ndst / 256;
    for (int idx = lbid(); idx < ntk * ntn; idx += gridDim.x) {
        const int tk = idx % ntk, tn = idx / ntk;
        const int r0 = tid >> 6, c4 = (tid & 63) * 4; const int ns = mapcol(mode, tn * 256 + c4);
        f32x4 v[8];
#pragma unroll
        for (int i = 0; i < 8; ++i) { const int k = tk * 64 + r0 + 8 * i; v[i] = (f32x4){0.f, 0.f, 0.f, 0.f}; if (ns >= 0) v[i] = *(const f32x4*)(src + (size_t)k * ldsrc + ns); if (kscale) v[i] = v[i] * kscale[k]; }
#pragma unroll
        for (int i = 0; i < 8; ++i) *(LAS f32x4*)(tile + (r0 + 8 * i) * 260 + c4) = v[i];
        __syncthreads();
        const int n = tid >> 1, kh = (tid & 1) * 32;
#pragma unroll
        for (int q = 0; q < 4; ++q) { float x[8];
#pragma unroll
            for (int i = 0; i < 8; ++i) x[i] = tile[(kh + 8 * q + i) * 260 + n];
            u32x4 w; w.x = pk(x[0], x[1]); w.y = pk(x[2], x[3]); w.z = pk(x[4], x[5]); w.w = pk(x[6], x[7]);
            *(u32x4*)(dst + (size_t)(tn * 256 + n) * K + tk * 64 + kh + 8 * q) = w; }
        __syncthreads();
    }
}
#define PIN(k) (p.in[lidx(k)])
__device__ __forceinline__ int lidx(int k) { asm volatile("" : "+s"(k)); return k; }
__device__ __forceinline__ void copyf(float* dst, const float* src, size_t n, size_t gt, size_t nth) { if (gt < n) dst[gt] = src[gt]; }
__device__ __forceinline__ void phase0(LAS unsigned char* lds, const Params& p) {
    unsigned char* ws = p.ws;
    const size_t gt = (size_t)lbid() * 512 + ltid(), nth = (size_t)gridDim.x * 512;
    { bf16_t* XB = (bf16_t*)(ws + WS_XB); const size_t n4 = (size_t)MTOK * DM / 4, np4 = (size_t)NPROMPT * DM / 4; const f32x4* xp = (const f32x4*)PIN(0); const f32x4* xs = (const f32x4*)PIN(1);
      size_t i = gt;
      for (; i + 3 * nth < n4; i += 4 * nth) { f32x4 v[4];
#pragma unroll
          for (int u = 0; u < 4; ++u) { const size_t j = i + u * nth; v[u] = j < np4 ? xp[j] : xs[j - np4]; }
#pragma unroll
          for (int u = 0; u < 4; ++u) { u32x2 w; w.x = pk(v[u][0], v[u][1]); w.y = pk(v[u][2], v[u][3]); ((u32x2*)XB)[i + u * nth] = w; } }
      for (; i < n4; i += nth) { const f32x4 v = i < np4 ? xp[i] : xs[i - np4]; u32x2 w; w.x = pk(v[0], v[1]); w.y = pk(v[2], v[3]); ((u32x2*)XB)[i] = w; } }
    { unsigned* z = (unsigned*)(ws + WS_BAR); for (size_t i = gt; i < BAR_ZERO_BYTES / 4; i += nth) z[i] = 0u; }
    { bf16_t* W = (bf16_t*)(ws + WS_WS); const float* wsrc = PIN(30); for (size_t i = gt; i < 8 * 128 * 128 / 2; i += nth) { ((unsigned*)W)[i] = pk(wsrc[2 * i], wsrc[2 * i + 1]); }
      f32x2* R = (f32x2*)(ws + WS_ROPE); for (size_t i = gt; i < 4096 * 16; i += nth) { const int pos = (int)(i >> 4), j = (int)(i & 15);
          const float inv = 1.0f / powf(10000.0f, (float)(2 * j) / 32.0f); const float ang = (float)pos * inv; R[i] = (f32x2){cosf(ang), sinf(ang)}; } }
    { float* SMp = (float*)(ws + WS_SMALL);
#pragma unroll 1
      for (int k = 0; k < 6; ++k) { const int gi = k == 0 ? 4 : k == 1 ? 17 : k == 2 ? 21 : k == 3 ? 25 : k == 4 ? 33 : 37; copyf(SMp + SM_LN + k * 2048, PIN(gi), 1024, gt, nth); copyf(SMp + SM_LN + k * 2048 + 1024, PIN(gi + 1), 1024, gt, nth); }
      copyf(SMp + SM_WGF, PIN(11), 4096, gt, nth); copyf(SMp + SM_WGB, PIN(13), 4096, gt, nth); copyf(SMp + SM_BGF, PIN(12), 256, gt, nth); copyf(SMp + SM_BGB, PIN(14), 256, gt, nth);
      copyf(SMp + SM_GN, PIN(15), 128, gt, nth); copyf(SMp + SM_LNG, PIN(28), 3072, gt, nth); copyf(SMp + SM_LNB, PIN(29), 3072, gt, nth); copyf(SMp + SM_BS, PIN(31), 1024, gt, nth); }
#pragma unroll 1
    for (int f = 0; f < 4; ++f) { const int gi = f == 0 ? 2 : f == 1 ? 19 : f == 2 ? 23 : 35;
        convert_T(lds, PIN(gi), 2 * FH, DM, 2 * FH, (bf16_t*)(ws + WS_FFN + (size_t)f * 17301504), 1, nullptr);
        convert_T(lds, PIN(gi + 1), DM, FH, DM, (bf16_t*)(ws + WS_FFN + (size_t)f * 17301504 + 11534336), 0, nullptr);
    }
    convert_T(lds, PIN(6), LDP, DM, 2816, (bf16_t*)(ws + WS_WIN), 2, nullptr);
    convert_T(lds, PIN(8), 768, 768, 768, (bf16_t*)(ws + WS_UQ), 0, PIN(7));
    convert_T(lds, PIN(10), 1024, 256, 512, (bf16_t*)(ws + WS_UKN), 3, PIN(9));
    convert_T(lds, PIN(10), 1024, 256, 512, (bf16_t*)(ws + WS_UV), 4, PIN(9));
    convert_T(lds, PIN(16), DM, DM, DM, (bf16_t*)(ws + WS_WOUT), 0, nullptr);
    convert_T(lds, PIN(27), 2 * SH, DM, 2 * SH, (bf16_t*)(ws + WS_SIN), 0, nullptr);
    convert_T(lds, PIN(32), DM, SH, DM, (bf16_t*)(ws + WS_SOUT), 0, nullptr);
}

__device__ __forceinline__ void ln_phase(const float* pre, const float* g, const float* b, bf16_t* xb, float* outf) {
    const int wid = ltid() >> 6, lane = ltid() & 63;
    f32x4 gv[4], bv[4];
#pragma unroll
    for (int i = 0; i < 4; ++i) { gv[i] = *(const f32x4*)(g + 4 * lane + 256 * i); bv[i] = *(const f32x4*)(b + 4 * lane + 256 * i); }
    const int nw = gridDim.x * 8;
    for (int row = lbid() * 8 + wid; row < MTOK; row += 2 * nw) {
        const int row2 = row + nw; const bool has2 = row2 < MTOK;
        const float* pr = pre + (size_t)row * DM; const float* pr2 = pre + (size_t)(has2 ? row2 : row) * DM; f32x4 v[4], w[4]; float s = 0.f, s2 = 0.f;
#pragma unroll
        for (int i = 0; i < 4; ++i) { v[i] = *(const f32x4*)(pr + 4 * lane + 256 * i); w[i] = *(const f32x4*)(pr2 + 4 * lane + 256 * i); }
#pragma unroll
        for (int i = 0; i < 4; ++i) { s += (v[i][0] + v[i][1]) + (v[i][2] + v[i][3]); s2 += (w[i][0] + w[i][1]) + (w[i][2] + w[i][3]); }
#pragma unroll
        for (int o = 32; o >= 1; o >>= 1) { s += __shfl_xor(s, o); s2 += __shfl_xor(s2, o); }
        const float mean = s * (1.0f / 1024.0f), mean2 = s2 * (1.0f / 1024.0f); float q = 0.f, q2 = 0.f;
#pragma unroll
        for (int i = 0; i < 4; ++i) { v[i] = v[i] - mean; q += (v[i][0] * v[i][0] + v[i][1] * v[i][1]) + (v[i][2] * v[i][2] + v[i][3] * v[i][3]);
                                      w[i] = w[i] - mean2; q2 += (w[i][0] * w[i][0] + w[i][1] * w[i][1]) + (w[i][2] * w[i][2] + w[i][3] * w[i][3]); }
#pragma unroll
        for (int o = 32; o >= 1; o >>= 1) { q += __shfl_xor(q, o); q2 += __shfl_xor(q2, o); }
        const float rstd = rsqrtf(q * (1.0f / 1024.0f) + 1e-5f), rstd2 = rsqrtf(q2 * (1.0f / 1024.0f) + 1e-5f);
#pragma unroll
        for (int i = 0; i < 4; ++i) { const f32x4 y = v[i] * rstd * gv[i] + bv[i];
            if (xb) { u32x2 t; t.x = pk(y[0], y[1]); t.y = pk(y[2], y[3]); *(u32x2*)(xb + (size_t)row * DM + 4 * lane + 256 * i) = t; }
            if (outf) *(f32x4*)(outf + (size_t)row * DM + 4 * lane + 256 * i) = y; }
        if (has2) {
#pragma unroll
            for (int i = 0; i < 4; ++i) { const f32x4 y = w[i] * rstd2 * gv[i] + bv[i];
                if (xb) { u32x2 t; t.x = pk(y[0], y[1]); t.y = pk(y[2], y[3]); *(u32x2*)(xb + (size_t)row2 * DM + 4 * lane + 256 * i) = t; }
                if (outf) *(f32x4*)(outf + (size_t)row2 * DM + 4 * lane + 256 * i) = y; } }
    }
}

__device__ __forceinline__ void kr_pass(const bf16_t* P, const f32x2* ROPE, bf16_t* KR) {
    const size_t gt = (size_t)lbid() * 512 + ltid(), nth = (size_t)gridDim.x * 512;
    for (size_t i = gt; i < (size_t)MTOK * 16; i += nth) { const int row = (int)(i >> 4), j = (int)(i & 15); const int pos = tok_pos(row);
        const bf16_t* pr = P + (size_t)row * LDP + 1024; const float x1 = bflo((unsigned)pr[j]), x2 = bflo((unsigned)pr[j + 16]); const f32x2 cs = ROPE[(size_t)pos * 16 + j];
        KR[(size_t)row * 32 + j] = (bf16_t)(pk(x1 * cs.x - x2 * cs.y, 0.f) & 0xffffu); KR[(size_t)row * 32 + 16 + j] = (bf16_t)(pk(x1 * cs.y + x2 * cs.x, 0.f) & 0xffffu); }
}

#define MFMA16(a, b, c) __builtin_amdgcn_mfma_f32_16x16x32_bf16((a), (b), (c), 0, 0, 0)
__device__ __forceinline__ bf16x8 mk8(u32x2 lo, u32x2 hi) { u32x4 w; w.x = lo.x; w.y = lo.y; w.z = hi.x; w.w = hi.y; return __builtin_bit_cast(bf16x8, w); }
__device__ __forceinline__ bf16x8 pack8(f32x4 a, f32x4 b) { u32x4 w; w.x = pk(a[0], a[1]); w.y = pk(a[2], a[3]); w.z = pk(b[0], b[1]); w.w = pk(b[2], b[3]); return __builtin_bit_cast(bf16x8, w); }

__device__ __forceinline__ void attn_phase(LAS unsigned char* lds, const bf16_t* Q, const bf16_t* KN, const bf16_t* KR, const bf16_t* VT, bf16_t* O) {
    const int tid = ltid(), wid = tid >> 6, lane = tid & 63, fr = lane & 15, fq = lane >> 4;
    const int G = gridDim.x; const int L = (G % 8 == 0) ? ((lbid() & 7) * (G >> 3) + (lbid() >> 3)) : lbid();
    constexpr int KBYTES = 128 * 208, BUF = KBYTES + 64 * 272;
    for (int it = L; it < 3072; it += G) {
        int h, S, row0, qb;
        if (it < 2048) { const int pair = it >> 4; qb = it & 15; h = pair & 7; S = 4096; row0 = NPROMPT + (pair >> 3) * 4096; }
        else { const int j = it - 2048, pair = j >> 3; qb = j & 7; h = pair & 7; S = 2048; row0 = (pair >> 3) * 2048; }
        const int qrow0 = row0 + qb * 256 + wid * 32;
        bf16x8 Qf[2][3];
#pragma unroll
        for (int qf = 0; qf < 2; ++qf)
#pragma unroll
            for (int ks = 0; ks < 3; ++ks) Qf[qf][ks] = *(const bf16x8*)(Q + (size_t)(qrow0 + 16 * qf + fr) * 768 + h * 96 + 32 * ks + 8 * fq);
        f32x4 Oacc[2][4];
#pragma unroll
        for (int qf = 0; qf < 2; ++qf)
#pragma unroll
            for (int nb = 0; nb < 4; ++nb) Oacc[qf][nb] = (f32x4){0.f, 0.f, 0.f, 0.f};
        float mi[2] = {-1e30f, -1e30f}, li[2] = {0.f, 0.f};
        const int nt = S / 128;
        const bf16_t* ksrc[3]; int kstep[3], kdst[3]; const bf16_t* vsrc[2]; int vdst[2];
#pragma unroll
        for (int i = 0; i < 3; ++i) { const int pp = tid + 512 * i, key = pp / 12, part = pp % 12;
            ksrc[i] = part < 8 ? KN + (size_t)(row0 + key) * 512 + h * 64 + part * 8 : KR + (size_t)(row0 + key) * 32 + (part - 8) * 8;
            kstep[i] = part < 8 ? 128 * 512 : 128 * 32; kdst[i] = key * 208 + part * 16; }
#pragma unroll
        for (int i = 0; i < 2; ++i) { const int pp = tid + 512 * i, dv = pp >> 4, seg = pp & 15;
            vsrc[i] = VT + (size_t)(h * 64 + dv) * MTOK + row0 + seg * 8; vdst[i] = KBYTES + dv * 272 + seg * 16; }
        u32x4 rk[3], rv[2];
#pragma unroll
        for (int i = 0; i < 3; ++i) rk[i] = *(const u32x4*)ksrc[i];
#pragma unroll
        for (int i = 0; i < 2; ++i) rv[i] = *(const u32x4*)vsrc[i];
#pragma unroll
        for (int i = 0; i < 3; ++i) *(LAS u32x4*)(lds + kdst[i]) = rk[i];
#pragma unroll
        for (int i = 0; i < 2; ++i) *(LAS u32x4*)(lds + vdst[i]) = rv[i];
        __syncthreads();
        for (int t = 0; t < nt; ++t) {
            const bool pf = (t + 1 < nt);
            if (pf) {
#pragma unroll
                for (int i = 0; i < 3; ++i) rk[i] = *(const u32x4*)(ksrc[i] + (size_t)(t + 1) * kstep[i]);
#pragma unroll
                for (int i = 0; i < 2; ++i) rv[i] = *(const u32x4*)(vsrc[i] + (size_t)(t + 1) * 128);
            }
#pragma unroll 1
            for (int sub = 0; sub < 2; ++sub) {
                LAS unsigned char* kb_ = lds + (t & 1) * BUF + sub * (64 * 208); LAS unsigned char* vb_ = lds + (t & 1) * BUF + KBYTES + sub * 128;
                bf16x8 Pf[2][2];
                {
                    bf16x8 Kf[4][3];
#pragma unroll
                    for (int kb = 0; kb < 4; ++kb)
#pragma unroll
                        for (int ks = 0; ks < 3; ++ks) Kf[kb][ks] = *(const LAS bf16x8*)(kb_ + (16 * kb + fr) * 208 + (32 * ks + 8 * fq) * 2);
#pragma unroll
                    for (int qf = 0; qf < 2; ++qf) {
                        f32x4 s[4];
#pragma unroll
                        for (int kb = 0; kb < 4; ++kb) { s[kb] = (f32x4){0.f, 0.f, 0.f, 0.f};
#pragma unroll
                            for (int ks = 0; ks < 3; ++ks) s[kb] = MFMA16(Kf[kb][ks], Qf[qf][ks], s[kb]); }
                        float mx = -1e30f;
#pragma unroll
                        for (int kb = 0; kb < 4; ++kb) mx = fmaxf(mx, fmaxf(fmaxf(s[kb][0], s[kb][1]), fmaxf(s[kb][2], s[kb][3])));
                        mx = fmaxf(mx, __shfl_xor(mx, 16)); mx = fmaxf(mx, __shfl_xor(mx, 32));
                        const float mn = fmaxf(mi[qf], mx), al = fexp2(mi[qf] - mn); mi[qf] = mn;
                        float ps = 0.f;
#pragma unroll
                        for (int kb = 0; kb < 4; ++kb)
#pragma unroll
                            for (int j = 0; j < 4; ++j) { const float pv = fexp2(s[kb][j] - mn); s[kb][j] = pv; ps += pv; }
                        li[qf] = li[qf] * al + ps;
#pragma unroll
                        for (int nb = 0; nb < 4; ++nb) Oacc[qf][nb] = Oacc[qf][nb] * al;
                        Pf[qf][0] = pack8(s[0], s[1]); Pf[qf][1] = pack8(s[2], s[3]);
                    }
                }
#pragma unroll
                for (int nb = 0; nb < 4; ++nb)
#pragma unroll
                    for (int c = 0; c < 2; ++c) {
                        const u32x2 lo = *(const LAS u32x2*)(vb_ + (16 * nb + fr) * 272 + (32 * c + 4 * fq) * 2), hi = *(const LAS u32x2*)(vb_ + (16 * nb + fr) * 272 + (32 * c + 16 + 4 * fq) * 2);
                        const bf16x8 Vf = mk8(lo, hi);
#pragma unroll
                        for (int qf = 0; qf < 2; ++qf) Oacc[qf][nb] = MFMA16(Vf, Pf[qf][c], Oacc[qf][nb]);
                    }
            }
            if (pf) { LAS unsigned char* nb_ = lds + ((t + 1) & 1) * BUF;
#pragma unroll
                for (int i = 0; i < 3; ++i) *(LAS u32x4*)(nb_ + kdst[i]) = rk[i];
#pragma unroll
                for (int i = 0; i < 2; ++i) *(LAS u32x4*)(nb_ + vdst[i]) = rv[i]; }
            __syncthreads();
        }
#pragma unroll
        for (int qf = 0; qf < 2; ++qf) { float l = li[qf]; l += __shfl_xor(l, 16); l += __shfl_xor(l, 32); const float inv = 1.0f / l; const int row = qrow0 + 16 * qf + fr;
#pragma unroll
            for (int nb = 0; nb < 4; ++nb) { const f32x4 o = Oacc[qf][nb] * inv; u32x2 w; w.x = pk(o[0], o[1]); w.y = pk(o[2], o[3]); *(u32x2*)(O + (size_t)row * LDP + h * 64 + 16 * nb + 4 * fq) = w; } }
    }
}

constexpr int GL_QF = 0, GL_KF = 9216, GL_QB = 18432, GL_KB = 27648, GL_KSF = 36864, GL_KSB = 46080, GL_VT = 55296, GL_RED = 73728;
constexpr int GL_W = 74752;
__device__ __forceinline__ void gla_stage_w(LAS unsigned char* lds, const float* SMp) {
    const int tid = ltid(); LAS float* w = (LAS float*)(lds + GL_W);
    for (int i = tid; i < 4096; i += 512) { w[i] = SMp[SM_WGF + i]; w[4096 + i] = SMp[SM_WGB + i]; }
    if (tid < 256) { w[8192 + tid] = SMp[SM_BGF + tid]; w[8448 + tid] = SMp[SM_BGB + tid]; }
    __syncthreads();
}
__device__ __forceinline__ float dpp_add(float x, float v, const int ctrl, const int row_mask) {
    return x; }
#define DPP_STEP(x, ctrl, rmask) x = x + __int_as_float(__builtin_amdgcn_update_dpp(0, __float_as_int(x), ctrl, rmask, 0xf, false))
__device__ __forceinline__ float wave_incl_scan(float x, int lane) {
    DPP_STEP(x, 0x111, 0xf); DPP_STEP(x, 0x112, 0xf); DPP_STEP(x, 0x114, 0xf); DPP_STEP(x, 0x118, 0xf);
    DPP_STEP(x, 0x142, 0xa); DPP_STEP(x, 0x143, 0xc);
    return x;
}
__device__ __forceinline__ float logsig(float x) { return fminf(x, 0.f) - __logf(1.0f + __expf(-fabsf(x))); }
__device__ __forceinline__ void gla_prep(LAS unsigned char* lds, const bf16_t* P, int c, int h, float* DEC, bool wdec) {
    const int tid = ltid(), wid = tid >> 6, lane = tid & 63;
    const bf16_t* prow = P + (size_t)(c * 64 + lane) * LDP;
    float zf[16], zb[16];
    { const u32x4 a = *(const u32x4*)(prow + 2592), b = *(const u32x4*)(prow + 2600), c2 = *(const u32x4*)(prow + 2608), d = *(const u32x4*)(prow + 2616);
      const unsigned wa[8] = {a.x, a.y, a.z, a.w, b.x, b.y, b.z, b.w}, wb[8] = {c2.x, c2.y, c2.z, c2.w, d.x, d.y, d.z, d.w};
#pragma unroll
      for (int i = 0; i < 8; ++i) { zf[2 * i] = bflo(wa[i]); zf[2 * i + 1] = bfhi(wa[i]); zb[2 * i] = bflo(wb[i]); zb[2 * i + 1] = bfhi(wb[i]); } }
    float qv[8], kv[8];
    { const u32x4 a = *(const u32x4*)(prow + 1056 + h * 64 + 8 * wid), b = *(const u32x4*)(prow + 1312 + h * 64 + 8 * wid);
      const unsigned wa[4] = {a.x, a.y, a.z, a.w}, wb[4] = {b.x, b.y, b.z, b.w};
#pragma unroll
      for (int i = 0; i < 4; ++i) { qv[2 * i] = bflo(wa[i]) * 0.125f; qv[2 * i + 1] = bfhi(wa[i]) * 0.125f; kv[2 * i] = bflo(wb[i]); kv[2 * i + 1] = bfhi(wb[i]); } }
    float af[8], ab[8];
    { const LAS float* wl = (const LAS float*)(lds + GL_W) + h * 64 + 8 * wid;
      const f32x4 b0 = *(const LAS f32x4*)(wl + 8192), b1 = *(const LAS f32x4*)(wl + 8196), b2 = *(const LAS f32x4*)(wl + 8448), b3 = *(const LAS f32x4*)(wl + 8452);
#pragma unroll
      for (int i = 0; i < 4; ++i) { af[i] = b0[i]; af[4 + i] = b1[i]; ab[i] = b2[i]; ab[4 + i] = b3[i]; }
#pragma unroll
      for (int r = 0; r < 16; ++r) { const f32x4 f0 = *(const LAS f32x4*)(wl + r * 256), f1 = *(const LAS f32x4*)(wl + r * 256 + 4), g0 = *(const LAS f32x4*)(wl + 4096 + r * 256), g1 = *(const LAS f32x4*)(wl + 4096 + r * 256 + 4);
#pragma unroll
          for (int i = 0; i < 4; ++i) { af[i] += zf[r] * f0[i]; af[4 + i] += zf[r] * f1[i]; ab[i] += zb[r] * g0[i]; ab[4 + i] += zb[r] * g1[i]; } } }
    float oqf[8], okf[8], oqb[8], okb[8]; float tsf = 0.f, tsb = 0.f;
#pragma unroll
    for (int dd = 0; dd < 8; ++dd) {
        const int d = 8 * wid + dd;
        const float laf = logsig(af[dd]) * 0.0625f, lab = logsig(ab[dd]) * 0.0625f;
        const float pf = wave_incl_scan(laf, lane), pb = wave_incl_scan(lab, lane);
        const float totf = __shfl(pf, 63), totb = __shfl(pb, 63);
        const float sb = totb - pb + lab;
        if (!wdec) {
            oqf[dd] = qv[dd] * __expf(pf); okf[dd] = kv[dd] * __expf(-pf);
            oqb[dd] = qv[dd] * __expf(sb); okb[dd] = kv[dd] * __expf(-sb);
        } else {
            const float ksf = kv[dd] * __expf(totf - pf), ksb = kv[dd] * __expf(totb - sb);
            *(LAS bf16_t*)(lds + GL_KSF + (d * 72 + lane) * 2) = (bf16_t)(pk(ksf, 0.f) & 0xffffu);
            *(LAS bf16_t*)(lds + GL_KSB + (d * 72 + lane) * 2) = (bf16_t)(pk(ksb, 0.f) & 0xffffu);
            tsf = (lane == dd) ? totf : tsf; tsb = (lane == dd) ? totb : tsb;
        }
    }
    if (wdec && lane < 8) { DEC[((size_t)(c * 4 + h) * 2 + 0) * 64 + 8 * wid + lane] = __expf(tsf); DEC[((size_t)(c * 4 + h) * 2 + 1) * 64 + 8 * wid + lane] = __expf(tsb); }
    if (!wdec) { u32x4 w; const int off = (lane * 72 + 8 * wid) * 2;
      w.x = pk(oqf[0], oqf[1]); w.y = pk(oqf[2], oqf[3]); w.z = pk(oqf[4], oqf[5]); w.w = pk(oqf[6], oqf[7]); *(LAS u32x4*)(lds + GL_QF + off) = w;
      w.x = pk(okf[0], okf[1]); w.y = pk(okf[2], okf[3]); w.z = pk(okf[4], okf[5]); w.w = pk(okf[6], okf[7]); *(LAS u32x4*)(lds + GL_KF + off) = w;
      w.x = pk(oqb[0], oqb[1]); w.y = pk(oqb[2], oqb[3]); w.z = pk(oqb[4], oqb[5]); w.w = pk(oqb[6], oqb[7]); *(LAS u32x4*)(lds + GL_QB + off) = w;
      w.x = pk(okb[0], okb[1]); w.y = pk(okb[2], okb[3]); w.z = pk(okb[4], okb[5]); w.w = pk(okb[6], okb[7]); *(LAS u32x4*)(lds + GL_KB + off) = w; }
    { const int tp = tid >> 4, eg = tid & 15; const bf16_t* v0 = P + (size_t)(c * 64 + 2 * tp) * LDP + 1568 + h * 128 + 8 * eg;
      const u32x4 a = *(const u32x4*)v0, b = *(const u32x4*)(v0 + LDP); const unsigned wa[4] = {a.x, a.y, a.z, a.w}, wb[4] = {b.x, b.y, b.z, b.w};
      const int pcol = (4 * ((tp >> 2) ^ (eg & 7)) + (tp & 3)) * 4;
#pragma unroll
      for (int i = 0; i < 4; ++i) { *(LAS unsigned*)(lds + GL_VT + (8 * eg + 2 * i) * 144 + pcol) = (wa[i] & 0xffffu) | (wb[i] << 16);
                                    *(LAS unsigned*)(lds + GL_VT + (8 * eg + 2 * i + 1) * 144 + pcol) = (wa[i] >> 16) | (wb[i] & 0xffff0000u); } }
    __syncthreads();
}
__device__ __forceinline__ void gla_phaseA(LAS unsigned char* lds, const float* SMp, const bf16_t* P, bf16_t* ST, float* DEC) {
    const int tid = ltid(), wid = tid >> 6, lane = tid & 63, fr = lane & 15, fq = lane >> 4;
    gla_stage_w(lds, SMp);
    for (int it = lbid(); it < 1536 * 4; it += gridDim.x) {
        const int c = it >> 2, h = it & 3;
        gla_prep(lds, P, c, h, DEC, true);
        const int dir = wid >> 2, db = wid & 3; const int KS = dir ? GL_KSB : GL_KSF;
        bf16x8 a[2];
#pragma unroll
        for (int ks = 0; ks < 2; ++ks) a[ks] = *(const LAS bf16x8*)(lds + KS + ((16 * db + fr) * 72 + 32 * ks + 8 * fq) * 2);
        bf16_t* st = ST + ((size_t)(c * 4 + h) * 2 + dir) * 8192;
#pragma unroll
        for (int eb = 0; eb < 8; ++eb) { f32x4 acc = (f32x4){0.f, 0.f, 0.f, 0.f};
#pragma unroll
            for (int ks = 0; ks < 2; ++ks) { const int r = 16 * eb + fr; const bf16x8 b = *(const LAS bf16x8*)(lds + GL_VT + r * 144 + (((4 * ks + fq) ^ ((r >> 3) & 7)) * 16)); acc = MFMA16(a[ks], b, acc); }
            u32x2 w; w.x = pk(acc[0], acc[1]); w.y = pk(acc[2], acc[3]); *(u32x2*)(st + (16 * eb + fr) * 64 + 16 * db + 4 * fq) = w; }
        __syncthreads();
    }
}
__device__ __forceinline__ void gla_scan(bf16_t* ST, const float* DEC) {
    const int total = 32 * 8192;
    for (int tix = lbid() * 512 + ltid(); tix < total; tix += gridDim.x * 512) {
        const int piece = tix & 1023, dir = (tix >> 10) & 1, h = (tix >> 11) & 3, b = tix >> 13;
        const int N = b < 16 ? 32 : 64, c0 = b < 16 ? b * 32 : 512 + (b - 16) * 64, d0 = (piece & 7) * 8;
        float S[8];
#pragma unroll
        for (int i = 0; i < 8; ++i) S[i] = 0.f;
        for (int n = 0; n < N; n += 4) {
            u32x4 raw[4]; f32x4 e0[4], e1[4]; u32x4* ptr[4];
#pragma unroll
            for (int u = 0; u < 4; ++u) { const int c = dir ? c0 + N - 1 - (n + u) : c0 + n + u; const size_t base = (size_t)(c * 4 + h) * 2 + dir;
                ptr[u] = (u32x4*)(ST + base * 8192 + piece * 8); raw[u] = *ptr[u]; e0[u] = *(const f32x4*)(DEC + base * 64 + d0); e1[u] = *(const f32x4*)(DEC + base * 64 + d0 + 4); }
#pragma unroll
            for (int u = 0; u < 4; ++u) {
                u32x4 w; w.x = pk(S[0], S[1]); w.y = pk(S[2], S[3]); w.z = pk(S[4], S[5]); w.w = pk(S[6], S[7]); *ptr[u] = w;
                S[0] = e0[u][0] * S[0] + bflo(raw[u].x); S[1] = e0[u][1] * S[1] + bfhi(raw[u].x); S[2] = e0[u][2] * S[2] + bflo(raw[u].y); S[3] = e0[u][3] * S[3] + bfhi(raw[u].y);
                S[4] = e1[u][0] * S[4] + bflo(raw[u].z); S[5] = e1[u][1] * S[5] + bfhi(raw[u].z); S[6] = e1[u][2] * S[6] + bflo(raw[u].w); S[7] = e1[u][3] * S[7] + bfhi(raw[u].w); }
        }
    }
}
__device__ __forceinline__ void gla_phaseC(LAS unsigned char* lds, const float* SMp, bf16_t* P, const bf16_t* ST) {
    const int tid = ltid(), wid = tid >> 6, lane = tid & 63, fr = lane & 15, fq = lane >> 4;
    const float* gnorm = SMp + SM_GN;
    gla_stage_w(lds, SMp);
    for (int it = lbid(); it < 1536 * 4; it += gridDim.x) {
        const int c = it >> 2, h = it & 3;
        gla_prep(lds, P, c, h, nullptr, false);
        const int tb = wid & 3, eh = wid >> 2;
        f32x4 acc[4];
#pragma unroll
        for (int i = 0; i < 4; ++i) acc[i] = (f32x4){0.f, 0.f, 0.f, 0.f};
#pragma unroll
        for (int dir = 0; dir < 2; ++dir) {
            const int Qs = dir ? GL_QB : GL_QF, Ks = dir ? GL_KB : GL_KF;
            bf16x8 qf[2];
#pragma unroll
            for (int ks = 0; ks < 2; ++ks) qf[ks] = *(const LAS bf16x8*)(lds + Qs + ((16 * tb + fr) * 72 + 32 * ks + 8 * fq) * 2);
            f32x4 as[4];
#pragma unroll
            for (int sb = 0; sb < 4; ++sb) { as[sb] = (f32x4){0.f, 0.f, 0.f, 0.f};
#pragma unroll
                for (int ks = 0; ks < 2; ++ks) { const bf16x8 kf = *(const LAS bf16x8*)(lds + Ks + ((16 * sb + fr) * 72 + 32 * ks + 8 * fq) * 2); as[sb] = MFMA16(kf, qf[ks], as[sb]); }
#pragma unroll
                for (int j = 0; j < 4; ++j) { const int si = 16 * sb + 4 * fq + j, ti = 16 * tb + fr; const bool keep = dir ? (si > ti) : (si <= ti); as[sb][j] = keep ? as[sb][j] : 0.f; } }
            bf16x8 Pf[2]; Pf[0] = pack8(as[0], as[1]); Pf[1] = pack8(as[2], as[3]);
            const bf16_t* st = ST + ((size_t)(c * 4 + h) * 2 + dir) * 8192;
#pragma unroll
            for (int i = 0; i < 4; ++i) { const int e0 = 16 * (4 * eh + i) + fr;
#pragma unroll
                for (int cc = 0; cc < 2; ++cc) { const int sw = (e0 >> 3) & 7; const u32x2 lo = *(const LAS u32x2*)(lds + GL_VT + e0 * 144 + (((4 * cc + (fq >> 1)) ^ sw) * 16) + 8 * (fq & 1)), hi = *(const LAS u32x2*)(lds + GL_VT + e0 * 144 + (((4 * cc + 2 + (fq >> 1)) ^ sw) * 16) + 8 * (fq & 1));
                    acc[i] = MFMA16(mk8(lo, hi), Pf[cc], acc[i]); }
#pragma unroll
                for (int ks = 0; ks < 2; ++ks) { const bf16x8 sf = *(const bf16x8*)(st + e0 * 64 + 32 * ks + 8 * fq); acc[i] = MFMA16(sf, qf[ks], acc[i]); } }
        }
        float ss = 0.f;
#pragma unroll
        for (int i = 0; i < 4; ++i) ss += (acc[i][0] * acc[i][0] + acc[i][1] * acc[i][1]) + (acc[i][2] * acc[i][2] + acc[i][3] * acc[i][3]);
        ss += __shfl_xor(ss, 16); ss += __shfl_xor(ss, 32);
        LAS float* red = (LAS float*)(lds + GL_RED);
        if (fq == 0) red[eh * 64 + 16 * tb + fr] = ss;
        __syncthreads();
        const float tot = red[16 * tb + fr] + red[64 + 16 * tb + fr];
        const float rs = rsqrtf(tot * (1.0f / 128.0f) + 1e-6f);
        const int row = c * 64 + 16 * tb + fr; bf16_t* prow = P + (size_t)row * LDP;
#pragma unroll
        for (int i = 0; i < 4; ++i) { const int e = 16 * (4 * eh + i) + 4 * fq; const f32x4 g = *(const f32x4*)(gnorm + e); const u32x2 rr = *(const u32x2*)(prow + 2080 + h * 128 + e);
            const float o0 = acc[i][0] * rs * g[0] * silu(bflo(rr.x)), o1 = acc[i][1] * rs * g[1] * silu(bfhi(rr.x)), o2 = acc[i][2] * rs * g[2] * silu(bflo(rr.y)), o3 = acc[i][3] * rs * g[3] * silu(bfhi(rr.y));
            u32x2 w; w.x = pk(o0, o1); w.y = pk(o2, o3); *(u32x2*)(prow + 512 + h * 128 + e) = w; }
        __syncthreads();
    }
}

__device__ __forceinline__ void sgu_phase(LAS unsigned char* lds, bf16_t* V, const f32x2* STATS, const float* lng, const float* lnb, const bf16_t* Ws, const float* bs) {
    const int tid = ltid(), wid = tid >> 6, lane = tid & 63, fr = lane & 15, fq = lane >> 4;
    LAS float* MU = (LAS float*)(lds + 104448); LAS float* RS = (LAS float*)(lds + 104960);
    for (int unit = lbid(); unit < 6144; unit += gridDim.x) {
        const int ck = unit >> 3, g = unit & 7, cbase = g * 384, row0 = ck * 128;
        const int t0 = 16 * wid;
        bf16x8 Wf[4];
#pragma unroll
        for (int ks = 0; ks < 4; ++ks) Wf[ks] = *(const bf16x8*)(Ws + (size_t)(g * 128 + t0 + fr) * 128 + 32 * ks + 8 * fq);
        const float bias = bs[g * 128 + t0 + fr];
        if (tid < 128) { const f32x4* sp = (const f32x4*)(STATS + (size_t)(row0 + tid) * 48); float s1 = 0.f, s2 = 0.f;
#pragma unroll
            for (int i = 0; i < 24; ++i) { const f32x4 v = sp[i]; s1 += v[0] + v[2]; s2 += v[1] + v[3]; }
            const float mean = s1 * (1.0f / 3072.0f), var = s2 * (1.0f / 3072.0f) - mean * mean; MU[tid] = mean; RS[tid] = rsqrtf(fmaxf(var, 0.f) + 1e-5f); }
        __syncthreads();
#pragma unroll
        for (int i = 0; i < 6; ++i) { const int id = tid + 512 * i, rest = id >> 6, cg = (rest % 6) * 8 + (id & 7), tp = (rest / 6) * 8 + ((id >> 3) & 7); const int c = cbase + 8 * cg, r0 = row0 + 2 * tp;
            const int pcol = (4 * ((tp >> 2) ^ (cg & 7)) + (tp & 3)) * 4;
            const u32x4 a = *(const u32x4*)(V + (size_t)r0 * SH + c), b = *(const u32x4*)(V + (size_t)(r0 + 1) * SH + c);
            const f32x4 g0 = *(const f32x4*)(lng + c), g1 = *(const f32x4*)(lng + c + 4), b0 = *(const f32x4*)(lnb + c), b1 = *(const f32x4*)(lnb + c + 4);
            const float mu0 = MU[2 * tp], rs0 = RS[2 * tp], mu1 = MU[2 * tp + 1], rs1 = RS[2 * tp + 1];
            const unsigned wa[4] = {a.x, a.y, a.z, a.w}, wb[4] = {b.x, b.y, b.z, b.w}; const float gg[8] = {g0[0], g0[1], g0[2], g0[3], g1[0], g1[1], g1[2], g1[3]}, bb[8] = {b0[0], b0[1], b0[2], b0[3], b1[0], b1[1], b1[2], b1[3]};
#pragma unroll
            for (int e = 0; e < 4; ++e) {
                const float x0 = (bflo(wa[e]) - mu0) * rs0 * gg[2 * e] + bb[2 * e], x1 = (bflo(wb[e]) - mu1) * rs1 * gg[2 * e] + bb[2 * e];
                const float y0 = (bfhi(wa[e]) - mu0) * rs0 * gg[2 * e + 1] + bb[2 * e + 1], y1 = (bfhi(wb[e]) - mu1) * rs1 * gg[2 * e + 1] + bb[2 * e + 1];
                *(LAS unsigned*)(lds + (8 * cg + 2 * e) * 272 + pcol) = pk(x0, x1); *(LAS unsigned*)(lds + (8 * cg + 2 * e + 1) * 272 + pcol) = pk(y0, y1); } }
        __syncthreads();
        bf16_t* orow = V + (size_t)(row0 + t0 + fr) * SH + cbase + 4 * fq;
#pragma unroll
        for (int cb = 0; cb < 24; ++cb) { f32x4 acc = (f32x4){0.f, 0.f, 0.f, 0.f};
#pragma unroll
            for (int ks = 0; ks < 4; ++ks) { const int r = 16 * cb + fr; const bf16x8 a = *(const LAS bf16x8*)(lds + r * 272 + (((4 * ks + fq) ^ ((r >> 3) & 7)) * 16)); acc = MFMA16(a, Wf[ks], acc); }
            u32x2 w; w.x = pk(acc[0] + bias, acc[1] + bias); w.y = pk(acc[2] + bias, acc[3] + bias); *(u32x2*)(orow + 16 * cb) = w; }
        __syncthreads();
    }
}

#define ON(k) (((PM) >> (k)) & 1)
enum { K_G1 = 0, K_G2, K_LN, K_G3, K_G45, K_ATT, K_GLAC, K_MIX0, K_G7, K_SGU, K_G8, K_MIX1, K_G5A, K_G5B, K_GLAA };
constexpr int NSTEPS = 20;
__device__ __forceinline__ void step_info(int st, int& kind, int& arg, bool& sync) {
    sync = true;
    switch (st) {
        case 0: kind = K_G1; arg = 0; break; case 1: kind = K_G2; arg = 0; break;
        case 2: kind = K_G3; arg = 0; break;
        case 3: kind = K_G45; arg = 0; sync = false; break; case 4: kind = K_G5A; arg = 0; sync = false; break; case 5: kind = K_G5B; arg = 0; sync = false; break; case 6: kind = K_GLAA; arg = 0; break;
        case 7: kind = K_ATT; arg = 0; break; case 8: kind = K_GLAC; arg = 0; break; case 9: kind = K_MIX0; arg = 0; break;
        case 10: kind = K_G1; arg = 1; break; case 11: kind = K_G2; arg = 1; break;
        case 12: kind = K_G1; arg = 2; break; case 13: kind = K_G2; arg = 2; break;
        case 14: kind = K_G7; arg = 0; break; case 15: kind = K_SGU; arg = 0; break; case 16: kind = K_G8; arg = 0; break; case 17: kind = K_MIX1; arg = 0; break;
        case 18: kind = K_G1; arg = 3; break; default: kind = K_G2; arg = 3; break;
    }
}

__device__ __forceinline__ void grid_barrier(unsigned* bar, unsigned target) {
    asm volatile("s_waitcnt vmcnt(0) lgkmcnt(0)" ::: "memory");
    __syncthreads();
    if (threadIdx.x == 0) {
        __builtin_amdgcn_fence(__ATOMIC_RELEASE, "agent");
        asm volatile("s_waitcnt vmcnt(0)" ::: "memory");
        __hip_atomic_fetch_add(bar, 1u, __ATOMIC_RELAXED, __HIP_MEMORY_SCOPE_AGENT);
        while (__hip_atomic_load(bar, __ATOMIC_RELAXED, __HIP_MEMORY_SCOPE_AGENT) < target) __builtin_amdgcn_s_sleep(1);
        __builtin_amdgcn_fence(__ATOMIC_ACQUIRE, "agent");
        asm volatile("s_waitcnt vmcnt(0)" ::: "memory");
    }
    __syncthreads();
}
#define GSYNC(base) do { ++nbar; grid_barrier((unsigned*)((base) + WS_BAR), nbar * gridDim.x); } while (0)
__global__ void __launch_bounds__(512, 2) mega(Params p) {
    extern __shared__ __attribute__((aligned(16))) unsigned char shm[];
    LAS unsigned char* lds = (LAS unsigned char*)shm;
    cg::grid_group grid = cg::this_grid();
    if (ON(15)) phase0(lds, p);
    unsigned nbar = 0;
    grid.sync(); __builtin_amdgcn_fence(__ATOMIC_ACQUIRE, "agent"); asm volatile("s_waitcnt vmcnt(0)" ::: "memory");
#pragma unroll 1
    for (int st = 0; st < NSTEPS; ++st) {
        size_t zoff = 0; asm volatile("" : "+s"(zoff));
        unsigned char* ws = p.ws + zoff; unsigned char* dout = (unsigned char*)p.out + zoff;
        bf16_t* XB = (bf16_t*)(ws + WS_XB); bf16_t* R = (bf16_t*)(ws + WS_R); float* PRE = (float*)dout;
        bf16_t* ST = (bf16_t*)(ws + WS_ST); float* DEC = (float*)(ws + WS_DEC); float* SSQ = (float*)(ws + WS_SSQ); f32x2* STATS = (f32x2*)(ws + WS_STATS);
        bf16_t* Qb = (bf16_t*)(dout + DO_Q); bf16_t* KN = (bf16_t*)(dout + DO_KN); bf16_t* VT = (bf16_t*)(dout + DO_VT); bf16_t* KR = (bf16_t*)(dout + DO_KR);
        const f32x2* ROPE = (const f32x2*)(ws + WS_ROPE); const float* SMp = (const float*)(ws + WS_SMALL);
        int kind, arg; bool dosync; step_info(st, kind, arg, dosync);
        switch (kind) {
            case K_G1: if (ON(K_G1)) { EpiSwiglu E; E.H = R; const int rep = ((DUP & 4) && arg == 0) ? 2 : 1; for (int rr = 0; rr < rep; ++rr) run_gemm(lds, XB, DM, (const bf16_t*)(ws + WS_FFN + (size_t)arg * 17301504), DM, MTOK, 2 * FH, DM, E); } break;
            case K_G2: case K_MIX0: case K_MIX1: if (ON(K_G2)) { EpiLn E;
                const bf16_t* Bt; int lda, K, inst; float cs;
                if (kind == K_G2) { Bt = (const bf16_t*)(ws + WS_FFN + (size_t)arg * 17301504 + 11534336); lda = FH; K = FH; cs = 0.5f; inst = arg == 0 ? 0 : arg == 1 ? 2 : arg == 2 ? 3 : 5; }
                else if (kind == K_MIX0) { Bt = (const bf16_t*)(ws + WS_WOUT); lda = LDP; K = DM; cs = 1.0f; inst = 1; }
                else { Bt = (const bf16_t*)(ws + WS_SOUT); lda = SH; K = SH; cs = 1.0f; inst = 4; }
                E.XB = XB; E.OUTF = inst == 5 ? PRE : nullptr; E.G = SMp + SM_LN + inst * 2048; E.B = E.G + 1024; E.cs = cs;
                E.SLOT = (unsigned long long*)(ws + WS_SLOT); E.CNT = (unsigned*)(ws + WS_CNT) + (size_t)inst * 384 * 2 * 16;
                run_gemm(lds, R, lda, Bt, K, MTOK, DM, K, E); } break;
            case K_G3: if (ON(K_G3)) { EpiWin E; E.P = R; E.SSQ = SSQ; run_gemm(lds, XB, DM, (const bf16_t*)(ws + WS_WIN), DM, MTOK, 2816, DM, E); } break;
            case K_G45: if (ON(K_G45)) { kr_pass(R, ROPE, KR);
                EpiQ E; E.Q = Qb; E.SSQ = SSQ; E.ROPE = ROPE; run_gemm(lds, R, LDP, (const bf16_t*)(ws + WS_UQ), 768, MTOK, 768, 768, E); } break;
            case K_G5A: if (ON(K_G5A)) { EpiKN E; E.KN = KN; E.SSQ = SSQ; run_gemm(lds, R + 768, LDP, (const bf16_t*)(ws + WS_UKN), 256, MTOK, 512, 256, E); } break;
            case K_G5B: if (ON(K_G5B)) { EpiVT E; E.VT = VT; E.SSQ = SSQ; run_gemm(lds, (const bf16_t*)(ws + WS_UV), 256, R + 768, LDP, 512, MTOK, 256, E); } break;
            case K_GLAA: if (ON(K_GLAA)) { __syncthreads(); gla_phaseA(lds, SMp, R, ST, DEC); if (DUP & 2) gla_phaseA(lds, SMp, R, ST, DEC); } break;
            case K_ATT: if (ON(K_ATT)) { attn_phase(lds, Qb, KN, KR, VT, R); if (DUP & 1) { __syncthreads(); attn_phase(lds, Qb, KN, KR, VT, R); } gla_scan(ST, DEC); } break;
            case K_GLAC: if (ON(K_GLAC)) { gla_phaseC(lds, SMp, R, ST); if (DUP & 2) gla_phaseC(lds, SMp, R, ST); } break;
            case K_G7: if (ON(K_G7)) { EpiSguV E; E.V = R; E.STATS = STATS; run_gemm(lds, XB, DM, (const bf16_t*)(ws + WS_SIN) + (size_t)SH * DM, DM, MTOK, SH, DM, E); } break;
            case K_SGU: if (ON(K_SGU)) { sgu_phase(lds, R, STATS, SMp + SM_LNG, SMp + SM_LNB, (const bf16_t*)(ws + WS_WS), SMp + SM_BS); } break;
            case K_G8: if (ON(K_G8)) { EpiSguU E; E.V = R; run_gemm(lds, XB, DM, (const bf16_t*)(ws + WS_SIN), DM, MTOK, SH, DM, E); } break;
            default: break;
        }
        if (dosync) GSYNC(ws);
    }
}

constexpr int LDS_BYTES = 131072;
extern "C" void kernel_launch(void* const* d_in, const int* in_sizes, int n_in, void* d_out, int out_size, void* d_ws, size_t ws_size, hipStream_t stream) {
    static int grid_blocks = 0;
    if (!grid_blocks) {
        int dev = 0, cus = 0, per_cu = 0;
        (void)hipGetDevice(&dev);
        (void)hipDeviceGetAttribute(&cus, hipDeviceAttributeMultiprocessorCount, dev);
        (void)hipFuncSetAttribute((const void*)mega, hipFuncAttributeMaxDynamicSharedMemorySize, LDS_BYTES);
        (void)hipOccupancyMaxActiveBlocksPerMultiprocessor(&per_cu, (const void*)mega, 512, LDS_BYTES);
        if (per_cu < 1) per_cu = 1;
        grid_blocks = cus * per_cu;
        if (grid_blocks > 256) grid_blocks = 256;
    }
    Params p{};
    for (int i = 0; i < 39; ++i) p.in[i] = (const float*)d_in[i];
    p.out = (float*)d_out; p.ws = (unsigned char*)d_ws;
    void* args[] = {&p};
    hipError_t e = hipLaunchCooperativeKernel((const void*)mega, dim3(grid_blocks), dim3(512), args, LDS_BYTES, stream);
    if (e != hipSuccess) fprintf(stderr, "cooperative launch failed: %s (grid %d)\n", hipGetErrorString(e), grid_blocks);
}
```

```cpp
#include <hip/hip_runtime.h>
#include <hip/hip_cooperative_groups.h>
#include <cstdio>
namespace cg = cooperative_groups;

#define LAS __attribute__((address_space(3)))
typedef unsigned short bf16_t;
typedef short bf16x8 __attribute__((ext_vector_type(8)));
typedef float f32x4 __attribute__((ext_vector_type(4)));
typedef float f32x2 __attribute__((ext_vector_type(2)));
typedef unsigned u32x4 __attribute__((ext_vector_type(4)));
typedef unsigned u32x2 __attribute__((ext_vector_type(2)));

#ifndef PM
#define PM 0xFFFF
#endif
#ifndef DUP
#define DUP 0
#endif
constexpr int MTOK = 98304, NPROMPT = 32768, DM = 1024, FH = 2816, LDP = 2624, SH = 3072;
constexpr size_t MiB = 1048576;
constexpr size_t WS_FFN = 0;
constexpr size_t WS_WIN = 66 * MiB;
constexpr size_t WS_UQ = WS_WIN + 5767168;
constexpr size_t WS_UKN = WS_UQ + 1179648;
constexpr size_t WS_UV = WS_UKN + 262144;
constexpr size_t WS_WOUT = WS_UV + 262144;
constexpr size_t WS_SIN = WS_WOUT + 2097152;
constexpr size_t WS_SOUT = WS_SIN + 12582912;
constexpr size_t WS_WS = WS_SOUT + 6291456;
constexpr size_t WS_ROPE = WS_WS + 262144;
constexpr size_t WS_SMALL = WS_ROPE + 524288;
constexpr int SM_LN = 0, SM_WGF = 12288, SM_BGF = 16384, SM_WGB = 16640, SM_BGB = 20736, SM_GN = 20992, SM_LNG = 21120, SM_LNB = 24192, SM_BS = 27264;
constexpr size_t WS_XB = 96 * MiB;
constexpr size_t WS_R = 288 * MiB;
constexpr size_t WS_ST = 780 * MiB;
constexpr size_t WS_DEC = 972 * MiB;
constexpr size_t WS_SSQ = 976 * MiB;
constexpr size_t WS_STATS = 864 * MiB;
constexpr size_t WS_BAR = 983 * MiB;
constexpr size_t WS_CNT = WS_BAR + 4096;
constexpr size_t BAR_ZERO_BYTES = 4096 + 6 * 384 * 2 * 64;
constexpr size_t WS_SLOT = 984 * MiB;
constexpr size_t DO_Q = 0, DO_KN = 144 * MiB, DO_VT = 240 * MiB, DO_KR = 336 * MiB;

struct Params { const float* in[39]; float* out; unsigned char* ws; };

__device__ __forceinline__ int ltid() { int t = threadIdx.x; asm volatile("" : "+v"(t)); return t; }
__device__ __forceinline__ int lbid() { int t = blockIdx.x; asm volatile("" : "+s"(t)); return t; }
__device__ __forceinline__ float bflo(unsigned w) { return __uint_as_float(w << 16); }
__device__ __forceinline__ float bfhi(unsigned w) { return __uint_as_float(w & 0xffff0000u); }
typedef __bf16 bf16v2 __attribute__((ext_vector_type(2)));
__device__ __forceinline__ unsigned pk(float lo, float hi) { const f32x2 v = {lo, hi}; const bf16v2 b = __builtin_convertvector(v, bf16v2); return __builtin_bit_cast(unsigned, b); }
__device__ __forceinline__ float fexp2(float x) { return __builtin_amdgcn_exp2f(x); }
__device__ __forceinline__ float frcp(float x) { return __builtin_amdgcn_rcpf(x); }
__device__ __forceinline__ float silu(float x) { return x * frcp(1.0f + fexp2(-1.4426950408889634f * x)); }
__device__ __forceinline__ f32x2 gelu_pk(f32x2 v) {
    const f32x2 av = __builtin_elementwise_abs(v), d = av * 0.2316418882f + 1.0f;
    f32x2 t; t.x = frcp(d.x); t.y = frcp(d.y);
    f32x2 q = t * 0.5307027145f + (-0.7265760135f); q = q * t + 0.7107068705f; q = q * t + (-0.142248368f); q = q * t + 0.127414796f; q = q * t;
    const f32x2 s = (v * v) * (-0.72134752044f);
    f32x2 e; e.x = fexp2(s.x); e.y = fexp2(s.y);
    const f32x2 m = v * (q * e), r = v - m;
    f32x2 o; o.x = v.x < 0.f ? m.x : r.x; o.y = v.y < 0.f ? m.y : r.y; return o;
}
__device__ __forceinline__ f32x4 gelu4(f32x4 v) { f32x2 a = gelu_pk((f32x2){v[0], v[1]}), b = gelu_pk((f32x2){v[2], v[3]}); return (f32x4){a.x, a.y, b.x, b.y}; }
__device__ __forceinline__ int tok_pos(int row) { return row < NPROMPT ? (row & 2047) : (row & 4095); }

namespace pg8 {
constexpr int BM = 256, BK = 64, HALF = 128, HTB = HALF * BK * 2, STAGE_BYTES = 8 * HTB, NXCD = 8, WGM = 8;
__device__ __forceinline__ int lds_byte(int r, int c) { const int st = (r >> 4) * 2 + (c >> 5), rr = r & 15, cc = c & 31, ob = rr * 64 + cc * 2; return st * 1024 + (ob ^ (((ob >> 9) & 1) << 5)); }
__device__ __forceinline__ void stage_rc(int b, int& R, int& C) { const int st = b / 1024, sb = b % 1024, swz = sb ^ (((sb >> 9) & 1) << 5); R = (st >> 1) * 16 + swz / 64; C = (st & 1) * 32 + (swz % 64) / 2; }
__device__ __forceinline__ int perm32(int rho) { const int n = rho >> 4, i = rho & 15; return 8 * (i >> 2) + 4 * n + (i & 3); }
struct Unit { int pm, pn; };
struct Gemm { const bf16_t* A; const bf16_t* Bt; int lda, ldb, M, N, K; };
struct StaticOrder {
    int nM, nN, nwg, G, c;
    __device__ void init(int M, int N, int G_, int c_) { nM = M / BM; nN = N / BM; nwg = nM * nN; G = G_; c = c_; }
    __device__ bool next(int i, Unit& u) const {
        const long L = (long)i * G + c; if (L >= nwg) return false;
        int wgid = (int)L; { const int q = nwg / NXCD, r = nwg % NXCD, xcd = wgid % NXCD, off = wgid / NXCD; wgid = (xcd < r ? xcd * (q + 1) : r * (q + 1) + (xcd - r) * q) + off; }
        const int nig = WGM * nN, gid = wgid / nig, fm = gid * WGM, gsz = (nM - fm) < WGM ? (nM - fm) : WGM;
        u.pm = fm + ((wgid % nig) % gsz); u.pn = (wgid % nig) / gsz; return true;
    }
};
template <class Epi>
__device__ __forceinline__ void gemm_phase(LAS unsigned char* lds, const Gemm g, const StaticOrder& S, const Epi& E) {
    const int tid = ltid(), wid = __builtin_amdgcn_readfirstlane(tid >> 6), lane = tid & 63, wr = wid >> 2, wc = wid & 3, fr = lane & 15, fq = lane >> 4;
    int K = g.K, lda = g.lda, ldb = g.ldb; asm volatile("" : "+s"(K), "+s"(lda), "+s"(ldb));
    const int nt = K / BK;
    unsigned voffA[2], voffB[2];
#pragma unroll
    for (int i = 0; i < 2; ++i) { int R, C; stage_rc(tid * 16 + i * 8192, R, C); const int Rb = Epi::PERM ? ((R & ~31) + perm32(R & 31)) : R;
        voffA[i] = (unsigned)(R * lda + C) * 2u; voffB[i] = (unsigned)(Rb * ldb + C) * 2u; }
    const size_t kstep = (size_t)(BK * 2);
    const size_t hstepA = (size_t)HALF * lda * 2, hstepB = (size_t)HALF * ldb * 2;
    const size_t tstepA = 2 * hstepA, tstepB = 2 * hstepB;
    const unsigned ldsw = (unsigned)wid * 1024u;
    const int aoff = lds_byte(wr * 64 + fr, fq * 8), boff = lds_byte(wc * 32 + fr, fq * 8);
#define PG8_SA(b, h) (((b) * 2 + (h)) * HTB)
#define PG8_SB(b, h) ((4 + (b) * 2 + (h)) * HTB)
#define PG8_STAGE(bufoff, gbase, voff) do { _Pragma("unroll") for (int _i = 0; _i < 2; ++_i) \
        __builtin_amdgcn_global_load_lds((const unsigned*)((const char*)(gbase) + (voff)[_i]), (LAS unsigned*)(lds + (bufoff) + ldsw + _i * 8192), 16, 0, 0); } while (0)
#define PG8_LDA(dst, b, h) do { _Pragma("unroll") for (int m = 0; m < 4; ++m) _Pragma("unroll") for (int k = 0; k < 2; ++k) dst[m][k] = *(const LAS bf16x8*)(lds + PG8_SA(b, h) + aoff + m * 2048 + k * 1024); } while (0)
#define PG8_LDB(dst, b, h) do { _Pragma("unroll") for (int n = 0; n < 2; ++n) _Pragma("unroll") for (int k = 0; k < 2; ++k) dst[n][k] = *(const LAS bf16x8*)(lds + PG8_SB(b, h) + boff + n * 2048 + k * 1024); } while (0)
#define PG8_MMA(ai, bj, At, Bt) do { __builtin_amdgcn_s_setprio(1); _Pragma("unroll") for (int m = 0; m < 4; ++m) _Pragma("unroll") for (int n = 0; n < 2; ++n) _Pragma("unroll") for (int k = 0; k < 2; ++k) \
        acc[ai][bj][m][n] = __builtin_amdgcn_mfma_f32_16x16x32_bf16(Bt[n][k], At[m][k], acc[ai][bj][m][n], 0, 0, 0); __builtin_amdgcn_s_setprio(0); } while (0)
#define PG8_WAIT_V(n) asm volatile("s_waitcnt vmcnt(" #n ")" ::: "memory")
#define PG8_WAIT_L(n) asm volatile("s_waitcnt lgkmcnt(" #n ")" ::: "memory")
#define PG8_BAR __builtin_amdgcn_s_barrier()
#define PG8_SCHED __builtin_amdgcn_sched_barrier(0)
    Unit cur, nxt; int ui = 0;
    if (!S.next(0, cur)) return;
    f32x4 acc[2][2][4][2];
#pragma unroll
    for (int a = 0; a < 2; ++a)
#pragma unroll
        for (int b = 0; b < 2; ++b)
#pragma unroll
            for (int m = 0; m < 4; ++m)
#pragma unroll
                for (int n = 0; n < 2; ++n) acc[a][b][m][n] = (f32x4){0.f, 0.f, 0.f, 0.f};
    bf16x8 At[4][2], B0[2][2], B1[2][2];
    const char* cA = (const char*)g.A + (size_t)cur.pm * tstepA; const char* cB = (const char*)g.Bt + (size_t)cur.pn * tstepB;
    PG8_STAGE(PG8_SB(0, 0), cB, voffB); PG8_STAGE(PG8_SA(0, 0), cA, voffA); PG8_STAGE(PG8_SB(0, 1), cB + hstepB, voffB); PG8_STAGE(PG8_SA(0, 1), cA + hstepA, voffA);
    if (wr == 1) PG8_BAR;
    PG8_WAIT_V(4); PG8_BAR;
    PG8_STAGE(PG8_SB(1, 0), cB + kstep, voffB); PG8_STAGE(PG8_SA(1, 0), cA + kstep, voffA); PG8_STAGE(PG8_SB(1, 1), cB + hstepB + kstep, voffB);
    PG8_WAIT_V(6); PG8_BAR;
    for (;;) {
        const bool has_next = S.next(ui + 1, nxt);
        const char* nA = has_next ? (const char*)g.A + (size_t)nxt.pm * tstepA : cA; const char* nB = has_next ? (const char*)g.Bt + (size_t)nxt.pn * tstepB : cB;
        for (int t = 0; t < nt; t += 2) {
            const bool last = (t == nt - 2);
            const char* a1 = cA + (size_t)(t + 1) * kstep;
            const char* a2 = last ? nA : cA + (size_t)(t + 2) * kstep; const char* b2 = last ? nB : cB + (size_t)(t + 2) * kstep;
            const char* a3 = a2 + kstep; const char* b3 = b2 + kstep;
            PG8_LDB(B0, 0, 0); PG8_SCHED; PG8_LDA(At, 0, 0); PG8_STAGE(PG8_SA(1, 1), a1 + hstepA, voffA);
            PG8_WAIT_L(8); PG8_BAR; PG8_WAIT_L(0); PG8_MMA(0, 0, At, B0); PG8_BAR; PG8_SCHED;
            PG8_LDB(B1, 0, 1); PG8_STAGE(PG8_SB(0, 0), b2, voffB);
            PG8_BAR; PG8_WAIT_L(0); PG8_MMA(0, 1, At, B1); PG8_BAR;
            PG8_LDA(At, 0, 1); PG8_STAGE(PG8_SA(0, 0), a2, voffA);
            PG8_BAR; PG8_WAIT_L(0); PG8_MMA(1, 0, At, B0); PG8_BAR; PG8_SCHED;
            PG8_STAGE(PG8_SB(0, 1), b2 + hstepB, voffB);
            PG8_WAIT_V(6); PG8_BAR; PG8_MMA(1, 1, At, B1); PG8_BAR;
            PG8_LDB(B0, 1, 0); PG8_SCHED; PG8_LDA(At, 1, 0); PG8_STAGE(PG8_SA(0, 1), a2 + hstepA, voffA);
            PG8_WAIT_L(8); PG8_BAR; PG8_WAIT_L(0); PG8_MMA(0, 0, At, B0); PG8_BAR; PG8_SCHED;
            PG8_LDB(B1, 1, 1); PG8_STAGE(PG8_SB(1, 0), b3, voffB);
            PG8_BAR; PG8_WAIT_L(0); PG8_MMA(0, 1, At, B1); PG8_BAR;
            PG8_LDA(At, 1, 1); PG8_STAGE(PG8_SA(1, 0), a3, voffA);
            PG8_BAR; PG8_WAIT_L(0); PG8_MMA(1, 0, At, B0); PG8_BAR; PG8_SCHED;
            PG8_STAGE(PG8_SB(1, 1), b3 + hstepB, voffB);
            PG8_WAIT_V(6); PG8_BAR; PG8_MMA(1, 1, At, B1); PG8_BAR;
        }
        E(acc, cur, wr, wc, fr, fq);
        if (!has_next) break;
#pragma unroll
        for (int a = 0; a < 2; ++a)
#pragma unroll
            for (int b = 0; b < 2; ++b)
#pragma unroll
                for (int m = 0; m < 4; ++m)
#pragma unroll
                    for (int n = 0; n < 2; ++n) acc[a][b][m][n] = (f32x4){0.f, 0.f, 0.f, 0.f};
        cur = nxt; cA = nA; cB = nB; ++ui;
    }
    PG8_WAIT_V(0);
    if (wr == 0) PG8_BAR;
    PG8_BAR;
#undef PG8_SA
#undef PG8_SB
#undef PG8_STAGE
#undef PG8_LDA
#undef PG8_LDB
#undef PG8_MMA
#undef PG8_WAIT_V
#undef PG8_WAIT_L
#undef PG8_BAR
#undef PG8_SCHED
}
}
using pg8::Unit;
typedef f32x4 AccT[2][2][4][2];

struct EpiSwiglu {
    static constexpr bool PERM = true; bf16_t* H;
    __device__ __forceinline__ void operator()(const AccT& acc, const Unit& u, int wr, int wc, int fr, int fq) const {
        const int row0 = u.pm * 256 + wr * 64 + fr, col0 = u.pn * 128 + wc * 32 + 8 * fq;
#pragma unroll
        for (int ai = 0; ai < 2; ++ai)
#pragma unroll
            for (int m = 0; m < 4; ++m) { const f32x4 g0 = acc[ai][0][m][0], g1 = acc[ai][0][m][1], u0 = acc[ai][1][m][0], u1 = acc[ai][1][m][1];
                u32x4 w; w.x = pk(silu(g0[0]) * u0[0], silu(g0[1]) * u0[1]); w.y = pk(silu(g0[2]) * u0[2], silu(g0[3]) * u0[3]);
                w.z = pk(silu(g1[0]) * u1[0], silu(g1[1]) * u1[1]); w.w = pk(silu(g1[2]) * u1[2], silu(g1[3]) * u1[3]);
                *(u32x4*)(H + (size_t)(row0 + ai * 128 + m * 16) * FH + col0) = w; }
    }
};
struct EpiPre {
    static constexpr bool PERM = false; const bf16_t* XB; float* PRE; float cs;
    __device__ __forceinline__ void operator()(const AccT& acc, const Unit& u, int wr, int wc, int fr, int fq) const {
        const int row0 = u.pm * 256 + wr * 64 + fr, col0 = u.pn * 256 + wc * 32 + 4 * fq;
#pragma unroll
        for (int ai = 0; ai < 2; ++ai)
#pragma unroll
            for (int m = 0; m < 4; ++m) { const size_t ro = (size_t)(row0 + ai * 128 + m * 16) * DM + col0;
#pragma unroll
                for (int bj = 0; bj < 2; ++bj)
#pragma unroll
                    for (int n = 0; n < 2; ++n) { const u32x2 xw = *(const u32x2*)(XB + ro + bj * 128 + n * 16); const f32x4 a = acc[ai][bj][m][n];
                        f32x4 o; o[0] = 1.41421356237f * bflo(xw.x) + cs * a[0]; o[1] = 1.41421356237f * bfhi(xw.x) + cs * a[1]; o[2] = 1.41421356237f * bflo(xw.y) + cs * a[2]; o[3] = 1.41421356237f * bfhi(xw.y) + cs * a[3];
                        *(f32x4*)(PRE + ro + bj * 128 + n * 16) = o; } }
    }
};
struct EpiLn {
    static constexpr bool PERM = true; bf16_t* XB; float* OUTF; const float* G; const float* B; float cs; unsigned long long* SLOT; unsigned* CNT;
    __device__ __forceinline__ void operator()(AccT& acc, const Unit& u, int wr, int wc, int fr, int fq) const {
        const int row0 = u.pm * 256 + wr * 64 + fr, col0 = u.pn * 256 + wc * 32 + 8 * fq; const float AL = 1.41421356237f;
#pragma unroll
        for (int ai = 0; ai < 2; ++ai) {
            u32x4 xw[4][2];
#pragma unroll
            for (int m = 0; m < 4; ++m)
#pragma unroll
                for (int bj = 0; bj < 2; ++bj) xw[m][bj] = *(const u32x4*)(XB + (size_t)(row0 + ai * 128 + m * 16) * DM + col0 + bj * 128);
#pragma unroll
            for (int m = 0; m < 4; ++m) { const int row = row0 + ai * 128 + m * 16; float s1 = 0.f, s2 = 0.f;
#pragma unroll
                for (int bj = 0; bj < 2; ++bj) { const u32x4 x = xw[m][bj]; const f32x4 a0 = acc[ai][bj][m][0], a1 = acc[ai][bj][m][1]; f32x4 v0, v1;
                    v0[0] = AL * bflo(x.x) + cs * a0[0]; v0[1] = AL * bfhi(x.x) + cs * a0[1]; v0[2] = AL * bflo(x.y) + cs * a0[2]; v0[3] = AL * bfhi(x.y) + cs * a0[3];
                    v1[0] = AL * bflo(x.z) + cs * a1[0]; v1[1] = AL * bfhi(x.z) + cs * a1[1]; v1[2] = AL * bflo(x.w) + cs * a1[2]; v1[3] = AL * bfhi(x.w) + cs * a1[3];
                    acc[ai][bj][m][0] = v0; acc[ai][bj][m][1] = v1;
                    s1 += ((v0[0] + v0[1]) + (v0[2] + v0[3])) + ((v1[0] + v1[1]) + (v1[2] + v1[3]));
                    s2 += (v0[0] * v0[0] + v0[1] * v0[1]) + (v0[2] * v0[2] + v0[3] * v0[3]) + (v1[0] * v1[0] + v1[1] * v1[1]) + (v1[2] * v1[2] + v1[3] * v1[3]); }
                s1 += __shfl_xor(s1, 16); s1 += __shfl_xor(s1, 32); s2 += __shfl_xor(s2, 16); s2 += __shfl_xor(s2, 32);
                if (fq == 0) __hip_atomic_store(SLOT + (size_t)row * 16 + u.pn * 4 + wc, ((unsigned long long)__float_as_uint(s2) << 32) | (unsigned long long)__float_as_uint(s1), __ATOMIC_RELAXED, __HIP_MEMORY_SCOPE_AGENT); }
            asm volatile("" ::: "memory");
        }
        asm volatile("s_waitcnt vmcnt(0)" ::: "memory");
        unsigned* cnt = CNT + ((size_t)u.pm * 2 + wr) * 16;
        if ((fr | fq) == 0) __hip_atomic_fetch_add(cnt, 1u, __ATOMIC_RELAXED, __HIP_MEMORY_SCOPE_AGENT);
        while ((unsigned)__builtin_amdgcn_readfirstlane((int)__hip_atomic_load(cnt, __ATOMIC_RELAXED, __HIP_MEMORY_SCOPE_AGENT)) < 16u) __builtin_amdgcn_s_sleep(1);
        __builtin_amdgcn_fence(__ATOMIC_ACQUIRE, "workgroup"); asm volatile("" ::: "memory");
        f32x4 gv[2][2], bv[2][2];
#pragma unroll
        for (int bt = 0; bt < 3; ++bt) { const int rb = bt * 3, nr = bt == 2 ? 2 : 3;
            unsigned long long sw[3][4];
#pragma unroll
            for (int k = 0; k < 3; ++k) if (k < nr) { const int r8 = rb + k; const unsigned long long* sp = SLOT + (size_t)(row0 + (r8 >> 2) * 128 + (r8 & 3) * 16) * 16 + 4 * fq;
#pragma unroll
                for (int i = 0; i < 4; ++i) sw[k][i] = __hip_atomic_load(sp + i, __ATOMIC_RELAXED, __HIP_MEMORY_SCOPE_AGENT); }
            if (bt == 0) {
#pragma unroll
                for (int bj = 0; bj < 2; ++bj)
#pragma unroll
                    for (int n = 0; n < 2; ++n) { gv[bj][n] = *(const f32x4*)(G + col0 + bj * 128 + 4 * n); bv[bj][n] = *(const f32x4*)(B + col0 + bj * 128 + 4 * n); } }
#pragma unroll
            for (int k = 0; k < 3; ++k) if (k < nr) { const int r8 = rb + k, ai = r8 >> 2, m = r8 & 3; const int row = row0 + ai * 128 + m * 16; float t1 = 0.f, t2 = 0.f;
#pragma unroll
                for (int i = 0; i < 4; ++i) { const unsigned long long w = sw[k][i]; t1 += __uint_as_float((unsigned)w); t2 += __uint_as_float((unsigned)(w >> 32)); }
                t1 += __shfl_xor(t1, 16); t1 += __shfl_xor(t1, 32); t2 += __shfl_xor(t2, 16); t2 += __shfl_xor(t2, 32);
                const float mean = t1 * (1.0f / 1024.0f), var = t2 * (1.0f / 1024.0f) - mean * mean, rstd = rsqrtf(fmaxf(var, 0.f) + 1e-5f);
#pragma unroll
                for (int bj = 0; bj < 2; ++bj) { const f32x4 y0 = (acc[ai][bj][m][0] - mean) * rstd * gv[bj][0] + bv[bj][0], y1 = (acc[ai][bj][m][1] - mean) * rstd * gv[bj][1] + bv[bj][1];
                    if (OUTF) { *(f32x4*)(OUTF + (size_t)row * DM + col0 + bj * 128) = y0; *(f32x4*)(OUTF + (size_t)row * DM + col0 + bj * 128 + 4) = y1; }
                    else { u32x4 w; w.x = pk(y0[0], y0[1]); w.y = pk(y0[2], y0[3]); w.z = pk(y1[0], y1[1]); w.w = pk(y1[2], y1[3]); *(u32x4*)(XB + (size_t)row * DM + col0 + bj * 128) = w; } } }
            asm volatile("" ::: "memory");
        }
    }
};
struct EpiWin {
    static constexpr bool PERM = true; bf16_t* P; float* SSQ;
    __device__ __forceinline__ void operator()(const AccT& acc, const Unit& u, int wr, int wc, int fr, int fq) const {
        const int row0 = u.pm * 256 + wr * 64 + fr, col0 = u.pn * 256 + wc * 32 + 8 * fq;
#pragma unroll
        for (int ai = 0; ai < 2; ++ai)
#pragma unroll
            for (int m = 0; m < 4; ++m) { const int row = row0 + ai * 128 + m * 16; float s = 0.f;
#pragma unroll
                for (int bj = 0; bj < 2; ++bj) { f32x4 v0 = acc[ai][bj][m][0], v1 = acc[ai][bj][m][1]; const int c = col0 + bj * 128;
                    s += (v0[0] * v0[0] + v0[1] * v0[1]) + (v0[2] * v0[2] + v0[3] * v0[3]) + (v1[0] * v1[0] + v1[1] * v1[1]) + (v1[2] * v1[2] + v1[3] * v1[3]);
                    if (c < LDP) { u32x4 w; w.x = pk(v0[0], v0[1]); w.y = pk(v0[2], v0[3]); w.z = pk(v1[0], v1[1]); w.w = pk(v1[2], v1[3]); *(u32x4*)(P + (size_t)row * LDP + c) = w; } }
                if (u.pn < 4) { s += __shfl_xor(s, 16); s += __shfl_xor(s, 32); if (fq == 0) SSQ[(size_t)row * 16 + u.pn * 4 + wc] = s; } }
    }
};
struct EpiQ {
    static constexpr bool PERM = false; bf16_t* Q; const float* SSQ; const f32x2* ROPE;
    __device__ __forceinline__ void operator()(const AccT& acc, const Unit& u, int wr, int wc, int fr, int fq) const {
        const int row0 = u.pm * 256 + wr * 64 + fr; const float QS = 0.10206207261596577f * 1.4426950408889634f;
#pragma unroll
        for (int ai = 0; ai < 2; ++ai)
#pragma unroll
            for (int m = 0; m < 4; ++m) { const int row = row0 + ai * 128 + m * 16;
                const f32x4 s0 = *(const f32x4*)(SSQ + (size_t)row * 16), s1 = *(const f32x4*)(SSQ + (size_t)row * 16 + 4), s2 = *(const f32x4*)(SSQ + (size_t)row * 16 + 8);
                const float ss = ((s0[0] + s0[1]) + (s0[2] + s0[3])) + ((s1[0] + s1[1]) + (s1[2] + s1[3])) + ((s2[0] + s2[1]) + (s2[2] + s2[3]));
                const float rs = rsqrtf(ss * (1.0f / 768.0f) + 1e-6f) * QS; const int pos = tok_pos(row);
#pragma unroll
                for (int bj = 0; bj < 2; ++bj) { const int cg = u.pn * 256 + bj * 128 + wc * 32; f32x4 a0 = acc[ai][bj][m][0] * rs, a1 = acc[ai][bj][m][1] * rs;
                    if ((cg % 96) == 64) { const f32x4 t0 = *(const f32x4*)(ROPE + (size_t)pos * 16 + 4 * fq), t1 = *(const f32x4*)(ROPE + (size_t)pos * 16 + 4 * fq + 2);
                        const float cs[4] = {t0[0], t0[2], t1[0], t1[2]}, sn[4] = {t0[1], t0[3], t1[1], t1[3]}; f32x4 o0, o1;
#pragma unroll
                        for (int j = 0; j < 4; ++j) { o0[j] = a0[j] * cs[j] - a1[j] * sn[j]; o1[j] = a0[j] * sn[j] + a1[j] * cs[j]; }
                        a0 = o0; a1 = o1; }
                    u32x2 w0, w1; w0.x = pk(a0[0], a0[1]); w0.y = pk(a0[2], a0[3]); w1.x = pk(a1[0], a1[1]); w1.y = pk(a1[2], a1[3]);
                    *(u32x2*)(Q + (size_t)row * 768 + cg + 4 * fq) = w0; *(u32x2*)(Q + (size_t)row * 768 + cg + 16 + 4 * fq) = w1; }
                asm volatile("" ::: "memory"); }
    }
};
struct EpiKN {
    static constexpr bool PERM = true; bf16_t* KN; const float* SSQ;
    __device__ __forceinline__ void operator()(const AccT& acc, const Unit& u, int wr, int wc, int fr, int fq) const {
        const int row0 = u.pm * 256 + wr * 64 + fr, col0 = u.pn * 256 + wc * 32 + 8 * fq;
#pragma unroll
        for (int ai = 0; ai < 2; ++ai)
#pragma unroll
            for (int m = 0; m < 4; ++m) { const int row = row0 + ai * 128 + m * 16; const f32x4 s3 = *(const f32x4*)(SSQ + (size_t)row * 16 + 12);
                const float rs = rsqrtf(((s3[0] + s3[1]) + (s3[2] + s3[3])) * (1.0f / 256.0f) + 1e-6f);
#pragma unroll
                for (int bj = 0; bj < 2; ++bj) { const f32x4 v0 = acc[ai][bj][m][0] * rs, v1 = acc[ai][bj][m][1] * rs;
                    u32x4 w; w.x = pk(v0[0], v0[1]); w.y = pk(v0[2], v0[3]); w.z = pk(v1[0], v1[1]); w.w = pk(v1[2], v1[3]); *(u32x4*)(KN + (size_t)row * 512 + col0 + bj * 128) = w; }
                asm volatile("" ::: "memory"); }
    }
};
struct EpiVT {
    static constexpr bool PERM = true; bf16_t* VT; const float* SSQ;
    __device__ __forceinline__ void operator()(const AccT& acc, const Unit& u, int wr, int wc, int fr, int fq) const {
        const int f0 = u.pm * 256 + wr * 64 + fr, tok0 = u.pn * 256 + wc * 32 + 8 * fq;
#pragma unroll
        for (int bj = 0; bj < 2; ++bj) {
            float rs[8];
#pragma unroll
            for (int i = 0; i < 8; ++i) { const f32x4 s3 = *(const f32x4*)(SSQ + (size_t)(tok0 + bj * 128 + i) * 16 + 12); rs[i] = rsqrtf(((s3[0] + s3[1]) + (s3[2] + s3[3])) * (1.0f / 256.0f) + 1e-6f); }
            asm volatile("" ::: "memory");
#pragma unroll
            for (int ai = 0; ai < 2; ++ai)
#pragma unroll
                for (int m = 0; m < 4; ++m) { const int f = f0 + ai * 128 + m * 16; const f32x4 v0 = acc[ai][bj][m][0], v1 = acc[ai][bj][m][1];
                    u32x4 w; w.x = pk(v0[0] * rs[0], v0[1] * rs[1]); w.y = pk(v0[2] * rs[2], v0[3] * rs[3]); w.z = pk(v1[0] * rs[4], v1[1] * rs[5]); w.w = pk(v1[2] * rs[6], v1[3] * rs[7]);
                    *(u32x4*)(VT + (size_t)f * MTOK + tok0 + bj * 128) = w; }
            asm volatile("" ::: "memory");
        }
    }
};
struct EpiSguV {
    static constexpr bool PERM = true; bf16_t* V; f32x2* STATS;
    __device__ __forceinline__ void operator()(const AccT& acc, const Unit& u, int wr, int wc, int fr, int fq) const {
        const int row0 = u.pm * 256 + wr * 64 + fr, col0 = u.pn * 256 + wc * 32 + 8 * fq;
#pragma unroll
        for (int ai = 0; ai < 2; ++ai)
#pragma unroll
            for (int m = 0; m < 4; ++m) { const int row = row0 + ai * 128 + m * 16; float s1 = 0.f, s2 = 0.f;
#pragma unroll
                for (int bj = 0; bj < 2; ++bj) { const f32x4 v0 = gelu4(acc[ai][bj][m][0]), v1 = gelu4(acc[ai][bj][m][1]);
                    s1 += ((v0[0] + v0[1]) + (v0[2] + v0[3])) + ((v1[0] + v1[1]) + (v1[2] + v1[3]));
                    s2 += (v0[0] * v0[0] + v0[1] * v0[1]) + (v0[2] * v0[2] + v0[3] * v0[3]) + (v1[0] * v1[0] + v1[1] * v1[1]) + (v1[2] * v1[2] + v1[3] * v1[3]);
                    u32x4 w; w.x = pk(v0[0], v0[1]); w.y = pk(v0[2], v0[3]); w.z = pk(v1[0], v1[1]); w.w = pk(v1[2], v1[3]); *(u32x4*)(V + (size_t)row * SH + col0 + bj * 128) = w; }
                s1 += __shfl_xor(s1, 16); s1 += __shfl_xor(s1, 32); s2 += __shfl_xor(s2, 16); s2 += __shfl_xor(s2, 32);
                if (fq == 0) STATS[(size_t)row * 48 + u.pn * 4 + wc] = (f32x2){s1, s2}; }
    }
};
struct EpiSguU {
    static constexpr bool PERM = true; bf16_t* V;
    __device__ __forceinline__ void operator()(const AccT& acc, const Unit& u, int wr, int wc, int fr, int fq) const {
        const int row0 = u.pm * 256 + wr * 64 + fr, col0 = u.pn * 256 + wc * 32 + 8 * fq;
#pragma unroll
        for (int ai = 0; ai < 2; ++ai) {
            u32x4 vv[4][2];
#pragma unroll
            for (int m = 0; m < 4; ++m)
#pragma unroll
                for (int bj = 0; bj < 2; ++bj) vv[m][bj] = *(const u32x4*)(V + (size_t)(row0 + ai * 128 + m * 16) * SH + col0 + bj * 128);
#pragma unroll
            for (int m = 0; m < 4; ++m) { const int row = row0 + ai * 128 + m * 16;
#pragma unroll
                for (int bj = 0; bj < 2; ++bj) { bf16_t* ptr = V + (size_t)row * SH + col0 + bj * 128; const u32x4 x = vv[m][bj];
                    const f32x4 v0 = gelu4(acc[ai][bj][m][0]), v1 = gelu4(acc[ai][bj][m][1]);
                    u32x4 w; w.x = pk(v0[0] * bflo(x.x), v0[1] * bfhi(x.x)); w.y = pk(v0[2] * bflo(x.y), v0[3] * bfhi(x.y)); w.z = pk(v1[0] * bflo(x.z), v1[1] * bfhi(x.z)); w.w = pk(v1[2] * bflo(x.w), v1[3] * bfhi(x.w));
                    *(u32x4*)ptr = w; } }
            asm volatile("" ::: "memory");
        }
    }
};

template <class Epi> __device__ __forceinline__ void run_gemm(LAS unsigned char* lds, const bf16_t* A, int lda, const bf16_t* Bt, int ldb, int M, int N, int K, const Epi& E) {
    pg8::Gemm g; g.A = A; g.Bt = Bt; g.lda = lda; g.ldb = ldb; g.M = M; g.N = N; g.K = K;
    pg8::StaticOrder S; S.init(M, N, (int)gridDim.x, lbid());
    pg8::gemm_phase<Epi>(lds, g, S, E);
}

__device__ __forceinline__ int mapcol(int mode, int nd) {
    switch (mode) {
        case 1: { const int t = nd >> 8, w = nd & 255; return (w >= 128 ? FH : 0) + t * 128 + (w & 127); }
        case 2: return nd < LDP ? nd : -1;
        case 3: return (nd >> 6) * 128 + (nd & 63);
        case 4: return (nd >> 6) * 128 + 64 + (nd & 63);
        default: return nd;
    }
}
__device__ __forceinline__ void convert_T(LAS unsigned char* lds, const float* src, int ldsrc, int K, int Ndst, bf16_t* dst, int mode, const float* kscale) {
    LAS float* tile = (LAS float*)lds;
    const int tid = ltid(), ntk = K / 64, ntn = Ndst / 256;
    for (int idx = lbid(); idx < ntk * ntn; idx += gridDim.x) {
        const int tk = idx % ntk, tn = idx / ntk;
        const int r0 = tid >> 6, c4 = (tid & 63) * 4; const int ns = mapcol(mode, tn * 256 + c4);
        f32x4 v[8];
#pragma unroll
        for (int i = 0; i < 8; ++i) { const int k = tk * 64 + r0 + 8 * i; v[i] = (f32x4){0.f, 0.f, 0.f, 0.f}; if (ns >= 0) v[i] = *(const f32x4*)(src + (size_t)k * ldsrc + ns); if (kscale) v[i] = v[i] * kscale[k]; }
#pragma unroll
        for (int i = 0; i < 8; ++i) *(LAS f32x4*)(tile + (r0 + 8 * i) * 260 + c4) = v[i];
        __syncthreads();
        const int n = tid >> 1, kh = (tid & 1) * 32;
#pragma unroll
        for (int q = 0; q < 4; ++q) { float x[8];
#pragma unroll
            for (int i = 0; i < 8; ++i) x[i] = tile[(kh + 8 * q + i) * 260 + n];
            u32x4 w; w.x = pk(x[0], x[1]); w.y = pk(x[2], x[3]); w.z = pk(x[4], x[5]); w.w = pk(x[6], x[7]);
            *(u32x4*)(dst + (size_t)(tn * 256 + n) * K + tk * 64 + kh + 8 * q) = w; }
        __syncthreads();
    }
}
#define PIN(k) (p.in[lidx(k)])
__device__ __forceinline__ int lidx(int k) { asm volatile("" : "+s"(k)); return k; }
__device__ __forceinline__ void copyf(float* dst, const float* src, size_t n, size_t gt, size_t nth) { if (gt < n) dst[gt] = src[gt]; }
__device__ __forceinline__ void phase0(LAS unsigned char* lds, const Params& p) {
    unsigned char* ws = p.ws;
    const size_t gt = (size_t)lbid() * 512 + ltid(), nth = (size_t)gridDim.x * 512;
    { bf16_t* XB = (bf16_t*)(ws + WS_XB); const size_t n4 = (size_t)MTOK * DM / 4, np4 = (size_t)NPROMPT * DM / 4; const f32x4* xp = (const f32x4*)PIN(0); const f32x4* xs = (const f32x4*)PIN(1);
      size_t i = gt;
      for (; i + 3 * nth < n4; i += 4 * nth) { f32x4 v[4];
#pragma unroll
          for (int u = 0; u < 4; ++u) { const size_t j = i + u * nth; v[u] = j < np4 ? xp[j] : xs[j - np4]; }
#pragma unroll
          for (int u = 0; u < 4; ++u) { u32x2 w; w.x = pk(v[u][0], v[u][1]); w.y = pk(v[u][2], v[u][3]); ((u32x2*)XB)[i + u * nth] = w; } }
      for (; i < n4; i += nth) { const f32x4 v = i < np4 ? xp[i] : xs[i - np4]; u32x2 w; w.x = pk(v[0], v[1]); w.y = pk(v[2], v[3]); ((u32x2*)XB)[i] = w; } }
    { unsigned* z = (unsigned*)(ws + WS_BAR); for (size_t i = gt; i < BAR_ZERO_BYTES / 4; i += nth) z[i] = 0u; }
    { bf16_t* W = (bf16_t*)(ws + WS_WS); const float* wsrc = PIN(30); for (size_t i = gt; i < 8 * 128 * 128 / 2; i += nth) { ((unsigned*)W)[i] = pk(wsrc[2 * i], wsrc[2 * i + 1]); }
      f32x2* R = (f32x2*)(ws + WS_ROPE); for (size_t i = gt; i < 4096 * 16; i += nth) { const int pos = (int)(i >> 4), j = (int)(i & 15);
          const float inv = 1.0f / powf(10000.0f, (float)(2 * j) / 32.0f); const float ang = (float)pos * inv; R[i] = (f32x2){cosf(ang), sinf(ang)}; } }
    { float* SMp = (float*)(ws + WS_SMALL);
#pragma unroll 1
      for (int k = 0; k < 6; ++k) { const int gi = k == 0 ? 4 : k == 1 ? 17 : k == 2 ? 21 : k == 3 ? 25 : k == 4 ? 33 : 37; copyf(SMp + SM_LN + k * 2048, PIN(gi), 1024, gt, nth); copyf(SMp + SM_LN + k * 2048 + 1024, PIN(gi + 1), 1024, gt, nth); }
      copyf(SMp + SM_WGF, PIN(11), 4096, gt, nth); copyf(SMp + SM_WGB, PIN(13), 4096, gt, nth); copyf(SMp + SM_BGF, PIN(12), 256, gt, nth); copyf(SMp + SM_BGB, PIN(14), 256, gt, nth);
      copyf(SMp + SM_GN, PIN(15), 128, gt, nth); copyf(SMp + SM_LNG, PIN(28), 3072, gt, nth); copyf(SMp + SM_LNB, PIN(29), 3072, gt, nth); copyf(SMp + SM_BS, PIN(31), 1024, gt, nth); }
#pragma unroll 1
    for (int f = 0; f < 4; ++f) { const int gi = f == 0 ? 2 : f == 1 ? 19 : f == 2 ? 23 : 35;
        convert_T(lds, PIN(gi), 2 * FH, DM, 2 * FH, (bf16_t*)(ws + WS_FFN + (size_t)f * 17301504), 1, nullptr);
        convert_T(lds, PIN(gi + 1), DM, FH, DM, (bf16_t*)(ws + WS_FFN + (size_t)f * 17301504 + 11534336), 0, nullptr);
    }
    convert_T(lds, PIN(6), LDP, DM, 2816, (bf16_t*)(ws + WS_WIN), 2, nullptr);
    convert_T(lds, PIN(8), 768, 768, 768, (bf16_t*)(ws + WS_UQ), 0, PIN(7));
    convert_T(lds, PIN(10), 1024, 256, 512, (bf16_t*)(ws + WS_UKN), 3, PIN(9));
    convert_T(lds, PIN(10), 1024, 256, 512, (bf16_t*)(ws + WS_UV), 4, PIN(9));
    convert_T(lds, PIN(16), DM, DM, DM, (bf16_t*)(ws + WS_WOUT), 0, nullptr);
    convert_T(lds, PIN(27), 2 * SH, DM, 2 * SH, (bf16_t*)(ws + WS_SIN), 0, nullptr);
    convert_T(lds, PIN(32), DM, SH, DM, (bf16_t*)(ws + WS_SOUT), 0, nullptr);
}

__device__ __forceinline__ void ln_phase(const float* pre, const float* g, const float* b, bf16_t* xb, float* outf) {
    const int wid = ltid() >> 6, lane = ltid() & 63;
    f32x4 gv[4], bv[4];
#pragma unroll
    for (int i = 0; i < 4; ++i) { gv[i] = *(const f32x4*)(g + 4 * lane + 256 * i); bv[i] = *(const f32x4*)(b + 4 * lane + 256 * i); }
    const int nw = gridDim.x * 8;
    for (int row = lbid() * 8 + wid; row < MTOK; row += 2 * nw) {
        const int row2 = row + nw; const bool has2 = row2 < MTOK;
        const float* pr = pre + (size_t)row * DM; const float* pr2 = pre + (size_t)(has2 ? row2 : row) * DM; f32x4 v[4], w[4]; float s = 0.f, s2 = 0.f;
#pragma unroll
        for (int i = 0; i < 4; ++i) { v[i] = *(const f32x4*)(pr + 4 * lane + 256 * i); w[i] = *(const f32x4*)(pr2 + 4 * lane + 256 * i); }
#pragma unroll
        for (int i = 0; i < 4; ++i) { s += (v[i][0] + v[i][1]) + (v[i][2] + v[i][3]); s2 += (w[i][0] + w[i][1]) + (w[i][2] + w[i][3]); }
#pragma unroll
        for (int o = 32; o >= 1; o >>= 1) { s += __shfl_xor(s, o); s2 += __shfl_xor(s2, o); }
        const float mean = s * (1.0f / 1024.0f), mean2 = s2 * (1.0f / 1024.0f); float q = 0.f, q2 = 0.f;
#pragma unroll
        for (int i = 0; i < 4; ++i) { v[i] = v[i] - mean; q += (v[i][0] * v[i][0] + v[i][1] * v[i][1]) + (v[i][2] * v[i][2] + v[i][3] * v[i][3]);
                                      w[i] = w[i] - mean2; q2 += (w[i][0] * w[i][0] + w[i][1] * w[i][1]) + (w[i][2] * w[i][2] + w[i][3] * w[i][3]); }
#pragma unroll
        for (int o = 32; o >= 1; o >>= 1) { q += __shfl_xor(q, o); q2 += __shfl_xor(q2, o); }
        const float rstd = rsqrtf(q * (1.0f / 1024.0f) + 1e-5f), rstd2 = rsqrtf(q2 * (1.0f / 1024.0f) + 1e-5f);
#pragma unroll
        for (int i = 0; i < 4; ++i) { const f32x4 y = v[i] * rstd * gv[i] + bv[i];
            if (xb) { u32x2 t; t.x = pk(y[0], y[1]); t.y = pk(y[2], y[3]); *(u32x2*)(xb + (size_t)row * DM + 4 * lane + 256 * i) = t; }
            if (outf) *(f32x4*)(outf + (size_t)row * DM + 4 * lane + 256 * i) = y; }
        if (has2) {
#pragma unroll
            for (int i = 0; i < 4; ++i) { const f32x4 y = w[i] * rstd2 * gv[i] + bv[i];
                if (xb) { u32x2 t; t.x = pk(y[0], y[1]); t.y = pk(y[2], y[3]); *(u32x2*)(xb + (size_t)row2 * DM + 4 * lane + 256 * i) = t; }
                if (outf) *(f32x4*)(outf + (size_t)row2 * DM + 4 * lane + 256 * i) = y; } }
    }
}

__device__ __forceinline__ void kr_pass(const bf16_t* P, const f32x2* ROPE, bf16_t* KR) {
    const size_t gt = (size_t)lbid() * 512 + ltid(), nth = (size_t)gridDim.x * 512;
    for (size_t i = gt; i < (size_t)MTOK * 16; i += nth) { const int row = (int)(i >> 4), j = (int)(i & 15); const int pos = tok_pos(row);
        const bf16_t* pr = P + (size_t)row * LDP + 1024; const float x1 = bflo((unsigned)pr[j]), x2 = bflo((unsigned)pr[j + 16]); const f32x2 cs = ROPE[(size_t)pos * 16 + j];
        KR[(size_t)row * 32 + j] = (bf16_t)(pk(x1 * cs.x - x2 * cs.y, 0.f) & 0xffffu); KR[(size_t)row * 32 + 16 + j] = (bf16_t)(pk(x1 * cs.y + x2 * cs.x, 0.f) & 0xffffu); }
}

#define MFMA16(a, b, c) __builtin_amdgcn_mfma_f32_16x16x32_bf16((a), (b), (c), 0, 0, 0)
__device__ __forceinline__ bf16x8 mk8(u32x2 lo, u32x2 hi) { u32x4 w; w.x = lo.x; w.y = lo.y; w.z = hi.x; w.w = hi.y; return __builtin_bit_cast(bf16x8, w); }
__device__ __forceinline__ bf16x8 pack8(f32x4 a, f32x4 b) { u32x4 w; w.x = pk(a[0], a[1]); w.y = pk(a[2], a[3]); w.z = pk(b[0], b[1]); w.w = pk(b[2], b[3]); return __builtin_bit_cast(bf16x8, w); }

__device__ __forceinline__ void attn_phase(LAS unsigned char* lds, const bf16_t* Q, const bf16_t* KN, const bf16_t* KR, const bf16_t* VT, bf16_t* O) {
    const int tid = ltid(), wid = tid >> 6, lane = tid & 63, fr = lane & 15, fq = lane >> 4;
    const int G = gridDim.x; const int L = (G % 8 == 0) ? ((lbid() & 7) * (G >> 3) + (lbid() >> 3)) : lbid();
    constexpr int KBYTES = 128 * 208, BUF = KBYTES + 64 * 272;
    for (int it = L; it < 3072; it += G) {
        int h, S, row0, qb;
        if (it < 2048) { const int pair = it >> 4; qb = it & 15; h = pair & 7; S = 4096; row0 = NPROMPT + (pair >> 3) * 4096; }
        else { const int j = it - 2048, pair = j >> 3; qb = j & 7; h = pair & 7; S = 2048; row0 = (pair >> 3) * 2048; }
        const int qrow0 = row0 + qb * 256 + wid * 32;
        bf16x8 Qf[2][3];
#pragma unroll
        for (int qf = 0; qf < 2; ++qf)
#pragma unroll
            for (int ks = 0; ks < 3; ++ks) Qf[qf][ks] = *(const bf16x8*)(Q + (size_t)(qrow0 + 16 * qf + fr) * 768 + h * 96 + 32 * ks + 8 * fq);
        f32x4 Oacc[2][4];
#pragma unroll
        for (int qf = 0; qf < 2; ++qf)
#pragma unroll
            for (int nb = 0; nb < 4; ++nb) Oacc[qf][nb] = (f32x4){0.f, 0.f, 0.f, 0.f};
        float mi[2] = {-1e30f, -1e30f}, li[2] = {0.f, 0.f};
        const int nt = S / 128;
        const bf16_t* ksrc[3]; int kstep[3], kdst[3]; const bf16_t* vsrc[2]; int vdst[2];
#pragma unroll
        for (int i = 0; i < 3; ++i) { const int pp = tid + 512 * i, key = pp / 12, part = pp % 12;
            ksrc[i] = part < 8 ? KN + (size_t)(row0 + key) * 512 + h * 64 + part * 8 : KR + (size_t)(row0 + key) * 32 + (part - 8) * 8;
            kstep[i] = part < 8 ? 128 * 512 : 128 * 32; kdst[i] = key * 208 + part * 16; }
#pragma unroll
        for (int i = 0; i < 2; ++i) { const int pp = tid + 512 * i, dv = pp >> 4, seg = pp & 15;
            vsrc[i] = VT + (size_t)(h * 64 + dv) * MTOK + row0 + seg * 8; vdst[i] = KBYTES + dv * 272 + seg * 16; }
        u32x4 rk[3], rv[2];
#pragma unroll
        for (int i = 0; i < 3; ++i) rk[i] = *(const u32x4*)ksrc[i];
#pragma unroll
        for (int i = 0; i < 2; ++i) rv[i] = *(const u32x4*)vsrc[i];
#pragma unroll
        for (int i = 0; i < 3; ++i) *(LAS u32x4*)(lds + kdst[i]) = rk[i];
#pragma unroll
        for (int i = 0; i < 2; ++i) *(LAS u32x4*)(lds + vdst[i]) = rv[i];
        __syncthreads();
        for (int t = 0; t < nt; ++t) {
            const bool pf = (t + 1 < nt);
            if (pf) {
#pragma unroll
                for (int i = 0; i < 3; ++i) rk[i] = *(const u32x4*)(ksrc[i] + (size_t)(t + 1) * kstep[i]);
#pragma unroll
                for (int i = 0; i < 2; ++i) rv[i] = *(const u32x4*)(vsrc[i] + (size_t)(t + 1) * 128);
            }
#pragma unroll 1
            for (int sub = 0; sub < 2; ++sub) {
                LAS unsigned char* kb_ = lds + (t & 1) * BUF + sub * (64 * 208); LAS unsigned char* vb_ = lds + (t & 1) * BUF + KBYTES + sub * 128;
                bf16x8 Pf[2][2];
                {
                    bf16x8 Kf[4][3];
#pragma unroll
                    for (int kb = 0; kb < 4; ++kb)
#pragma unroll
                        for (int ks = 0; ks < 3; ++ks) Kf[kb][ks] = *(const LAS bf16x8*)(kb_ + (16 * kb + fr) * 208 + (32 * ks + 8 * fq) * 2);
#pragma unroll
                    for (int qf = 0; qf < 2; ++qf) {
                        f32x4 s[4];
#pragma unroll
                        for (int kb = 0; kb < 4; ++kb) { s[kb] = (f32x4){0.f, 0.f, 0.f, 0.f};
#pragma unroll
                            for (int ks = 0; ks < 3; ++ks) s[kb] = MFMA16(Kf[kb][ks], Qf[qf][ks], s[kb]); }
                        float mx = -1e30f;
#pragma unroll
                        for (int kb = 0; kb < 4; ++kb) mx = fmaxf(mx, fmaxf(fmaxf(s[kb][0], s[kb][1]), fmaxf(s[kb][2], s[kb][3])));
                        mx = fmaxf(mx, __shfl_xor(mx, 16)); mx = fmaxf(mx, __shfl_xor(mx, 32));
                        const float mn = fmaxf(mi[qf], mx), al = fexp2(mi[qf] - mn); mi[qf] = mn;
                        float ps = 0.f;
#pragma unroll
                        for (int kb = 0; kb < 4; ++kb)
#pragma unroll
                            for (int j = 0; j < 4; ++j) { const float pv = fexp2(s[kb][j] - mn); s[kb][j] = pv; ps += pv; }
                        li[qf] = li[qf] * al + ps;
#pragma unroll
                        for (int nb = 0; nb < 4; ++nb) Oacc[qf][nb] = Oacc[qf][nb] * al;
                        Pf[qf][0] = pack8(s[0], s[1]); Pf[qf][1] = pack8(s[2], s[3]);
                    }
                }
#pragma unroll
                for (int nb = 0; nb < 4; ++nb)
#pragma unroll
                    for (int c = 0; c < 2; ++c) {
                        const u32x2 lo = *(const LAS u32x2*)(vb_ + (16 * nb + fr) * 272 + (32 * c + 4 * fq) * 2), hi = *(const LAS u32x2*)(vb_ + (16 * nb + fr) * 272 + (32 * c + 16 + 4 * fq) * 2);
                        const bf16x8 Vf = mk8(lo, hi);
#pragma unroll
                        for (int qf = 0; qf < 2; ++qf) Oacc[qf][nb] = MFMA16(Vf, Pf[qf][c], Oacc[qf][nb]);
                    }
            }
            if (pf) { LAS unsigned char* nb_ = lds + ((t + 1) & 1) * BUF;
#pragma unroll
                for (int i = 0; i < 3; ++i) *(LAS u32x4*)(nb_ + kdst[i]) = rk[i];
#pragma unroll
                for (int i = 0; i < 2; ++i) *(LAS u32x4*)(nb_ + vdst[i]) = rv[i]; }
            __syncthreads();
        }
#pragma unroll
        for (int qf = 0; qf < 2; ++qf) { float l = li[qf]; l += __shfl_xor(l, 16); l += __shfl_xor(l, 32); const float inv = 1.0f / l; const int row = qrow0 + 16 * qf + fr;
#pragma unroll
            for (int nb = 0; nb < 4; ++nb) { const f32x4 o = Oacc[qf][nb] * inv; u32x2 w; w.x = pk(o[0], o[1]); w.y = pk(o[2], o[3]); *(u32x2*)(O + (size_t)row * LDP + h * 64 + 16 * nb + 4 * fq) = w; } }
    }
}

constexpr int GL_QF = 0, GL_KF = 9216, GL_QB = 18432, GL_KB = 27648, GL_KSF = 36864, GL_KSB = 46080, GL_VT = 55296, GL_RED = 73728;
constexpr int GL_W = 74752;
__device__ __forceinline__ void gla_stage_w(LAS unsigned char* lds, const float* SMp) {
    const int tid = ltid(); LAS float* w = (LAS float*)(lds + GL_W);
    for (int i = tid; i < 4096; i += 512) { w[i] = SMp[SM_WGF + i]; w[4096 + i] = SMp[SM_WGB + i]; }
    if (tid < 256) { w[8192 + tid] = SMp[SM_BGF + tid]; w[8448 + tid] = SMp[SM_BGB + tid]; }
    __syncthreads();
}
__device__ __forceinline__ float dpp_add(float x, float v, const int ctrl, const int row_mask) {
    return x; }
#define DPP_STEP(x, ctrl, rmask) x = x + __int_as_float(__builtin_amdgcn_update_dpp(0, __float_as_int(x), ctrl, rmask, 0xf, false))
__device__ __forceinline__ float wave_incl_scan(float x, int lane) {
    DPP_STEP(x, 0x111, 0xf); DPP_STEP(x, 0x112, 0xf); DPP_STEP(x, 0x114, 0xf); DPP_STEP(x, 0x118, 0xf);
    DPP_STEP(x, 0x142, 0xa); DPP_STEP(x, 0x143, 0xc);
    return x;
}
__device__ __forceinline__ float logsig(float x) { return fminf(x, 0.f) - __logf(1.0f + __expf(-fabsf(x))); }
__device__ __forceinline__ void gla_prep(LAS unsigned char* lds, const bf16_t* P, int c, int h, float* DEC, bool wdec) {
    const int tid = ltid(), wid = tid >> 6, lane = tid & 63;
    const bf16_t* prow = P + (size_t)(c * 64 + lane) * LDP;
    float zf[16], zb[16];
    { const u32x4 a = *(const u32x4*)(prow + 2592), b = *(const u32x4*)(prow + 2600), c2 = *(const u32x4*)(prow + 2608), d = *(const u32x4*)(prow + 2616);
      const unsigned wa[8] = {a.x, a.y, a.z, a.w, b.x, b.y, b.z, b.w}, wb[8] = {c2.x, c2.y, c2.z, c2.w, d.x, d.y, d.z, d.w};
#pragma unroll
      for (int i = 0; i < 8; ++i) { zf[2 * i] = bflo(wa[i]); zf[2 * i + 1] = bfhi(wa[i]); zb[2 * i] = bflo(wb[i]); zb[2 * i + 1] = bfhi(wb[i]); } }
    float qv[8], kv[8];
    { const u32x4 a = *(const u32x4*)(prow + 1056 + h * 64 + 8 * wid), b = *(const u32x4*)(prow + 1312 + h * 64 + 8 * wid);
      const unsigned wa[4] = {a.x, a.y, a.z, a.w}, wb[4] = {b.x, b.y, b.z, b.w};
#pragma unroll
      for (int i = 0; i < 4; ++i) { qv[2 * i] = bflo(wa[i]) * 0.125f; qv[2 * i + 1] = bfhi(wa[i]) * 0.125f; kv[2 * i] = bflo(wb[i]); kv[2 * i + 1] = bfhi(wb[i]); } }
    float af[8], ab[8];
    { const LAS float* wl = (const LAS float*)(lds + GL_W) + h * 64 + 8 * wid;
      const f32x4 b0 = *(const LAS f32x4*)(wl + 8192), b1 = *(const LAS f32x4*)(wl + 8196), b2 = *(const LAS f32x4*)(wl + 8448), b3 = *(const LAS f32x4*)(wl + 8452);
#pragma unroll
      for (int i = 0; i < 4; ++i) { af[i] = b0[i]; af[4 + i] = b1[i]; ab[i] = b2[i]; ab[4 + i] = b3[i]; }
#pragma unroll
      for (int r = 0; r < 16; ++r) { const f32x4 f0 = *(const LAS f32x4*)(wl + r * 256), f1 = *(const LAS f32x4*)(wl + r * 256 + 4), g0 = *(const LAS f32x4*)(wl + 4096 + r * 256), g1 = *(const LAS f32x4*)(wl + 4096 + r * 256 + 4);
#pragma unroll
          for (int i = 0; i < 4; ++i) { af[i] += zf[r] * f0[i]; af[4 + i] += zf[r] * f1[i]; ab[i] += zb[r] * g0[i]; ab[4 + i] += zb[r] * g1[i]; } } }
    float oqf[8], okf[8], oqb[8], okb[8]; float tsf = 0.f, tsb = 0.f;
#pragma unroll
    for (int dd = 0; dd < 8; ++dd) {
        const int d = 8 * wid + dd;
        const float laf = logsig(af[dd]) * 0.0625f, lab = logsig(ab[dd]) * 0.0625f;
        const float pf = wave_incl_scan(laf, lane), pb = wave_incl_scan(lab, lane);
        const float totf = __shfl(pf, 63), totb = __shfl(pb, 63);
        const float sb = totb - pb + lab;
        if (!wdec) {
            oqf[dd] = qv[dd] * __expf(pf); okf[dd] = kv[dd] * __expf(-pf);
            oqb[dd] = qv[dd] * __expf(sb); okb[dd] = kv[dd] * __expf(-sb);
        } else {
            const float ksf = kv[dd] * __expf(totf - pf), ksb = kv[dd] * __expf(totb - sb);
            *(LAS bf16_t*)(lds + GL_KSF + (d * 72 + lane) * 2) = (bf16_t)(pk(ksf, 0.f) & 0xffffu);
            *(LAS bf16_t*)(lds + GL_KSB + (d * 72 + lane) * 2) = (bf16_t)(pk(ksb, 0.f) & 0xffffu);
            tsf = (lane == dd) ? totf : tsf; tsb = (lane == dd) ? totb : tsb;
        }
    }
    if (wdec && lane < 8) { DEC[((size_t)(c * 4 + h) * 2 + 0) * 64 + 8 * wid + lane] = __expf(tsf); DEC[((size_t)(c * 4 + h) * 2 + 1) * 64 + 8 * wid + lane] = __expf(tsb); }
    if (!wdec) { u32x4 w; const int off = (lane * 72 + 8 * wid) * 2;
      w.x = pk(oqf[0], oqf[1]); w.y = pk(oqf[2], oqf[3]); w.z = pk(oqf[4], oqf[5]); w.w = pk(oqf[6], oqf[7]); *(LAS u32x4*)(lds + GL_QF + off) = w;
      w.x = pk(okf[0], okf[1]); w.y = pk(okf[2], okf[3]); w.z = pk(okf[4], okf[5]); w.w = pk(okf[6], okf[7]); *(LAS u32x4*)(lds + GL_KF + off) = w;
      w.x = pk(oqb[0], oqb[1]); w.y = pk(oqb[2], oqb[3]); w.z = pk(oqb[4], oqb[5]); w.w = pk(oqb[6], oqb[7]); *(LAS u32x4*)(lds + GL_QB + off) = w;
      w.x = pk(okb[0], okb[1]); w.y = pk(okb[2], okb[3]); w.z = pk(okb[4], okb[5]); w.w = pk(okb[6], okb[7]); *(LAS u32x4*)(lds + GL_KB + off) = w; }
    { const int tp = tid >> 4, eg = tid & 15; const bf16_t* v0 = P + (size_t)(c * 64 + 2 * tp) * LDP + 1568 + h * 128 + 8 * eg;
      const u32x4 a = *(const u32x4*)v0, b = *(const u32x4*)(v0 + LDP); const unsigned wa[4] = {a.x, a.y, a.z, a.w}, wb[4] = {b.x, b.y, b.z, b.w};
      const int pcol = (4 * ((tp >> 2) ^ (eg & 7)) + (tp & 3)) * 4;
#pragma unroll
      for (int i = 0; i < 4; ++i) { *(LAS unsigned*)(lds + GL_VT + (8 * eg + 2 * i) * 144 + pcol) = (wa[i] & 0xffffu) | (wb[i] << 16);
                                    *(LAS unsigned*)(lds + GL_VT + (8 * eg + 2 * i + 1) * 144 + pcol) = (wa[i] >> 16) | (wb[i] & 0xffff0000u); } }
    __syncthreads();
}
__device__ __forceinline__ void gla_phaseA(LAS unsigned char* lds, const float* SMp, const bf16_t* P, bf16_t* ST, float* DEC) {
    const int tid = ltid(), wid = tid >> 6, lane = tid & 63, fr = lane & 15, fq = lane >> 4;
    gla_stage_w(lds, SMp);
    for (int it = lbid(); it < 1536 * 4; it += gridDim.x) {
        const int c = it >> 2, h = it & 3;
        gla_prep(lds, P, c, h, DEC, true);
        const int dir = wid >> 2, db = wid & 3; const int KS = dir ? GL_KSB : GL_KSF;
        bf16x8 a[2];
#pragma unroll
        for (int ks = 0; ks < 2; ++ks) a[ks] = *(const LAS bf16x8*)(lds + KS + ((16 * db + fr) * 72 + 32 * ks + 8 * fq) * 2);
        bf16_t* st = ST + ((size_t)(c * 4 + h) * 2 + dir) * 8192;
#pragma unroll
        for (int eb = 0; eb < 8; ++eb) { f32x4 acc = (f32x4){0.f, 0.f, 0.f, 0.f};
#pragma unroll
            for (int ks = 0; ks < 2; ++ks) { const int r = 16 * eb + fr; const bf16x8 b = *(const LAS bf16x8*)(lds + GL_VT + r * 144 + (((4 * ks + fq) ^ ((r >> 3) & 7)) * 16)); acc = MFMA16(a[ks], b, acc); }
            u32x2 w; w.x = pk(acc[0], acc[1]); w.y = pk(acc[2], acc[3]); *(u32x2*)(st + (16 * eb + fr) * 64 + 16 * db + 4 * fq) = w; }
        __syncthreads();
    }
}
__device__ __forceinline__ void gla_scan(bf16_t* ST, const float* DEC) {
    const int total = 32 * 8192;
    for (int tix = lbid() * 512 + ltid(); tix < total; tix += gridDim.x * 512) {
        const int piece = tix & 1023, dir = (tix >> 10) & 1, h = (tix >> 11) & 3, b = tix >> 13;
        const int N = b < 16 ? 32 : 64, c0 = b < 16 ? b * 32 : 512 + (b - 16) * 64, d0 = (piece & 7) * 8;
        float S[8];
#pragma unroll
        for (int i = 0; i < 8; ++i) S[i] = 0.f;
        for (int n = 0; n < N; n += 4) {
            u32x4 raw[4]; f32x4 e0[4], e1[4]; u32x4* ptr[4];
#pragma unroll
            for (int u = 0; u < 4; ++u) { const int c = dir ? c0 + N - 1 - (n + u) : c0 + n + u; const size_t base = (size_t)(c * 4 + h) * 2 + dir;
                ptr[u] = (u32x4*)(ST + base * 8192 + piece * 8); raw[u] = *ptr[u]; e0[u] = *(const f32x4*)(DEC + base * 64 + d0); e1[u] = *(const f32x4*)(DEC + base * 64 + d0 + 4); }
#pragma unroll
            for (int u = 0; u < 4; ++u) {
                u32x4 w; w.x = pk(S[0], S[1]); w.y = pk(S[2], S[3]); w.z = pk(S[4], S[5]); w.w = pk(S[6], S[7]); *ptr[u] = w;
                S[0] = e0[u][0] * S[0] + bflo(raw[u].x); S[1] = e0[u][1] * S[1] + bfhi(raw[u].x); S[2] = e0[u][2] * S[2] + bflo(raw[u].y); S[3] = e0[u][3] * S[3] + bfhi(raw[u].y);
                S[4] = e1[u][0] * S[4] + bflo(raw[u].z); S[5] = e1[u][1] * S[5] + bfhi(raw[u].z); S[6] = e1[u][2] * S[6] + bflo(raw[u].w); S[7] = e1[u][3] * S[7] + bfhi(raw[u].w); }
        }
    }
}
__device__ __forceinline__ void gla_phaseC(LAS unsigned char* lds, const float* SMp, bf16_t* P, const bf16_t* ST) {
    const int tid = ltid(), wid = tid >> 6, lane = tid & 63, fr = lane & 15, fq = lane >> 4;
    const float* gnorm = SMp + SM_GN;
    gla_stage_w(lds, SMp);
    for (int it = lbid(); it < 1536 * 4; it += gridDim.x) {
        const int c = it >> 2, h = it & 3;
        gla_prep(lds, P, c, h, nullptr, false);
        const int tb = wid & 3, eh = wid >> 2;
        f32x4 acc[4];
#pragma unroll
        for (int i = 0; i < 4; ++i) acc[i] = (f32x4){0.f, 0.f, 0.f, 0.f};
#pragma unroll
        for (int dir = 0; dir < 2; ++dir) {
            const int Qs = dir ? GL_QB : GL_QF, Ks = dir ? GL_KB : GL_KF;
            bf16x8 qf[2];
#pragma unroll
            for (int ks = 0; ks < 2; ++ks) qf[ks] = *(const LAS bf16x8*)(lds + Qs + ((16 * tb + fr) * 72 + 32 * ks + 8 * fq) * 2);
            f32x4 as[4];
#pragma unroll
            for (int sb = 0; sb < 4; ++sb) { as[sb] = (f32x4){0.f, 0.f, 0.f, 0.f};
#pragma unroll
                for (int ks = 0; ks < 2; ++ks) { const bf16x8 kf = *(const LAS bf16x8*)(lds + Ks + ((16 * sb + fr) * 72 + 32 * ks + 8 * fq) * 2); as[sb] = MFMA16(kf, qf[ks], as[sb]); }
#pragma unroll
                for (int j = 0; j < 4; ++j) { const int si = 16 * sb + 4 * fq + j, ti = 16 * tb + fr; const bool keep = dir ? (si > ti) : (si <= ti); as[sb][j] = keep ? as[sb][j] : 0.f; } }
            bf16x8 Pf[2]; Pf[0] = pack8(as[0], as[1]); Pf[1] = pack8(as[2], as[3]);
            const bf16_t* st = ST + ((size_t)(c * 4 + h) * 2 + dir) * 8192;
#pragma unroll
            for (int i = 0; i < 4; ++i) { const int e0 = 16 * (4 * eh + i) + fr;
#pragma unroll
                for (int cc = 0; cc < 2; ++cc) { const int sw = (e0 >> 3) & 7; const u32x2 lo = *(const LAS u32x2*)(lds + GL_VT + e0 * 144 + (((4 * cc + (fq >> 1)) ^ sw) * 16) + 8 * (fq & 1)), hi = *(const LAS u32x2*)(lds + GL_VT + e0 * 144 + (((4 * cc + 2 + (fq >> 1)) ^ sw) * 16) + 8 * (fq & 1));
                    acc[i] = MFMA16(mk8(lo, hi), Pf[cc], acc[i]); }
#pragma unroll
                for (int ks = 0; ks < 2; ++ks) { const bf16x8 sf = *(const bf16x8*)(st + e0 * 64 + 32 * ks + 8 * fq); acc[i] = MFMA16(sf, qf[ks], acc[i]); } }
        }
        float ss = 0.f;
#pragma unroll
        for (int i = 0; i < 4; ++i) ss += (acc[i][0] * acc[i][0] + acc[i][1] * acc[i][1]) + (acc[i][2] * acc[i][2] + acc[i][3] * acc[i][3]);
        ss += __shfl_xor(ss, 16); ss += __shfl_xor(ss, 32);
        LAS float* red = (LAS float*)(lds + GL_RED);
        if (fq == 0) red[eh * 64 + 16 * tb + fr] = ss;
        __syncthreads();
        const float tot = red[16 * tb + fr] + red[64 + 16 * tb + fr];
        const float rs = rsqrtf(tot * (1.0f / 128.0f) + 1e-6f);
        const int row = c * 64 + 16 * tb + fr; bf16_t* prow = P + (size_t)row * LDP;
#pragma unroll
        for (int i = 0; i < 4; ++i) { const int e = 16 * (4 * eh + i) + 4 * fq; const f32x4 g = *(const f32x4*)(gnorm + e); const u32x2 rr = *(const u32x2*)(prow + 2080 + h * 128 + e);
            const float o0 = acc[i][0] * rs * g[0] * silu(bflo(rr.x)), o1 = acc[i][1] * rs * g[1] * silu(bfhi(rr.x)), o2 = acc[i][2] * rs * g[2] * silu(bflo(rr.y)), o3 = acc[i][3] * rs * g[3] * silu(bfhi(rr.y));
            u32x2 w; w.x = pk(o0, o1); w.y = pk(o2, o3); *(u32x2*)(prow + 512 + h * 128 + e) = w; }
        __syncthreads();
    }
}

__device__ __forceinline__ void sgu_phase(LAS unsigned char* lds, bf16_t* V, const f32x2* STATS, const float* lng, const float* lnb, const bf16_t* Ws, const float* bs) {
    const int tid = ltid(), wid = tid >> 6, lane = tid & 63, fr = lane & 15, fq = lane >> 4;
    LAS float* MU = (LAS float*)(lds + 104448); LAS float* RS = (LAS float*)(lds + 104960);
    for (int unit = lbid(); unit < 6144; unit += gridDim.x) {
        const int ck = unit >> 3, g = unit & 7, cbase = g * 384, row0 = ck * 128;
        const int t0 = 16 * wid;
        bf16x8 Wf[4];
#pragma unroll
        for (int ks = 0; ks < 4; ++ks) Wf[ks] = *(const bf16x8*)(Ws + (size_t)(g * 128 + t0 + fr) * 128 + 32 * ks + 8 * fq);
        const float bias = bs[g * 128 + t0 + fr];
        if (tid < 128) { const f32x4* sp = (const f32x4*)(STATS + (size_t)(row0 + tid) * 48); float s1 = 0.f, s2 = 0.f;
#pragma unroll
            for (int i = 0; i < 24; ++i) { const f32x4 v = sp[i]; s1 += v[0] + v[2]; s2 += v[1] + v[3]; }
            const float mean = s1 * (1.0f / 3072.0f), var = s2 * (1.0f / 3072.0f) - mean * mean; MU[tid] = mean; RS[tid] = rsqrtf(fmaxf(var, 0.f) + 1e-5f); }
        __syncthreads();
#pragma unroll
        for (int i = 0; i < 6; ++i) { const int id = tid + 512 * i, rest = id >> 6, cg = (rest % 6) * 8 + (id & 7), tp = (rest / 6) * 8 + ((id >> 3) & 7); const int c = cbase + 8 * cg, r0 = row0 + 2 * tp;
            const int pcol = (4 * ((tp >> 2) ^ (cg & 7)) + (tp & 3)) * 4;
            const u32x4 a = *(const u32x4*)(V + (size_t)r0 * SH + c), b = *(const u32x4*)(V + (size_t)(r0 + 1) * SH + c);
            const f32x4 g0 = *(const f32x4*)(lng + c), g1 = *(const f32x4*)(lng + c + 4), b0 = *(const f32x4*)(lnb + c), b1 = *(const f32x4*)(lnb + c + 4);
            const float mu0 = MU[2 * tp], rs0 = RS[2 * tp], mu1 = MU[2 * tp + 1], rs1 = RS[2 * tp + 1];
            const unsigned wa[4] = {a.x, a.y, a.z, a.w}, wb[4] = {b.x, b.y, b.z, b.w}; const float gg[8] = {g0[0], g0[1], g0[2], g0[3], g1[0], g1[1], g1[2], g1[3]}, bb[8] = {b0[0], b0[1], b0[2], b0[3], b1[0], b1[1], b1[2], b1[3]};
#pragma unroll
            for (int e = 0; e < 4; ++e) {
                const float x0 = (bflo(wa[e]) - mu0) * rs0 * gg[2 * e] + bb[2 * e], x1 = (bflo(wb[e]) - mu1) * rs1 * gg[2 * e] + bb[2 * e];
                const float y0 = (bfhi(wa[e]) - mu0) * rs0 * gg[2 * e + 1] + bb[2 * e + 1], y1 = (bfhi(wb[e]) - mu1) * rs1 * gg[2 * e + 1] + bb[2 * e + 1];
                *(LAS unsigned*)(lds + (8 * cg + 2 * e) * 272 + pcol) = pk(x0, x1); *(LAS unsigned*)(lds + (8 * cg + 2 * e + 1) * 272 + pcol) = pk(y0, y1); } }
        __syncthreads();
        bf16_t* orow = V + (size_t)(row0 + t0 + fr) * SH + cbase + 4 * fq;
#pragma unroll
        for (int cb = 0; cb < 24; ++cb) { f32x4 acc = (f32x4){0.f, 0.f, 0.f, 0.f};
#pragma unroll
            for (int ks = 0; ks < 4; ++ks) { const int r = 16 * cb + fr; const bf16x8 a = *(const LAS bf16x8*)(lds + r * 272 + (((4 * ks + fq) ^ ((r >> 3) & 7)) * 16)); acc = MFMA16(a, Wf[ks], acc); }
            u32x2 w; w.x = pk(acc[0] + bias, acc[1] + bias); w.y = pk(acc[2] + bias, acc[3] + bias); *(u32x2*)(orow + 16 * cb) = w; }
        __syncthreads();
    }
}

#define ON(k) (((PM) >> (k)) & 1)
enum { K_G1 = 0, K_G2, K_LN, K_G3, K_G45, K_ATT, K_GLAC, K_MIX0, K_G7, K_SGU, K_G8, K_MIX1, K_G5A, K_G5B, K_GLAA };
constexpr int NSTEPS = 20;
__device__ __forceinline__ void step_info(int st, int& kind, int& arg, bool& sync) {
    sync = true;
    switch (st) {
        case 0: kind = K_G1; arg = 0; break; case 1: kind = K_G2; arg = 0; break;
        case 2: kind = K_G3; arg = 0; break;
        case 3: kind = K_G45; arg = 0; sync = false; break; case 4: kind = K_G5A; arg = 0; sync = false; break; case 5: kind = K_G5B; arg = 0; sync = false; break; case 6: kind = K_GLAA; arg = 0; break;
        case 7: kind = K_ATT; arg = 0; break; case 8: kind = K_GLAC; arg = 0; break; case 9: kind = K_MIX0; arg = 0; break;
        case 10: kind = K_G1; arg = 1; break; case 11: kind = K_G2; arg = 1; break;
        case 12: kind = K_G1; arg = 2; break; case 13: kind = K_G2; arg = 2; break;
        case 14: kind = K_G7; arg = 0; break; case 15: kind = K_SGU; arg = 0; break; case 16: kind = K_G8; arg = 0; break; case 17: kind = K_MIX1; arg = 0; break;
        case 18: kind = K_G1; arg = 3; break; default: kind = K_G2; arg = 3; break;
    }
}

__device__ __forceinline__ void grid_barrier(unsigned* bar, unsigned target) {
    asm volatile("s_waitcnt vmcnt(0) lgkmcnt(0)" ::: "memory");
    __syncthreads();
    if (threadIdx.x == 0) {
        __builtin_amdgcn_fence(__ATOMIC_RELEASE, "agent");
        asm volatile("s_waitcnt vmcnt(0)" ::: "memory");
        __hip_atomic_fetch_add(bar, 1u, __ATOMIC_RELAXED, __HIP_MEMORY_SCOPE_AGENT);
        while (__hip_atomic_load(bar, __ATOMIC_RELAXED, __HIP_MEMORY_SCOPE_AGENT) < target) __builtin_amdgcn_s_sleep(1);
        __builtin_amdgcn_fence(__ATOMIC_ACQUIRE, "agent");
        asm volatile("s_waitcnt vmcnt(0)" ::: "memory");
    }
    __syncthreads();
}
#define GSYNC(base) do { ++nbar; grid_barrier((unsigned*)((base) + WS_BAR), nbar * gridDim.x); } while (0)
__global__ void __launch_bounds__(512, 2) mega(Params p) {
    extern __shared__ __attribute__((aligned(16))) unsigned char shm[];
    LAS unsigned char* lds = (LAS unsigned char*)shm;
    cg::grid_group grid = cg::this_grid();
    if (ON(15)) phase0(lds, p);
    unsigned nbar = 0;
    grid.sync(); __builtin_amdgcn_fence(__ATOMIC_ACQUIRE, "agent"); asm volatile("s_waitcnt vmcnt(0)" ::: "memory");
#pragma unroll 1
    for (int st = 0; st < NSTEPS; ++st) {
        size_t zoff = 0; asm volatile("" : "+s"(zoff));
        unsigned char* ws = p.ws + zoff; unsigned char* dout = (unsigned char*)p.out + zoff;
        bf16_t* XB = (bf16_t*)(ws + WS_XB); bf16_t* R = (bf16_t*)(ws + WS_R); float* PRE = (float*)dout;
        bf16_t* ST = (bf16_t*)(ws + WS_ST); float* DEC = (float*)(ws + WS_DEC); float* SSQ = (float*)(ws + WS_SSQ); f32x2* STATS = (f32x2*)(ws + WS_STATS);
        bf16_t* Qb = (bf16_t*)(dout + DO_Q); bf16_t* KN = (bf16_t*)(dout + DO_KN); bf16_t* VT = (bf16_t*)(dout + DO_VT); bf16_t* KR = (bf16_t*)(dout + DO_KR);
        const f32x2* ROPE = (const f32x2*)(ws + WS_ROPE); const float* SMp = (const float*)(ws + WS_SMALL);
        int kind, arg; bool dosync; step_info(st, kind, arg, dosync);
        switch (kind) {
            case K_G1: if (ON(K_G1)) { EpiSwiglu E; E.H = R; const int rep = ((DUP & 4) && arg == 0) ? 2 : 1; for (int rr = 0; rr < rep; ++rr) run_gemm(lds, XB, DM, (const bf16_t*)(ws + WS_FFN + (size_t)arg * 17301504), DM, MTOK, 2 * FH, DM, E); } break;
            case K_G2: case K_MIX0: case K_MIX1: if (ON(K_G2)) { EpiLn E;
                const bf16_t* Bt; int lda, K, inst; float cs;
                if (kind == K_G2) { Bt = (const bf16_t*)(ws + WS_FFN + (size_t)arg * 17301504 + 11534336); lda = FH; K = FH; cs = 0.5f; inst = arg == 0 ? 0 : arg == 1 ? 2 : arg == 2 ? 3 : 5; }
                else if (kind == K_MIX0) { Bt = (const bf16_t*)(ws + WS_WOUT); lda = LDP; K = DM; cs = 1.0f; inst = 1; }
                else { Bt = (const bf16_t*)(ws + WS_SOUT); lda = SH; K = SH; cs = 1.0f; inst = 4; }
                E.XB = XB; E.OUTF = inst == 5 ? PRE : nullptr; E.G = SMp + SM_LN + inst * 2048; E.B = E.G + 1024; E.cs = cs;
                E.SLOT = (unsigned long long*)(ws + WS_SLOT); E.CNT = (unsigned*)(ws + WS_CNT) + (size_t)inst * 384 * 2 * 16;
                run_gemm(lds, R, lda, Bt, K, MTOK, DM, K, E); } break;
            case K_G3: if (ON(K_G3)) { EpiWin E; E.P = R; E.SSQ = SSQ; run_gemm(lds, XB, DM, (const bf16_t*)(ws + WS_WIN), DM, MTOK, 2816, DM, E); } break;
            case K_G45: if (ON(K_G45)) { kr_pass(R, ROPE, KR);
                EpiQ E; E.Q = Qb; E.SSQ = SSQ; E.ROPE = ROPE; run_gemm(lds, R, LDP, (const bf16_t*)(ws + WS_UQ), 768, MTOK, 768, 768, E); } break;
            case K_G5A: if (ON(K_G5A)) { EpiKN E; E.KN = KN; E.SSQ = SSQ; run_gemm(lds, R + 768, LDP, (const bf16_t*)(ws + WS_UKN), 256, MTOK, 512, 256, E); } break;
            case K_G5B: if (ON(K_G5B)) { EpiVT E; E.VT = VT; E.SSQ = SSQ; run_gemm(lds, (const bf16_t*)(ws + WS_UV), 256, R + 768, LDP, 512, MTOK, 256, E); } break;
            case K_GLAA: if (ON(K_GLAA)) { __syncthreads(); gla_phaseA(lds, SMp, R, ST, DEC); if (DUP & 2) gla_phaseA(lds, SMp, R, ST, DEC); } break;
            case K_ATT: if (ON(K_ATT)) { attn_phase(lds, Qb, KN, KR, VT, R); if (DUP & 1) { __syncthreads(); attn_phase(lds, Qb, KN, KR, VT, R); } gla_scan(ST, DEC); } break;
            case K_GLAC: if (ON(K_GLAC)) { gla_phaseC(lds, SMp, R, ST); if (DUP & 2) gla_phaseC(lds, SMp, R, ST); } break;
            case K_G7: if (ON(K_G7)) { EpiSguV E; E.V = R; E.STATS = STATS; run_gemm(lds, XB, DM, (const bf16_t*)(ws + WS_SIN) + (size_t)SH * DM, DM, MTOK, SH, DM, E); } break;
            case K_SGU: if (ON(K_SGU)) { sgu_phase(lds, R, STATS, SMp + SM_LNG, SMp + SM_LNB, (const bf16_t*)(ws + WS_WS), SMp + SM_BS); } break;
            case K_G8: if (ON(K_G8)) { EpiSguU E; E.V = R; run_gemm(lds, XB, DM, (const bf16_t*)(ws + WS_SIN), DM, MTOK, SH, DM, E); } break;
            default: break;
        }
        if (dosync) GSYNC(ws);
    }
}

constexpr int LDS_BYTES = 131072;
extern "C" void kernel_launch(void* const* d_in, const int* in_sizes, int n_in, void* d_out, int out_size, void* d_ws, size_t ws_size, hipStream_t stream) {
    static int grid_blocks = 0;
    if (!grid_blocks) {
        int dev = 0, cus = 0, per_cu = 0;
        (void)hipGetDevice(&dev);
        (void)hipDeviceGetAttribute(&cus, hipDeviceAttributeMultiprocessorCount, dev);
        (void)hipFuncSetAttribute((const void*)mega, hipFuncAttributeMaxDynamicSharedMemorySize, LDS_BYTES);
        (void)hipOccupancyMaxActiveBlocksPerMultiprocessor(&per_cu, (const void*)mega, 512, LDS_BYTES);
        if (per_cu < 1) per_cu = 1;
        grid_blocks = cus * per_cu;
        if (grid_blocks > 256) grid_blocks = 256;
    }
    Params p{};
    for (int i = 0; i < 39; ++i) p.in[i] = (const float*)d_in[i];
    p.out = (float*)d_out; p.ws = (unsigned char*)d_ws;
    void* args[] = {&p};
    hipError_t e = hipLaunchCooperativeKernel((const void*)mega, dim3(grid_blocks), dim3(512), args, LDS_BYTES, stream);
    if (e != hipSuccess) fprintf(stderr, "cooperative launch failed: %s (grid %d)\n", hipGetErrorString(e), grid_blocks);
}
```

```cpp
#include <hip/hip_runtime.h>
#include <hip/hip_cooperative_groups.h>
#include <cstdio>
namespace cg = cooperative_groups;

#define LAS __attribute__((address_space(3)))
typedef unsigned short bf16_t;
typedef short bf16x8 __attribute__((ext_vector_type(8)));
typedef float f32x4 __attribute__((ext_vector_type(4)));
typedef float f32x2 __attribute__((ext_vector_type(2)));
typedef unsigned u32x4 __attribute__((ext_vector_type(4)));
typedef unsigned u32x2 __attribute__((ext_vector_type(2)));

#ifndef PM
#define PM 0xFFFF
#endif
#ifndef DUP
#define DUP 0
#endif
constexpr int MTOK = 98304, NPROMPT = 32768, DM = 1024, FH = 2816, LDP = 2624, SH = 3072;
constexpr size_t MiB = 1048576;
constexpr size_t WS_FFN = 0;
constexpr size_t WS_WIN = 66 * MiB;
constexpr size_t WS_UQ = WS_WIN + 5767168;
constexpr size_t WS_UKN = WS_UQ + 1179648;
constexpr size_t WS_UV = WS_UKN + 262144;
constexpr size_t WS_WOUT = WS_UV + 262144;
constexpr size_t WS_SIN = WS_WOUT + 2097152;
constexpr size_t WS_SOUT = WS_SIN + 12582912;
constexpr size_t WS_WS = WS_SOUT + 6291456;
constexpr size_t WS_ROPE = WS_WS + 262144;
constexpr size_t WS_SMALL = WS_ROPE + 524288;
constexpr int SM_LN = 0, SM_WGF = 12288, SM_BGF = 16384, SM_WGB = 16640, SM_BGB = 20736, SM_GN = 20992, SM_LNG = 21120, SM_LNB = 24192, SM_BS = 27264;
constexpr size_t WS_XB = 96 * MiB;
constexpr size_t WS_R = 288 * MiB;
constexpr size_t WS_ST = 780 * MiB;
constexpr size_t WS_DEC = 972 * MiB;
constexpr size_t WS_SSQ = 976 * MiB;
constexpr size_t WS_STATS = 864 * MiB;
constexpr size_t WS_BAR = 983 * MiB;
constexpr size_t WS_CNT = WS_BAR + 4096;
constexpr size_t BAR_ZERO_BYTES = 4096 + 6 * 384 * 2 * 64;
constexpr size_t WS_SLOT = 984 * MiB;
constexpr size_t DO_Q = 0, DO_KN = 144 * MiB, DO_VT = 240 * MiB, DO_KR = 336 * MiB;

struct Params { const float* in[39]; float* out; unsigned char* ws; };

__device__ __forceinline__ int ltid() { int t = threadIdx.x; asm volatile("" : "+v"(t)); return t; }
__device__ __forceinline__ int lbid() { int t = blockIdx.x; asm volatile("" : "+s"(t)); return t; }
__device__ __forceinline__ float bflo(unsigned w) { return __uint_as_float(w << 16); }
__device__ __forceinline__ float bfhi(unsigned w) { return __uint_as_float(w & 0xffff0000u); }
typedef __bf16 bf16v2 __attribute__((ext_vector_type(2)));
__device__ __forceinline__ unsigned pk(float lo, float hi) { const f32x2 v = {lo, hi}; const bf16v2 b = __builtin_convertvector(v, bf16v2); return __builtin_bit_cast(unsigned, b); }
__device__ __forceinline__ float fexp2(float x) { return __builtin_amdgcn_exp2f(x); }
__device__ __forceinline__ float frcp(float x) { return __builtin_amdgcn_rcpf(x); }
__device__ __forceinline__ float silu(float x) { return x * frcp(1.0f + fexp2(-1.4426950408889634f * x)); }
__device__ __forceinline__ f32x2 gelu_pk(f32x2 v) {
    const f32x2 av = __builtin_elementwise_abs(v), d = av * 0.2316418882f + 1.0f;
    f32x2 t; t.x = frcp(d.x); t.y = frcp(d.y);
    f32x2 q = t * 0.5307027145f + (-0.7265760135f); q = q * t + 0.7107068705f; q = q * t + (-0.142248368f); q = q * t + 0.127414796f; q = q * t;
    const f32x2 s = (v * v) * (-0.72134752044f);
    f32x2 e; e.x = fexp2(s.x); e.y = fexp2(s.y);
    const f32x2 m = v * (q * e), r = v - m;
    f32x2 o; o.x = v.x < 0.f ? m.x : r.x; o.y = v.y < 0.f ? m.y : r.y; return o;
}
__device__ __forceinline__ f32x4 gelu4(f32x4 v) { f32x2 a = gelu_pk((f32x2){v[0], v[1]}), b = gelu_pk((f32x2){v[2], v[3]}); return (f32x4){a.x, a.y, b.x, b.y}; }
__device__ __forceinline__ int tok_pos(int row) { return row < NPROMPT ? (row & 2047) : (row & 4095); }

namespace pg8 {
constexpr int BM = 256, BK = 64, HALF = 128, HTB = HALF * BK * 2, STAGE_BYTES = 8 * HTB, NXCD = 8, WGM = 8;
__device__ __forceinline__ int lds_byte(int r, int c) { const int st = (r >> 4) * 2 + (c >> 5), rr = r & 15, cc = c & 31, ob = rr * 64 + cc * 2; return st * 1024 + (ob ^ (((ob >> 9) & 1) << 5)); }
__device__ __forceinline__ void stage_rc(int b, int& R, int& C) { const int st = b / 1024, sb = b % 1024, swz = sb ^ (((sb >> 9) & 1) << 5); R = (st >> 1) * 16 + swz / 64; C = (st & 1) * 32 + (swz % 64) / 2; }
__device__ __forceinline__ int perm32(int rho) { const int n = rho >> 4, i = rho & 15; return 8 * (i >> 2) + 4 * n + (i & 3); }
struct Unit { int pm, pn; };
struct Gemm { const bf16_t* A; const bf16_t* Bt; int lda, ldb, M, N, K; };
struct StaticOrder {
    int nM, nN, nwg, G, c;
    __device__ void init(int M, int N, int G_, int c_) { nM = M / BM; nN = N / BM; nwg = nM * nN; G = G_; c = c_; }
    __device__ bool next(int i, Unit& u) const {
        const long L = (long)i * G + c; if (L >= nwg) return false;
        int wgid = (int)L; { const int q = nwg / NXCD, r = nwg % NXCD, xcd = wgid % NXCD, off = wgid / NXCD; wgid = (xcd < r ? xcd * (q + 1) : r * (q + 1) + (xcd - r) * q) + off; }
        const int nig = WGM * nN, gid = wgid / nig, fm = gid * WGM, gsz = (nM - fm) < WGM ? (nM - fm) : WGM;
        u.pm = fm + ((wgid % nig) % gsz); u.pn = (wgid % nig) / gsz; return true;
    }
};
template <class Epi>
__device__ __forceinline__ void gemm_phase(LAS unsigned char* lds, const Gemm g, const StaticOrder& S, const Epi& E) {
    const int tid = ltid(), wid = __builtin_amdgcn_readfirstlane(tid >> 6), lane = tid & 63, wr = wid >> 2, wc = wid & 3, fr = lane & 15, fq = lane >> 4;
    int K = g.K, lda = g.lda, ldb = g.ldb; asm volatile("" : "+s"(K), "+s"(lda), "+s"(ldb));
    const int nt = K / BK;
    unsigned voffA[2], voffB[2];
#pragma unroll
    for (int i = 0; i < 2; ++i) { int R, C; stage_rc(tid * 16 + i * 8192, R, C); const int Rb = Epi::PERM ? ((R & ~31) + perm32(R & 31)) : R;
        voffA[i] = (unsigned)(R * lda + C) * 2u; voffB[i] = (unsigned)(Rb * ldb + C) * 2u; }
    const size_t kstep = (size_t)(BK * 2);
    const size_t hstepA = (size_t)HALF * lda * 2, hstepB = (size_t)HALF * ldb * 2;
    const size_t tstepA = 2 * hstepA, tstepB = 2 * hstepB;
    const unsigned ldsw = (unsigned)wid * 1024u;
    const int aoff = lds_byte(wr * 64 + fr, fq * 8), boff = lds_byte(wc * 32 + fr, fq * 8);
#define PG8_SA(b, h) (((b) * 2 + (h)) * HTB)
#define PG8_SB(b, h) ((4 + (b) * 2 + (h)) * HTB)
#define PG8_STAGE(bufoff, gbase, voff) do { _Pragma("unroll") for (int _i = 0; _i < 2; ++_i) \
        __builtin_amdgcn_global_load_lds((const unsigned*)((const char*)(gbase) + (voff)[_i]), (LAS unsigned*)(lds + (bufoff) + ldsw + _i * 8192), 16, 0, 0); } while (0)
#define PG8_LDA(dst, b, h) do { _Pragma("unroll") for (int m = 0; m < 4; ++m) _Pragma("unroll") for (int k = 0; k < 2; ++k) dst[m][k] = *(const LAS bf16x8*)(lds + PG8_SA(b, h) + aoff + m * 2048 + k * 1024); } while (0)
#define PG8_LDB(dst, b, h) do { _Pragma("unroll") for (int n = 0; n < 2; ++n) _Pragma("unroll") for (int k = 0; k < 2; ++k) dst[n][k] = *(const LAS bf16x8*)(lds + PG8_SB(b, h) + boff + n * 2048 + k * 1024); } while (0)
#define PG8_MMA(ai, bj, At, Bt) do { __builtin_amdgcn_s_setprio(1); _Pragma("unroll") for (int m = 0; m < 4; ++m) _Pragma("unroll") for (int n = 0; n < 2; ++n) _Pragma("unroll") for (int k = 0; k < 2; ++k) \
        acc[ai][bj][m][n] = __builtin_amdgcn_mfma_f32_16x16x32_bf16(Bt[n][k], At[m][k], acc[ai][bj][m][n], 0, 0, 0); __builtin_amdgcn_s_setprio(0); } while (0)
#define PG8_WAIT_V(n) asm volatile("s_waitcnt vmcnt(" #n ")" ::: "memory")
#define PG8_WAIT_L(n) asm volatile("s_waitcnt lgkmcnt(" #n ")" ::: "memory")
#define PG8_BAR __builtin_amdgcn_s_barrier()
#define PG8_SCHED __builtin_amdgcn_sched_barrier(0)
    Unit cur, nxt; int ui = 0;
    if (!S.next(0, cur)) return;
    f32x4 acc[2][2][4][2];
#pragma unroll
    for (int a = 0; a < 2; ++a)
#pragma unroll
        for (int b = 0; b < 2; ++b)
#pragma unroll
            for (int m = 0; m < 4; ++m)
#pragma unroll
                for (int n = 0; n < 2; ++n) acc[a][b][m][n] = (f32x4){0.f, 0.f, 0.f, 0.f};
    bf16x8 At[4][2], B0[2][2], B1[2][2];
    const char* cA = (const char*)g.A + (size_t)cur.pm * tstepA; const char* cB = (const char*)g.Bt + (size_t)cur.pn * tstepB;
    PG8_STAGE(PG8_SB(0, 0), cB, voffB); PG8_STAGE(PG8_SA(0, 0), cA, voffA); PG8_STAGE(PG8_SB(0, 1), cB + hstepB, voffB); PG8_STAGE(PG8_SA(0, 1), cA + hstepA, voffA);
    if (wr == 1) PG8_BAR;
    PG8_WAIT_V(4); PG8_BAR;
    PG8_STAGE(PG8_SB(1, 0), cB + kstep, voffB); PG8_STAGE(PG8_SA(1, 0), cA + kstep, voffA); PG8_STAGE(PG8_SB(1, 1), cB + hstepB + kstep, voffB);
    PG8_WAIT_V(6); PG8_BAR;
    for (;;) {
        const bool has_next = S.next(ui + 1, nxt);
        const char* nA = has_next ? (const char*)g.A + (size_t)nxt.pm * tstepA : cA; const char* nB = has_next ? (const char*)g.Bt + (size_t)nxt.pn * tstepB : cB;
        for (int t = 0; t < nt; t += 2) {
            const bool last = (t == nt - 2);
            const char* a1 = cA + (size_t)(t + 1) * kstep;
            const char* a2 = last ? nA : cA + (size_t)(t + 2) * kstep; const char* b2 = last ? nB : cB + (size_t)(t + 2) * kstep;
            const char* a3 = a2 + kstep; const char* b3 = b2 + kstep;
            PG8_LDB(B0, 0, 0); PG8_SCHED; PG8_LDA(At, 0, 0); PG8_STAGE(PG8_SA(1, 1), a1 + hstepA, voffA);
            PG8_WAIT_L(8); PG8_BAR; PG8_WAIT_L(0); PG8_MMA(0, 0, At, B0); PG8_BAR; PG8_SCHED;
            PG8_LDB(B1, 0, 1); PG8_STAGE(PG8_SB(0, 0), b2, voffB);
            PG8_BAR; PG8_WAIT_L(0); PG8_MMA(0, 1, At, B1); PG8_BAR;
            PG8_LDA(At, 0, 1); PG8_STAGE(PG8_SA(0, 0), a2, voffA);
            PG8_BAR; PG8_WAIT_L(0); PG8_MMA(1, 0, At, B0); PG8_BAR; PG8_SCHED;
            PG8_STAGE(PG8_SB(0, 1), b2 + hstepB, voffB);
            PG8_WAIT_V(6); PG8_BAR; PG8_MMA(1, 1, At, B1); PG8_BAR;
            PG8_LDB(B0, 1, 0); PG8_SCHED; PG8_LDA(At, 1, 0); PG8_STAGE(PG8_SA(0, 1), a2 + hstepA, voffA);
            PG8_WAIT_L(8); PG8_BAR; PG8_WAIT_L(0); PG8_MMA(0, 0, At, B0); PG8_BAR; PG8_SCHED;
            PG8_LDB(B1, 1, 1); PG8_STAGE(PG8_SB(1, 0), b3, voffB);
            PG8_BAR; PG8_WAIT_L(0); PG8_MMA(0, 1, At, B1); PG8_BAR;
            PG8_LDA(At, 1, 1); PG8_STAGE(PG8_SA(1, 0), a3, voffA);
            PG8_BAR; PG8_WAIT_L(0); PG8_MMA(1, 0, At, B0); PG8_BAR; PG8_SCHED;
            PG8_STAGE(PG8_SB(1, 1), b3 + hstepB, voffB);
            PG8_WAIT_V(6); PG8_BAR; PG8_MMA(1, 1, At, B1); PG8_BAR;
        }
        E(acc, cur, wr, wc, fr, fq);
        if (!has_next) break;
#pragma unroll
        for (int a = 0; a < 2; ++a)
#pragma unroll
            for (int b = 0; b < 2; ++b)
#pragma unroll
                for (int m = 0; m < 4; ++m)
#pragma unroll
                    for (int n = 0; n < 2; ++n) acc[a][b][m][n] = (f32x4){0.f, 0.f, 0.f, 0.f};
        cur = nxt; cA = nA; cB = nB; ++ui;
    }
    PG8_WAIT_V(0);
    if (wr == 0) PG8_BAR;
    PG8_BAR;
#undef PG8_SA
#undef PG8_SB
#undef PG8_STAGE
#undef PG8_LDA
#undef PG8_LDB
#undef PG8_MMA
#undef PG8_WAIT_V
#undef PG8_WAIT_L
#undef PG8_BAR
#undef PG8_SCHED
}
}
using pg8::Unit;
typedef f32x4 AccT[2][2][4][2];

struct EpiSwiglu {
    static constexpr bool PERM = true; bf16_t* H;
    __device__ __forceinline__ void operator()(const AccT& acc, const Unit& u, int wr, int wc, int fr, int fq) const {
        const int row0 = u.pm * 256 + wr * 64 + fr, col0 = u.pn * 128 + wc * 32 + 8 * fq;
#pragma unroll
        for (int ai = 0; ai < 2; ++ai)
#pragma unroll
            for (int m = 0; m < 4; ++m) { const f32x4 g0 = acc[ai][0][m][0], g1 = acc[ai][0][m][1], u0 = acc[ai][1][m][0], u1 = acc[ai][1][m][1];
                u32x4 w; w.x = pk(silu(g0[0]) * u0[0], silu(g0[1]) * u0[1]); w.y = pk(silu(g0[2]) * u0[2], silu(g0[3]) * u0[3]);
                w.z = pk(silu(g1[0]) * u1[0], silu(g1[1]) * u1[1]); w.w = pk(silu(g1[2]) * u1[2], silu(g1[3]) * u1[3]);
                *(u32x4*)(H + (size_t)(row0 + ai * 128 + m * 16) * FH + col0) = w; }
    }
};
struct EpiPre {
    static constexpr bool PERM = false; const bf16_t* XB; float* PRE; float cs;
    __device__ __forceinline__ void operator()(const AccT& acc, const Unit& u, int wr, int wc, int fr, int fq) const {
        const int row0 = u.pm * 256 + wr * 64 + fr, col0 = u.pn * 256 + wc * 32 + 4 * fq;
#pragma unroll
        for (int ai = 0; ai < 2; ++ai)
#pragma unroll
            for (int m = 0; m < 4; ++m) { const size_t ro = (size_t)(row0 + ai * 128 + m * 16) * DM + col0;
#pragma unroll
                for (int bj = 0; bj < 2; ++bj)
#pragma unroll
                    for (int n = 0; n < 2; ++n) { const u32x2 xw = *(const u32x2*)(XB + ro + bj * 128 + n * 16); const f32x4 a = acc[ai][bj][m][n];
                        f32x4 o; o[0] = 1.41421356237f * bflo(xw.x) + cs * a[0]; o[1] = 1.41421356237f * bfhi(xw.x) + cs * a[1]; o[2] = 1.41421356237f * bflo(xw.y) + cs * a[2]; o[3] = 1.41421356237f * bfhi(xw.y) + cs * a[3];
                        *(f32x4*)(PRE + ro + bj * 128 + n * 16) = o; } }
    }
};
struct EpiLn {
    static constexpr bool PERM = true; bf16_t* XB; float* OUTF; const float* G; const float* B; float cs; unsigned long long* SLOT; unsigned* CNT;
    __device__ __forceinline__ void operator()(AccT& acc, const Unit& u, int wr, int wc, int fr, int fq) const {
        const int row0 = u.pm * 256 + wr * 64 + fr, col0 = u.pn * 256 + wc * 32 + 8 * fq; const float AL = 1.41421356237f;
#pragma unroll
        for (int ai = 0; ai < 2; ++ai) {
            u32x4 xw[4][2];
#pragma unroll
            for (int m = 0; m < 4; ++m)
#pragma unroll
                for (int bj = 0; bj < 2; ++bj) xw[m][bj] = *(const u32x4*)(XB + (size_t)(row0 + ai * 128 + m * 16) * DM + col0 + bj * 128);
#pragma unroll
            for (int m = 0; m < 4; ++m) { const int row = row0 + ai * 128 + m * 16; float s1 = 0.f, s2 = 0.f;
#pragma unroll
                for (int bj = 0; bj < 2; ++bj) { const u32x4 x = xw[m][bj]; const f32x4 a0 = acc[ai][bj][m][0], a1 = acc[ai][bj][m][1]; f32x4 v0, v1;
                    v0[0] = AL * bflo(x.x) + cs * a0[0]; v0[1] = AL * bfhi(x.x) + cs * a0[1]; v0[2] = AL * bflo(x.y) + cs * a0[2]; v0[3] = AL * bfhi(x.y) + cs * a0[3];
                    v1[0] = AL * bflo(x.z) + cs * a1[0]; v1[1] = AL * bfhi(x.z) + cs * a1[1]; v1[2] = AL * bflo(x.w) + cs * a1[2]; v1[3] = AL * bfhi(x.w) + cs * a1[3];
                    acc[ai][bj][m][0] = v0; acc[ai][bj][m][1] = v1;
                    s1 += ((v0[0] + v0[1]) + (v0[2] + v0[3])) + ((v1[0] + v1[1]) + (v1[2] + v1[3]));
                    s2 += (v0[0] * v0[0] + v0[1] * v0[1]) + (v0[2] * v0[2] + v0[3] * v0[3]) + (v1[0] * v1[0] + v1[1] * v1[1]) + (v1[2] * v1[2] + v1[3] * v1[3]); }
                s1 += __shfl_xor(s1, 16); s1 += __shfl_xor(s1, 32); s2 += __shfl_xor(s2, 16); s2 += __shfl_xor(s2, 32);
                if (fq == 0) __hip_atomic_store(SLOT + (size_t)row * 16 + u.pn * 4 + wc, ((unsigned long long)__float_as_uint(s2) << 32) | (unsigned long long)__float_as_uint(s1), __ATOMIC_RELAXED, __HIP_MEMORY_SCOPE_AGENT); }
            asm volatile("" ::: "memory");
        }
        asm volatile("s_waitcnt vmcnt(0)" ::: "memory");
        unsigned* cnt = CNT + ((size_t)u.pm * 2 + wr) * 16;
        if ((fr | fq) == 0) __hip_atomic_fetch_add(cnt, 1u, __ATOMIC_RELAXED, __HIP_MEMORY_SCOPE_AGENT);
        while ((unsigned)__builtin_amdgcn_readfirstlane((int)__hip_atomic_load(cnt, __ATOMIC_RELAXED, __HIP_MEMORY_SCOPE_AGENT)) < 16u) __builtin_amdgcn_s_sleep(1);
        __builtin_amdgcn_fence(__ATOMIC_ACQUIRE, "workgroup"); asm volatile("" ::: "memory");
        f32x4 gv[2][2], bv[2][2];
#pragma unroll
        for (int bt = 0; bt < 3; ++bt) { const int rb = bt * 3, nr = bt == 2 ? 2 : 3;
            unsigned long long sw[3][4];
#pragma unroll
            for (int k = 0; k < 3; ++k) if (k < nr) { const int r8 = rb + k; const unsigned long long* sp = SLOT + (size_t)(row0 + (r8 >> 2) * 128 + (r8 & 3) * 16) * 16 + 4 * fq;
#pragma unroll
                for (int i = 0; i < 4; ++i) sw[k][i] = __hip_atomic_load(sp + i, __ATOMIC_RELAXED, __HIP_MEMORY_SCOPE_AGENT); }
            if (bt == 0) {
#pragma unroll
                for (int bj = 0; bj < 2; ++bj)
#pragma unroll
                    for (int n = 0; n < 2; ++n) { gv[bj][n] = *(const f32x4*)(G + col0 + bj * 128 + 4 * n); bv[bj][n] = *(const f32x4*)(B + col0 + bj * 128 + 4 * n); } }
#pragma unroll
            for (int k = 0; k < 3; ++k) if (k < nr) { const int r8 = rb + k, ai = r8 >> 2, m = r8 & 3; const int row = row0 + ai * 128 + m * 16; float t1 = 0.f, t2 = 0.f;
#pragma unroll
                for (int i = 0; i < 4; ++i) { const unsigned long long w = sw[k][i]; t1 += __uint_as_float((unsigned)w); t2 += __uint_as_float((unsigned)(w >> 32)); }
                t1 += __shfl_xor(t1, 16); t1 += __shfl_xor(t1, 32); t2 += __shfl_xor(t2, 16); t2 += __shfl_xor(t2, 32);
                const float mean = t1 * (1.0f / 1024.0f), var = t2 * (1.0f / 1024.0f) - mean * mean, rstd = rsqrtf(fmaxf(var, 0.f) + 1e-5f);
#pragma unroll
                for (int bj = 0; bj < 2; ++bj) { const f32x4 y0 = (acc[ai][bj][m][0] - mean) * rstd * gv[bj][0] + bv[bj][0], y1 = (acc[ai][bj][m][1] - mean) * rstd * gv[bj][1] + bv[bj][1];
                    if (OUTF) { *(f32x4*)(OUTF + (size_t)row * DM + col0 + bj * 128) = y0; *(f32x4*)(OUTF + (size_t)row * DM + col0 + bj * 128 + 4) = y1; }
                    else { u32x4 w; w.x = pk(y0[0], y0[1]); w.y = pk(y0[2], y0[3]); w.z = pk(y1[0], y1[1]); w.w = pk(y1[2], y1[3]); *(u32x4*)(XB + (size_t)row * DM + col0 + bj * 128) = w; } } }
            asm volatile("" ::: "memory");
        }
    }
};
struct EpiWin {
    static constexpr bool PERM = true; bf16_t* P; float* SSQ;
    __device__ __forceinline__ void operator()(const AccT& acc, const Unit& u, int wr, int wc, int fr, int fq) const {
        const int row0 = u.pm * 256 + wr * 64 + fr, col0 = u.pn * 256 + wc * 32 + 8 * fq;
#pragma unroll
        for (int ai = 0; ai < 2; ++ai)
#pragma unroll
            for (int m = 0; m < 4; ++m) { const int row = row0 + ai * 128 + m * 16; float s = 0.f;
#pragma unroll
                for (int bj = 0; bj < 2; ++bj) { f32x4 v0 = acc[ai][bj][m][0], v1 = acc[ai][bj][m][1]; const int c = col0 + bj * 128;
                    s += (v0[0] * v0[0] + v0[1] * v0[1]) + (v0[2] * v0[2] + v0[3] * v0[3]) + (v1[0] * v1[0] + v1[1] * v1[1]) + (v1[2] * v1[2] + v1[3] * v1[3]);
                    if (c < LDP) { u32x4 w; w.x = pk(v0[0], v0[1]); w.y = pk(v0[2], v0[3]); w.z = pk(v1[0], v1[1]); w.w = pk(v1[2], v1[3]); *(u32x4*)(P + (size_t)row * LDP + c) = w; } }
                if (u.pn < 4) { s += __shfl_xor(s, 16); s += __shfl_xor(s, 32); if (fq == 0) SSQ[(size_t)row * 16 + u.pn * 4 + wc] = s; } }
    }
};
struct EpiQ {
    static constexpr bool PERM = false; bf16_t* Q; const float* SSQ; const f32x2* ROPE;
    __device__ __forceinline__ void operator()(const AccT& acc, const Unit& u, int wr, int wc, int fr, int fq) const {
        const int row0 = u.pm * 256 + wr * 64 + fr; const float QS = 0.10206207261596577f * 1.4426950408889634f;
#pragma unroll
        for (int ai = 0; ai < 2; ++ai) {
            f32x4 sq[4][3];
#pragma unroll
            for (int m = 0; m < 4; ++m)
#pragma unroll
                for (int k = 0; k < 3; ++k) sq[m][k] = *(const f32x4*)(SSQ + (size_t)(row0 + ai * 128 + m * 16) * 16 + 4 * k);
#pragma unroll
            for (int m = 0; m < 4; ++m) { const int row = row0 + ai * 128 + m * 16;
                const f32x4 s0 = sq[m][0], s1 = sq[m][1], s2 = sq[m][2];
                const float ss = ((s0[0] + s0[1]) + (s0[2] + s0[3])) + ((s1[0] + s1[1]) + (s1[2] + s1[3])) + ((s2[0] + s2[1]) + (s2[2] + s2[3]));
                const float rs = rsqrtf(ss * (1.0f / 768.0f) + 1e-6f) * QS; const int pos = tok_pos(row);
#pragma unroll
                for (int bj = 0; bj < 2; ++bj) { const int cg = u.pn * 256 + bj * 128 + wc * 32; f32x4 a0 = acc[ai][bj][m][0] * rs, a1 = acc[ai][bj][m][1] * rs;
                    if ((cg % 96) == 64) { const f32x4 t0 = *(const f32x4*)(ROPE + (size_t)pos * 16 + 4 * fq), t1 = *(const f32x4*)(ROPE + (size_t)pos * 16 + 4 * fq + 2);
                        const float cs[4] = {t0[0], t0[2], t1[0], t1[2]}, sn[4] = {t0[1], t0[3], t1[1], t1[3]}; f32x4 o0, o1;
#pragma unroll
                        for (int j = 0; j < 4; ++j) { o0[j] = a0[j] * cs[j] - a1[j] * sn[j]; o1[j] = a0[j] * sn[j] + a1[j] * cs[j]; }
                        a0 = o0; a1 = o1; }
                    u32x2 w0, w1; w0.x = pk(a0[0], a0[1]); w0.y = pk(a0[2], a0[3]); w1.x = pk(a1[0], a1[1]); w1.y = pk(a1[2], a1[3]);
                    *(u32x2*)(Q + (size_t)row * 768 + cg + 4 * fq) = w0; *(u32x2*)(Q + (size_t)row * 768 + cg + 16 + 4 * fq) = w1; }
                asm volatile("" ::: "memory"); }
        }
    }
};
struct EpiKN {
    static constexpr bool PERM = true; bf16_t* KN; const float* SSQ;
    __device__ __forceinline__ void operator()(const AccT& acc, const Unit& u, int wr, int wc, int fr, int fq) const {
        const int row0 = u.pm * 256 + wr * 64 + fr, col0 = u.pn * 256 + wc * 32 + 8 * fq;
        f32x4 s3[2][4];
#pragma unroll
        for (int ai = 0; ai < 2; ++ai)
#pragma unroll
            for (int m = 0; m < 4; ++m) s3[ai][m] = *(const f32x4*)(SSQ + (size_t)(row0 + ai * 128 + m * 16) * 16 + 12);
#pragma unroll
        for (int ai = 0; ai < 2; ++ai)
#pragma unroll
            for (int m = 0; m < 4; ++m) { const int row = row0 + ai * 128 + m * 16; const f32x4 q = s3[ai][m];
                const float rs = rsqrtf(((q[0] + q[1]) + (q[2] + q[3])) * (1.0f / 256.0f) + 1e-6f);
#pragma unroll
                for (int bj = 0; bj < 2; ++bj) { const f32x4 v0 = acc[ai][bj][m][0] * rs, v1 = acc[ai][bj][m][1] * rs;
                    u32x4 w; w.x = pk(v0[0], v0[1]); w.y = pk(v0[2], v0[3]); w.z = pk(v1[0], v1[1]); w.w = pk(v1[2], v1[3]); *(u32x4*)(KN + (size_t)row * 512 + col0 + bj * 128) = w; } }
    }
};
struct EpiVT {
    static constexpr bool PERM = true; bf16_t* VT; const float* SSQ;
    __device__ __forceinline__ void operator()(const AccT& acc, const Unit& u, int wr, int wc, int fr, int fq) const {
        const int f0 = u.pm * 256 + wr * 64 + fr, tok0 = u.pn * 256 + wc * 32 + 8 * fq;
#pragma unroll
        for (int bj = 0; bj < 2; ++bj) {
            float rs[8];
#pragma unroll
            for (int i = 0; i < 8; ++i) { const f32x4 s3 = *(const f32x4*)(SSQ + (size_t)(tok0 + bj * 128 + i) * 16 + 12); rs[i] = rsqrtf(((s3[0] + s3[1]) + (s3[2] + s3[3])) * (1.0f / 256.0f) + 1e-6f); }
            asm volatile("" ::: "memory");
#pragma unroll
            for (int ai = 0; ai < 2; ++ai)
#pragma unroll
                for (int m = 0; m < 4; ++m) { const int f = f0 + ai * 128 + m * 16; const f32x4 v0 = acc[ai][bj][m][0], v1 = acc[ai][bj][m][1];
                    u32x4 w; w.x = pk(v0[0] * rs[0], v0[1] * rs[1]); w.y = pk(v0[2] * rs[2], v0[3] * rs[3]); w.z = pk(v1[0] * rs[4], v1[1] * rs[5]); w.w = pk(v1[2] * rs[6], v1[3] * rs[7]);
                    *(u32x4*)(VT + (size_t)f * MTOK + tok0 + bj * 128) = w; }
            asm volatile("" ::: "memory");
        }
    }
};
struct EpiSguV {
    static constexpr bool PERM = true; bf16_t* V; f32x2* STATS;
    __device__ __forceinline__ void operator()(const AccT& acc, const Unit& u, int wr, int wc, int fr, int fq) const {
        const int row0 = u.pm * 256 + wr * 64 + fr, col0 = u.pn * 256 + wc * 32 + 8 * fq;
#pragma unroll
        for (int ai = 0; ai < 2; ++ai)
#pragma unroll
            for (int m = 0; m < 4; ++m) { const int row = row0 + ai * 128 + m * 16; float s1 = 0.f, s2 = 0.f;
#pragma unroll
                for (int bj = 0; bj < 2; ++bj) { const f32x4 v0 = gelu4(acc[ai][bj][m][0]), v1 = gelu4(acc[ai][bj][m][1]);
                    s1 += ((v0[0] + v0[1]) + (v0[2] + v0[3])) + ((v1[0] + v1[1]) + (v1[2] + v1[3]));
                    s2 += (v0[0] * v0[0] + v0[1] * v0[1]) + (v0[2] * v0[2] + v0[3] * v0[3]) + (v1[0] * v1[0] + v1[1] * v1[1]) + (v1[2] * v1[2] + v1[3] * v1[3]);
                    u32x4 w; w.x = pk(v0[0], v0[1]); w.y = pk(v0[2], v0[3]); w.z = pk(v1[0], v1[1]); w.w = pk(v1[2], v1[3]); *(u32x4*)(V + (size_t)row * SH + col0 + bj * 128) = w; }
                s1 += __shfl_xor(s1, 16); s1 += __shfl_xor(s1, 32); s2 += __shfl_xor(s2, 16); s2 += __shfl_xor(s2, 32);
                if (fq == 0) STATS[(size_t)row * 48 + u.pn * 4 + wc] = (f32x2){s1, s2}; }
    }
};
struct EpiSguU {
    static constexpr bool PERM = true; bf16_t* V;
    __device__ __forceinline__ void operator()(const AccT& acc, const Unit& u, int wr, int wc, int fr, int fq) const {
        const int row0 = u.pm * 256 + wr * 64 + fr, col0 = u.pn * 256 + wc * 32 + 8 * fq;
#pragma unroll
        for (int ai = 0; ai < 2; ++ai) {
            u32x4 vv[4][2];
#pragma unroll
            for (int m = 0; m < 4; ++m)
#pragma unroll
                for (int bj = 0; bj < 2; ++bj) vv[m][bj] = *(const u32x4*)(V + (size_t)(row0 + ai * 128 + m * 16) * SH + col0 + bj * 128);
#pragma unroll
            for (int m = 0; m < 4; ++m) { const int row = row0 + ai * 128 + m * 16;
#pragma unroll
                for (int bj = 0; bj < 2; ++bj) { bf16_t* ptr = V + (size_t)row * SH + col0 + bj * 128; const u32x4 x = vv[m][bj];
                    const f32x4 v0 = gelu4(acc[ai][bj][m][0]), v1 = gelu4(acc[ai][bj][m][1]);
                    u32x4 w; w.x = pk(v0[0] * bflo(x.x), v0[1] * bfhi(x.x)); w.y = pk(v0[2] * bflo(x.y), v0[3] * bfhi(x.y)); w.z = pk(v1[0] * bflo(x.z), v1[1] * bfhi(x.z)); w.w = pk(v1[2] * bflo(x.w), v1[3] * bfhi(x.w));
                    *(u32x4*)ptr = w; } }
            asm volatile("" ::: "memory");
        }
    }
};

template <class Epi> __device__ __forceinline__ void run_gemm(LAS unsigned char* lds, const bf16_t* A, int lda, const bf16_t* Bt, int ldb, int M, int N, int K, const Epi& E) {
    pg8::Gemm g; g.A = A; g.Bt = Bt; g.lda = lda; g.ldb = ldb; g.M = M; g.N = N; g.K = K;
    pg8::StaticOrder S; S.init(M, N, (int)gridDim.x, lbid());
    pg8::gemm_phase<Epi>(lds, g, S, E);
}

__device__ __forceinline__ int mapcol(int mode, int nd) {
    switch (mode) {
        case 1: { const int t = nd >> 8, w = nd & 255; return (w >= 128 ? FH : 0) + t * 128 + (w & 127); }
        case 2: return nd < LDP ? nd : -1;
        case 3: return (nd >> 6) * 128 + (nd & 63);
        case 4: return (nd >> 6) * 128 + 64 + (nd & 63);
        default: return nd;
    }
}
__device__ __forceinline__ void convert_T(LAS unsigned char* lds, const float* src, int ldsrc, int K, int Ndst, bf16_t* dst, int mode, const float* kscale) {
    LAS float* tile = (LAS float*)lds;
    const int tid = ltid(), ntk = K / 64, ntn = Ndst / 256;
    for (int idx = lbid(); idx < ntk * ntn; idx += gridDim.x) {
        const int tk = idx % ntk, tn = idx / ntk;
        const int r0 = tid >> 6, c4 = (tid & 63) * 4; const int ns = mapcol(mode, tn * 256 + c4);
        f32x4 v[8];
#pragma unroll
        for (int i = 0; i < 8; ++i) { const int k = tk * 64 + r0 + 8 * i; v[i] = (f32x4){0.f, 0.f, 0.f, 0.f}; if (ns >= 0) v[i] = *(const f32x4*)(src + (size_t)k * ldsrc + ns); if (kscale) v[i] = v[i] * kscale[k]; }
#pragma unroll
        for (int i = 0; i < 8; ++i) *(LAS f32x4*)(tile + (r0 + 8 * i) * 260 + c4) = v[i];
        __syncthreads();
        const int n = tid >> 1, kh = (tid & 1) * 32;
#pragma unroll
        for (int q = 0; q < 4; ++q) { float x[8];
#pragma unroll
            for (int i = 0; i < 8; ++i) x[i] = tile[(kh + 8 * q + i) * 260 + n];
            u32x4 w; w.x = pk(x[0], x[1]); w.y = pk(x[2], x[3]); w.z = pk(x[4], x[5]); w.w = pk(x[6], x[7]);
            *(u32x4*)(dst + (size_t)(tn * 256 + n) * K + tk * 64 + kh + 8 * q) = w; }
        __syncthreads();
    }
}
#define PIN(k) (p.in[lidx(k)])
__device__ __forceinline__ int lidx(int k) { asm volatile("" : "+s"(k)); return k; }
__device__ __forceinline__ void copyf(float* dst, const float* src, size_t n, size_t gt, size_t nth) { if (gt < n) dst[gt] = src[gt]; }
__device__ __forceinline__ void phase0(LAS unsigned char* lds, const Params& p) {
    unsigned char* ws = p.ws;
    const size_t gt = (size_t)lbid() * 512 + ltid(), nth = (size_t)gridDim.x * 512;
    { bf16_t* XB = (bf16_t*)(ws + WS_XB); const size_t n4 = (size_t)MTOK * DM / 4, np4 = (size_t)NPROMPT * DM / 4; const f32x4* xp = (const f32x4*)PIN(0); const f32x4* xs = (const f32x4*)PIN(1);
      size_t i = gt;
      for (; i + 3 * nth < n4; i += 4 * nth) { f32x4 v[4];
#pragma unroll
          for (int u = 0; u < 4; ++u) { const size_t j = i + u * nth; v[u] = j < np4 ? xp[j] : xs[j - np4]; }
#pragma unroll
          for (int u = 0; u < 4; ++u) { u32x2 w; w.x = pk(v[u][0], v[u][1]); w.y = pk(v[u][2], v[u][3]); ((u32x2*)XB)[i + u * nth] = w; } }
      for (; i < n4; i += nth) { const f32x4 v = i < np4 ? xp[i] : xs[i - np4]; u32x2 w; w.x = pk(v[0], v[1]); w.y = pk(v[2], v[3]); ((u32x2*)XB)[i] = w; } }
    { unsigned* z = (unsigned*)(ws + WS_BAR); for (size_t i = gt; i < BAR_ZERO_BYTES / 4; i += nth) z[i] = 0u; }
    { bf16_t* W = (bf16_t*)(ws + WS_WS); const float* wsrc = PIN(30); for (size_t i = gt; i < 8 * 128 * 128 / 2; i += nth) { ((unsigned*)W)[i] = pk(wsrc[2 * i], wsrc[2 * i + 1]); }
      f32x2* R = (f32x2*)(ws + WS_ROPE); for (size_t i = gt; i < 4096 * 16; i += nth) { const int pos = (int)(i >> 4), j = (int)(i & 15);
          const float inv = 1.0f / powf(10000.0f, (float)(2 * j) / 32.0f); const float ang = (float)pos * inv; R[i] = (f32x2){cosf(ang), sinf(ang)}; } }
    { float* SMp = (float*)(ws + WS_SMALL);
#pragma unroll 1
      for (int k = 0; k < 6; ++k) { const int gi = k == 0 ? 4 : k == 1 ? 17 : k == 2 ? 21 : k == 3 ? 25 : k == 4 ? 33 : 37; copyf(SMp + SM_LN + k * 2048, PIN(gi), 1024, gt, nth); copyf(SMp + SM_LN + k * 2048 + 1024, PIN(gi + 1), 1024, gt, nth); }
      copyf(SMp + SM_WGF, PIN(11), 4096, gt, nth); copyf(SMp + SM_WGB, PIN(13), 4096, gt, nth); copyf(SMp + SM_BGF, PIN(12), 256, gt, nth); copyf(SMp + SM_BGB, PIN(14), 256, gt, nth);
      copyf(SMp + SM_GN, PIN(15), 128, gt, nth); copyf(SMp + SM_LNG, PIN(28), 3072, gt, nth); copyf(SMp + SM_LNB, PIN(29), 3072, gt, nth); copyf(SMp + SM_BS, PIN(31), 1024, gt, nth); }
#pragma unroll 1
    for (int f = 0; f < 4; ++f) { const int gi = f == 0 ? 2 : f == 1 ? 19 : f == 2 ? 23 : 35;
        convert_T(lds, PIN(gi), 2 * FH, DM, 2 * FH, (bf16_t*)(ws + WS_FFN + (size_t)f * 17301504), 1, nullptr);
        convert_T(lds, PIN(gi + 1), DM, FH, DM, (bf16_t*)(ws + WS_FFN + (size_t)f * 17301504 + 11534336), 0, nullptr);
    }
    convert_T(lds, PIN(6), LDP, DM, 2816, (bf16_t*)(ws + WS_WIN), 2, nullptr);
    convert_T(lds, PIN(8), 768, 768, 768, (bf16_t*)(ws + WS_UQ), 0, PIN(7));
    convert_T(lds, PIN(10), 1024, 256, 512, (bf16_t*)(ws + WS_UKN), 3, PIN(9));
    convert_T(lds, PIN(10), 1024, 256, 512, (bf16_t*)(ws + WS_UV), 4, PIN(9));
    convert_T(lds, PIN(16), DM, DM, DM, (bf16_t*)(ws + WS_WOUT), 0, nullptr);
    convert_T(lds, PIN(27), 2 * SH, DM, 2 * SH, (bf16_t*)(ws + WS_SIN), 0, nullptr);
    convert_T(lds, PIN(32), DM, SH, DM, (bf16_t*)(ws + WS_SOUT), 0, nullptr);
}

__device__ __forceinline__ void ln_phase(const float* pre, const float* g, const float* b, bf16_t* xb, float* outf) {
    const int wid = ltid() >> 6, lane = ltid() & 63;
    f32x4 gv[4], bv[4];
#pragma unroll
    for (int i = 0; i < 4; ++i) { gv[i] = *(const f32x4*)(g + 4 * lane + 256 * i); bv[i] = *(const f32x4*)(b + 4 * lane + 256 * i); }
    const int nw = gridDim.x * 8;
    for (int row = lbid() * 8 + wid; row < MTOK; row += 2 * nw) {
        const int row2 = row + nw; const bool has2 = row2 < MTOK;
        const float* pr = pre + (size_t)row * DM; const float* pr2 = pre + (size_t)(has2 ? row2 : row) * DM; f32x4 v[4], w[4]; float s = 0.f, s2 = 0.f;
#pragma unroll
        for (int i = 0; i < 4; ++i) { v[i] = *(const f32x4*)(pr + 4 * lane + 256 * i); w[i] = *(const f32x4*)(pr2 + 4 * lane + 256 * i); }
#pragma unroll
        for (int i = 0; i < 4; ++i) { s += (v[i][0] + v[i][1]) + (v[i][2] + v[i][3]); s2 += (w[i][0] + w[i][1]) + (w[i][2] + w[i][3]); }
#pragma unroll
        for (int o = 32; o >= 1; o >>= 1) { s += __shfl_xor(s, o); s2 += __shfl_xor(s2, o); }
        const float mean = s * (1.0f / 1024.0f), mean2 = s2 * (1.0f / 1024.0f); float q = 0.f, q2 = 0.f;
#pragma unroll
        for (int i = 0; i < 4; ++i) { v[i] = v[i] - mean; q += (v[i][0] * v[i][0] + v[i][1] * v[i][1]) + (v[i][2] * v[i][2] + v[i][3] * v[i][3]);
                                      w[i] = w[i] - mean2; q2 += (w[i][0] * w[i][0] + w[i][1] * w[i][1]) + (w[i][2] * w[i][2] + w[i][3] * w[i][3]); }
#pragma unroll
        for (int o = 32; o >= 1; o >>= 1) { q += __shfl_xor(q, o); q2 += __shfl_xor(q2, o); }
        const float rstd = rsqrtf(q * (1.0f / 1024.0f) + 1e-5f), rstd2 = rsqrtf(q2 * (1.0f / 1024.0f) + 1e-5f);
#pragma unroll
        for (int i = 0; i < 4; ++i) { const f32x4 y = v[i] * rstd * gv[i] + bv[i];
            if (xb) { u32x2 t; t.x = pk(y[0], y[1]); t.y = pk(y[2], y[3]); *(u32x2*)(xb + (size_t)row * DM + 4 * lane + 256 * i) = t; }
            if (outf) *(f32x4*)(outf + (size_t)row * DM + 4 * lane + 256 * i) = y; }
        if (has2) {
#pragma unroll
            for (int i = 0; i < 4; ++i) { const f32x4 y = w[i] * rstd2 * gv[i] + bv[i];
                if (xb) { u32x2 t; t.x = pk(y[0], y[1]); t.y = pk(y[2], y[3]); *(u32x2*)(xb + (size_t)row2 * DM + 4 * lane + 256 * i) = t; }
                if (outf) *(f32x4*)(outf + (size_t)row2 * DM + 4 * lane + 256 * i) = y; } }
    }
}

__device__ __forceinline__ void kr_pass(const bf16_t* P, const f32x2* ROPE, bf16_t* KR) {
    const size_t gt = (size_t)lbid() * 512 + ltid(), nth = (size_t)gridDim.x * 512;
    for (size_t i = gt; i < (size_t)MTOK * 16; i += nth) { const int row = (int)(i >> 4), j = (int)(i & 15); const int pos = tok_pos(row);
        const bf16_t* pr = P + (size_t)row * LDP + 1024; const float x1 = bflo((unsigned)pr[j]), x2 = bflo((unsigned)pr[j + 16]); const f32x2 cs = ROPE[(size_t)pos * 16 + j];
        KR[(size_t)row * 32 + j] = (bf16_t)(pk(x1 * cs.x - x2 * cs.y, 0.f) & 0xffffu); KR[(size_t)row * 32 + 16 + j] = (bf16_t)(pk(x1 * cs.y + x2 * cs.x, 0.f) & 0xffffu); }
}

#define MFMA16(a, b, c) __builtin_amdgcn_mfma_f32_16x16x32_bf16((a), (b), (c), 0, 0, 0)
__device__ __forceinline__ bf16x8 mk8(u32x2 lo, u32x2 hi) { u32x4 w; w.x = lo.x; w.y = lo.y; w.z = hi.x; w.w = hi.y; return __builtin_bit_cast(bf16x8, w); }
__device__ __forceinline__ bf16x8 pack8(f32x4 a, f32x4 b) { u32x4 w; w.x = pk(a[0], a[1]); w.y = pk(a[2], a[3]); w.z = pk(b[0], b[1]); w.w = pk(b[2], b[3]); return __builtin_bit_cast(bf16x8, w); }

__device__ __forceinline__ void attn_phase(LAS unsigned char* lds, const bf16_t* Q, const bf16_t* KN, const bf16_t* KR, const bf16_t* VT, bf16_t* O) {
    const int tid = ltid(), wid = tid >> 6, lane = tid & 63, fr = lane & 15, fq = lane >> 4;
    const int G = gridDim.x; const int L = (G % 8 == 0) ? ((lbid() & 7) * (G >> 3) + (lbid() >> 3)) : lbid();
    constexpr int KBYTES = 128 * 208, BUF = KBYTES + 64 * 272;
    for (int it = L; it < 3072; it += G) {
        int h, S, row0, qb;
        if (it < 2048) { const int pair = it >> 4; qb = it & 15; h = pair & 7; S = 4096; row0 = NPROMPT + (pair >> 3) * 4096; }
        else { const int j = it - 2048, pair = j >> 3; qb = j & 7; h = pair & 7; S = 2048; row0 = (pair >> 3) * 2048; }
        const int qrow0 = row0 + qb * 256 + wid * 32;
        bf16x8 Qf[2][3];
#pragma unroll
        for (int qf = 0; qf < 2; ++qf)
#pragma unroll
            for (int ks = 0; ks < 3; ++ks) Qf[qf][ks] = *(const bf16x8*)(Q + (size_t)(qrow0 + 16 * qf + fr) * 768 + h * 96 + 32 * ks + 8 * fq);
        f32x4 Oacc[2][4];
#pragma unroll
        for (int qf = 0; qf < 2; ++qf)
#pragma unroll
            for (int nb = 0; nb < 4; ++nb) Oacc[qf][nb] = (f32x4){0.f, 0.f, 0.f, 0.f};
        float mi[2] = {-1e30f, -1e30f}, li[2] = {0.f, 0.f};
        const int nt = S / 128;
        const bf16_t* ksrc[3]; int kstep[3], kdst[3]; const bf16_t* vsrc[2]; int vdst[2];
#pragma unroll
        for (int i = 0; i < 3; ++i) { const int pp = tid + 512 * i, key = pp / 12, part = pp % 12;
            ksrc[i] = part < 8 ? KN + (size_t)(row0 + key) * 512 + h * 64 + part * 8 : KR + (size_t)(row0 + key) * 32 + (part - 8) * 8;
            kstep[i] = part < 8 ? 128 * 512 : 128 * 32; kdst[i] = key * 208 + part * 16; }
#pragma unroll
        for (int i = 0; i < 2; ++i) { const int pp = tid + 512 * i, dv = pp >> 4, seg = pp & 15;
            vsrc[i] = VT + (size_t)(h * 64 + dv) * MTOK + row0 + seg * 8; vdst[i] = KBYTES + dv * 272 + seg * 16; }
        u32x4 rk[3], rv[2];
#pragma unroll
        for (int i = 0; i < 3; ++i) rk[i] = *(const u32x4*)ksrc[i];
#pragma unroll
        for (int i = 0; i < 2; ++i) rv[i] = *(const u32x4*)vsrc[i];
#pragma unroll
        for (int i = 0; i < 3; ++i) *(LAS u32x4*)(lds + kdst[i]) = rk[i];
#pragma unroll
        for (int i = 0; i < 2; ++i) *(LAS u32x4*)(lds + vdst[i]) = rv[i];
        __syncthreads();
        for (int t = 0; t < nt; ++t) {
            const bool pf = (t + 1 < nt);
            if (pf) {
#pragma unroll
                for (int i = 0; i < 3; ++i) rk[i] = *(const u32x4*)(ksrc[i] + (size_t)(t + 1) * kstep[i]);
#pragma unroll
                for (int i = 0; i < 2; ++i) rv[i] = *(const u32x4*)(vsrc[i] + (size_t)(t + 1) * 128);
            }
#pragma unroll 1
            for (int sub = 0; sub < 2; ++sub) {
                LAS unsigned char* kb_ = lds + (t & 1) * BUF + sub * (64 * 208); LAS unsigned char* vb_ = lds + (t & 1) * BUF + KBYTES + sub * 128;
                bf16x8 Pf[2][2];
                {
                    bf16x8 Kf[4][3];
#pragma unroll
                    for (int kb = 0; kb < 4; ++kb)
#pragma unroll
                        for (int ks = 0; ks < 3; ++ks) Kf[kb][ks] = *(const LAS bf16x8*)(kb_ + (16 * kb + fr) * 208 + (32 * ks + 8 * fq) * 2);
#pragma unroll
                    for (int qf = 0; qf < 2; ++qf) {
                        f32x4 s[4];
#pragma unroll
                        for (int kb = 0; kb < 4; ++kb) { s[kb] = (f32x4){0.f, 0.f, 0.f, 0.f};
#pragma unroll
                            for (int ks = 0; ks < 3; ++ks) s[kb] = MFMA16(Kf[kb][ks], Qf[qf][ks], s[kb]); }
                        float mx = -1e30f;
#pragma unroll
                        for (int kb = 0; kb < 4; ++kb) mx = fmaxf(mx, fmaxf(fmaxf(s[kb][0], s[kb][1]), fmaxf(s[kb][2], s[kb][3])));
                        mx = fmaxf(mx, __shfl_xor(mx, 16)); mx = fmaxf(mx, __shfl_xor(mx, 32));
                        const float mn = fmaxf(mi[qf], mx), al = fexp2(mi[qf] - mn); mi[qf] = mn;
                        float ps = 0.f;
#pragma unroll
                        for (int kb = 0; kb < 4; ++kb)
#pragma unroll
                            for (int j = 0; j < 4; ++j) { const float pv = fexp2(s[kb][j] - mn); s[kb][j] = pv; ps += pv; }
                        li[qf] = li[qf] * al + ps;
#pragma unroll
                        for (int nb = 0; nb < 4; ++nb) Oacc[qf][nb] = Oacc[qf][nb] * al;
                        Pf[qf][0] = pack8(s[0], s[1]); Pf[qf][1] = pack8(s[2], s[3]);
                    }
                }
#pragma unroll
                for (int nb = 0; nb < 4; ++nb)
#pragma unroll
                    for (int c = 0; c < 2; ++c) {
                        const u32x2 lo = *(const LAS u32x2*)(vb_ + (16 * nb + fr) * 272 + (32 * c + 4 * fq) * 2), hi = *(const LAS u32x2*)(vb_ + (16 * nb + fr) * 272 + (32 * c + 16 + 4 * fq) * 2);
                        const bf16x8 Vf = mk8(lo, hi);
#pragma unroll
                        for (int qf = 0; qf < 2; ++qf) Oacc[qf][nb] = MFMA16(Vf, Pf[qf][c], Oacc[qf][nb]);
                    }
            }
            if (pf) { LAS unsigned char* nb_ = lds + ((t + 1) & 1) * BUF;
#pragma unroll
                for (int i = 0; i < 3; ++i) *(LAS u32x4*)(nb_ + kdst[i]) = rk[i];
#pragma unroll
                for (int i = 0; i < 2; ++i) *(LAS u32x4*)(nb_ + vdst[i]) = rv[i]; }
            __syncthreads();
        }
#pragma unroll
        for (int qf = 0; qf < 2; ++qf) { float l = li[qf]; l += __shfl_xor(l, 16); l += __shfl_xor(l, 32); const float inv = 1.0f / l; const int row = qrow0 + 16 * qf + fr;
#pragma unroll
            for (int nb = 0; nb < 4; ++nb) { const f32x4 o = Oacc[qf][nb] * inv; u32x2 w; w.x = pk(o[0], o[1]); w.y = pk(o[2], o[3]); *(u32x2*)(O + (size_t)row * LDP + h * 64 + 16 * nb + 4 * fq) = w; } }
    }
}

constexpr int GL_QF = 0, GL_KF = 9216, GL_QB = 18432, GL_KB = 27648, GL_KSF = 36864, GL_KSB = 46080, GL_VT = 55296, GL_RED = 73728;
constexpr int GL_W = 74752;
__device__ __forceinline__ void gla_stage_w(LAS unsigned char* lds, const float* SMp) {
    const int tid = ltid(); LAS float* w = (LAS float*)(lds + GL_W);
    for (int i = tid; i < 4096; i += 512) { w[i] = SMp[SM_WGF + i]; w[4096 + i] = SMp[SM_WGB + i]; }
    if (tid < 256) { w[8192 + tid] = SMp[SM_BGF + tid]; w[8448 + tid] = SMp[SM_BGB + tid]; }
    __syncthreads();
}
__device__ __forceinline__ float dpp_add(float x, float v, const int ctrl, const int row_mask) {
    return x; }
#define DPP_STEP(x, ctrl, rmask) x = x + __int_as_float(__builtin_amdgcn_update_dpp(0, __float_as_int(x), ctrl, rmask, 0xf, false))
__device__ __forceinline__ float wave_incl_scan(float x, int lane) {
    DPP_STEP(x, 0x111, 0xf); DPP_STEP(x, 0x112, 0xf); DPP_STEP(x, 0x114, 0xf); DPP_STEP(x, 0x118, 0xf);
    DPP_STEP(x, 0x142, 0xa); DPP_STEP(x, 0x143, 0xc);
    return x;
}
__device__ __forceinline__ float logsig(float x) { return fminf(x, 0.f) - __logf(1.0f + __expf(-fabsf(x))); }
__device__ __forceinline__ void gla_prep(LAS unsigned char* lds, const bf16_t* P, int c, int h, float* DEC, bool wdec) {
    const int tid = ltid(), wid = tid >> 6, lane = tid & 63;
    const bf16_t* prow = P + (size_t)(c * 64 + lane) * LDP;
    float zf[16], zb[16];
    { const u32x4 a = *(const u32x4*)(prow + 2592), b = *(const u32x4*)(prow + 2600), c2 = *(const u32x4*)(prow + 2608), d = *(const u32x4*)(prow + 2616);
      const unsigned wa[8] = {a.x, a.y, a.z, a.w, b.x, b.y, b.z, b.w}, wb[8] = {c2.x, c2.y, c2.z, c2.w, d.x, d.y, d.z, d.w};
#pragma unroll
      for (int i = 0; i < 8; ++i) { zf[2 * i] = bflo(wa[i]); zf[2 * i + 1] = bfhi(wa[i]); zb[2 * i] = bflo(wb[i]); zb[2 * i + 1] = bfhi(wb[i]); } }
    float qv[8], kv[8];
    { const u32x4 a = *(const u32x4*)(prow + 1056 + h * 64 + 8 * wid), b = *(const u32x4*)(prow + 1312 + h * 64 + 8 * wid);
      const unsigned wa[4] = {a.x, a.y, a.z, a.w}, wb[4] = {b.x, b.y, b.z, b.w};
#pragma unroll
      for (int i = 0; i < 4; ++i) { qv[2 * i] = bflo(wa[i]) * 0.125f; qv[2 * i + 1] = bfhi(wa[i]) * 0.125f; kv[2 * i] = bflo(wb[i]); kv[2 * i + 1] = bfhi(wb[i]); } }
    float af[8], ab[8];
    { const LAS float* wl = (const LAS float*)(lds + GL_W) + h * 64 + 8 * wid;
      const f32x4 b0 = *(const LAS f32x4*)(wl + 8192), b1 = *(const LAS f32x4*)(wl + 8196), b2 = *(const LAS f32x4*)(wl + 8448), b3 = *(const LAS f32x4*)(wl + 8452);
#pragma unroll
      for (int i = 0; i < 4; ++i) { af[i] = b0[i]; af[4 + i] = b1[i]; ab[i] = b2[i]; ab[4 + i] = b3[i]; }
#pragma unroll
      for (int r = 0; r < 16; ++r) { const f32x4 f0 = *(const LAS f32x4*)(wl + r * 256), f1 = *(const LAS f32x4*)(wl + r * 256 + 4), g0 = *(const LAS f32x4*)(wl + 4096 + r * 256), g1 = *(const LAS f32x4*)(wl + 4096 + r * 256 + 4);
#pragma unroll
          for (int i = 0; i < 4; ++i) { af[i] += zf[r] * f0[i]; af[4 + i] += zf[r] * f1[i]; ab[i] += zb[r] * g0[i]; ab[4 + i] += zb[r] * g1[i]; } } }
    float oqf[8], okf[8], oqb[8], okb[8]; float tsf = 0.f, tsb = 0.f;
#pragma unroll
    for (int dd = 0; dd < 8; ++dd) {
        const int d = 8 * wid + dd;
        const float laf = logsig(af[dd]) * 0.0625f, lab = logsig(ab[dd]) * 0.0625f;
        const float pf = wave_incl_scan(laf, lane), pb = wave_incl_scan(lab, lane);
        const float totf = __shfl(pf, 63), totb = __shfl(pb, 63);
        const float sb = totb - pb + lab;
        if (!wdec) {
            oqf[dd] = qv[dd] * __expf(pf); okf[dd] = kv[dd] * __expf(-pf);
            oqb[dd] = qv[dd] * __expf(sb); okb[dd] = kv[dd] * __expf(-sb);
        } else {
            const float ksf = kv[dd] * __expf(totf - pf), ksb = kv[dd] * __expf(totb - sb);
            *(LAS bf16_t*)(lds + GL_KSF + (d * 72 + lane) * 2) = (bf16_t)(pk(ksf, 0.f) & 0xffffu);
            *(LAS bf16_t*)(lds + GL_KSB + (d * 72 + lane) * 2) = (bf16_t)(pk(ksb, 0.f) & 0xffffu);
            tsf = (lane == dd) ? totf : tsf; tsb = (lane == dd) ? totb : tsb;
        }
    }
    if (wdec && lane < 8) { DEC[((size_t)(c * 4 + h) * 2 + 0) * 64 + 8 * wid + lane] = __expf(tsf); DEC[((size_t)(c * 4 + h) * 2 + 1) * 64 + 8 * wid + lane] = __expf(tsb); }
    if (!wdec) { u32x4 w; const int off = (lane * 72 + 8 * wid) * 2;
      w.x = pk(oqf[0], oqf[1]); w.y = pk(oqf[2], oqf[3]); w.z = pk(oqf[4], oqf[5]); w.w = pk(oqf[6], oqf[7]); *(LAS u32x4*)(lds + GL_QF + off) = w;
      w.x = pk(okf[0], okf[1]); w.y = pk(okf[2], okf[3]); w.z = pk(okf[4], okf[5]); w.w = pk(okf[6], okf[7]); *(LAS u32x4*)(lds + GL_KF + off) = w;
      w.x = pk(oqb[0], oqb[1]); w.y = pk(oqb[2], oqb[3]); w.z = pk(oqb[4], oqb[5]); w.w = pk(oqb[6], oqb[7]); *(LAS u32x4*)(lds + GL_QB + off) = w;
      w.x = pk(okb[0], okb[1]); w.y = pk(okb[2], okb[3]); w.z = pk(okb[4], okb[5]); w.w = pk(okb[6], okb[7]); *(LAS u32x4*)(lds + GL_KB + off) = w; }
    { const int tp = tid >> 4, eg = tid & 15; const bf16_t* v0 = P + (size_t)(c * 64 + 2 * tp) * LDP + 1568 + h * 128 + 8 * eg;
      const u32x4 a = *(const u32x4*)v0, b = *(const u32x4*)(v0 + LDP); const unsigned wa[4] = {a.x, a.y, a.z, a.w}, wb[4] = {b.x, b.y, b.z, b.w};
      const int pcol = (4 * ((tp >> 2) ^ (eg & 7)) + (tp & 3)) * 4;
#pragma unroll
      for (int i = 0; i < 4; ++i) { *(LAS unsigned*)(lds + GL_VT + (8 * eg + 2 * i) * 144 + pcol) = (wa[i] & 0xffffu) | (wb[i] << 16);
                                    *(LAS unsigned*)(lds + GL_VT + (8 * eg + 2 * i + 1) * 144 + pcol) = (wa[i] >> 16) | (wb[i] & 0xffff0000u); } }
    __syncthreads();
}
__device__ __forceinline__ void gla_phaseA(LAS unsigned char* lds, const float* SMp, const bf16_t* P, bf16_t* ST, float* DEC) {
    const int tid = ltid(), wid = tid >> 6, lane = tid & 63, fr = lane & 15, fq = lane >> 4;
    gla_stage_w(lds, SMp);
    for (int it = lbid(); it < 1536 * 4; it += gridDim.x) {
        const int c = it >> 2, h = it & 3;
        gla_prep(lds, P, c, h, DEC, true);
        const int dir = wid >> 2, db = wid & 3; const int KS = dir ? GL_KSB : GL_KSF;
        bf16x8 a[2];
#pragma unroll
        for (int ks = 0; ks < 2; ++ks) a[ks] = *(const LAS bf16x8*)(lds + KS + ((16 * db + fr) * 72 + 32 * ks + 8 * fq) * 2);
        bf16_t* st = ST + ((size_t)(c * 4 + h) * 2 + dir) * 8192;
#pragma unroll
        for (int eb = 0; eb < 8; ++eb) { f32x4 acc = (f32x4){0.f, 0.f, 0.f, 0.f};
#pragma unroll
            for (int ks = 0; ks < 2; ++ks) { const int r = 16 * eb + fr; const bf16x8 b = *(const LAS bf16x8*)(lds + GL_VT + r * 144 + (((4 * ks + fq) ^ ((r >> 3) & 7)) * 16)); acc = MFMA16(a[ks], b, acc); }
            u32x2 w; w.x = pk(acc[0], acc[1]); w.y = pk(acc[2], acc[3]); *(u32x2*)(st + (16 * eb + fr) * 64 + 16 * db + 4 * fq) = w; }
        __syncthreads();
    }
}
__device__ __forceinline__ void gla_scan(bf16_t* ST, const float* DEC) {
    const int total = 32 * 8192;
    for (int tix = lbid() * 512 + ltid(); tix < total; tix += gridDim.x * 512) {
        const int piece = tix & 1023, dir = (tix >> 10) & 1, h = (tix >> 11) & 3, b = tix >> 13;
        const int N = b < 16 ? 32 : 64, c0 = b < 16 ? b * 32 : 512 + (b - 16) * 64, d0 = (piece & 7) * 8;
        float S[8];
#pragma unroll
        for (int i = 0; i < 8; ++i) S[i] = 0.f;
        for (int n = 0; n < N; n += 4) {
            u32x4 raw[4]; f32x4 e0[4], e1[4]; u32x4* ptr[4];
#pragma unroll
            for (int u = 0; u < 4; ++u) { const int c = dir ? c0 + N - 1 - (n + u) : c0 + n + u; const size_t base = (size_t)(c * 4 + h) * 2 + dir;
                ptr[u] = (u32x4*)(ST + base * 8192 + piece * 8); raw[u] = *ptr[u]; e0[u] = *(const f32x4*)(DEC + base * 64 + d0); e1[u] = *(const f32x4*)(DEC + base * 64 + d0 + 4); }
#pragma unroll
            for (int u = 0; u < 4; ++u) {
                u32x4 w; w.x = pk(S[0], S[1]); w.y = pk(S[2], S[3]); w.z = pk(S[4], S[5]); w.w = pk(S[6], S[7]); *ptr[u] = w;
                S[0] = e0[u][0] * S[0] + bflo(raw[u].x); S[1] = e0[u][1] * S[1] + bfhi(raw[u].x); S[2] = e0[u][2] * S[2] + bflo(raw[u].y); S[3] = e0[u][3] * S[3] + bfhi(raw[u].y);
                S[4] = e1[u][0] * S[4] + bflo(raw[u].z); S[5] = e1[u][1] * S[5] + bfhi(raw[u].z); S[6] = e1[u][2] * S[6] + bflo(raw[u].w); S[7] = e1[u][3] * S[7] + bfhi(raw[u].w); }
        }
    }
}
__device__ __forceinline__ void gla_phaseC(LAS unsigned char* lds, const float* SMp, bf16_t* P, const bf16_t* ST) {
    const int tid = ltid(), wid = tid >> 6, lane = tid & 63, fr = lane & 15, fq = lane >> 4;
    const float* gnorm = SMp + SM_GN;
    gla_stage_w(lds, SMp);
    for (int it = lbid(); it < 1536 * 4; it += gridDim.x) {
        const int c = it >> 2, h = it & 3;
        gla_prep(lds, P, c, h, nullptr, false);
        const int tb = wid & 3, eh = wid >> 2;
        f32x4 acc[4];
#pragma unroll
        for (int i = 0; i < 4; ++i) acc[i] = (f32x4){0.f, 0.f, 0.f, 0.f};
#pragma unroll
        for (int dir = 0; dir < 2; ++dir) {
            const int Qs = dir ? GL_QB : GL_QF, Ks = dir ? GL_KB : GL_KF;
            bf16x8 qf[2];
#pragma unroll
            for (int ks = 0; ks < 2; ++ks) qf[ks] = *(const LAS bf16x8*)(lds + Qs + ((16 * tb + fr) * 72 + 32 * ks + 8 * fq) * 2);
            f32x4 as[4];
#pragma unroll
            for (int sb = 0; sb < 4; ++sb) { as[sb] = (f32x4){0.f, 0.f, 0.f, 0.f};
#pragma unroll
                for (int ks = 0; ks < 2; ++ks) { const bf16x8 kf = *(const LAS bf16x8*)(lds + Ks + ((16 * sb + fr) * 72 + 32 * ks + 8 * fq) * 2); as[sb] = MFMA16(kf, qf[ks], as[sb]); }
#pragma unroll
                for (int j = 0; j < 4; ++j) { const int si = 16 * sb + 4 * fq + j, ti = 16 * tb + fr; const bool keep = dir ? (si > ti) : (si <= ti); as[sb][j] = keep ? as[sb][j] : 0.f; } }
            bf16x8 Pf[2]; Pf[0] = pack8(as[0], as[1]); Pf[1] = pack8(as[2], as[3]);
            const bf16_t* st = ST + ((size_t)(c * 4 + h) * 2 + dir) * 8192;
#pragma unroll
            for (int i = 0; i < 4; ++i) { const int e0 = 16 * (4 * eh + i) + fr;
#pragma unroll
                for (int cc = 0; cc < 2; ++cc) { const int sw = (e0 >> 3) & 7; const u32x2 lo = *(const LAS u32x2*)(lds + GL_VT + e0 * 144 + (((4 * cc + (fq >> 1)) ^ sw) * 16) + 8 * (fq & 1)), hi = *(const LAS u32x2*)(lds + GL_VT + e0 * 144 + (((4 * cc + 2 + (fq >> 1)) ^ sw) * 16) + 8 * (fq & 1));
                    acc[i] = MFMA16(mk8(lo, hi), Pf[cc], acc[i]); }
#pragma unroll
                for (int ks = 0; ks < 2; ++ks) { const bf16x8 sf = *(const bf16x8*)(st + e0 * 64 + 32 * ks + 8 * fq); acc[i] = MFMA16(sf, qf[ks], acc[i]); } }
        }
        float ss = 0.f;
#pragma unroll
        for (int i = 0; i < 4; ++i) ss += (acc[i][0] * acc[i][0] + acc[i][1] * acc[i][1]) + (acc[i][2] * acc[i][2] + acc[i][3] * acc[i][3]);
        ss += __shfl_xor(ss, 16); ss += __shfl_xor(ss, 32);
        LAS float* red = (LAS float*)(lds + GL_RED);
        if (fq == 0) red[eh * 64 + 16 * tb + fr] = ss;
        __syncthreads();
        const float tot = red[16 * tb + fr] + red[64 + 16 * tb + fr];
        const float rs = rsqrtf(tot * (1.0f / 128.0f) + 1e-6f);
        const int row = c * 64 + 16 * tb + fr; bf16_t* prow = P + (size_t)row * LDP;
#pragma unroll
        for (int i = 0; i < 4; ++i) { const int e = 16 * (4 * eh + i) + 4 * fq; const f32x4 g = *(const f32x4*)(gnorm + e); const u32x2 rr = *(const u32x2*)(prow + 2080 + h * 128 + e);
            const float o0 = acc[i][0] * rs * g[0] * silu(bflo(rr.x)), o1 = acc[i][1] * rs * g[1] * silu(bfhi(rr.x)), o2 = acc[i][2] * rs * g[2] * silu(bflo(rr.y)), o3 = acc[i][3] * rs * g[3] * silu(bfhi(rr.y));
            u32x2 w; w.x = pk(o0, o1); w.y = pk(o2, o3); *(u32x2*)(prow + 512 + h * 128 + e) = w; }
        __syncthreads();
    }
}

__device__ __forceinline__ void sgu_phase(LAS unsigned char* lds, bf16_t* V, const f32x2* STATS, const float* lng, const float* lnb, const bf16_t* Ws, const float* bs) {
    const int tid = ltid(), wid = tid >> 6, lane = tid & 63, fr = lane & 15, fq = lane >> 4;
    LAS float* MU = (LAS float*)(lds + 104448); LAS float* RS = (LAS float*)(lds + 104960);
    for (int unit = lbid(); unit < 6144; unit += gridDim.x) {
        const int ck = unit >> 3, g = unit & 7, cbase = g * 384, row0 = ck * 128;
        const int t0 = 16 * wid;
        bf16x8 Wf[4];
#pragma unroll
        for (int ks = 0; ks < 4; ++ks) Wf[ks] = *(const bf16x8*)(Ws + (size_t)(g * 128 + t0 + fr) * 128 + 32 * ks + 8 * fq);
        const float bias = bs[g * 128 + t0 + fr];
        if (tid < 128) { const f32x4* sp = (const f32x4*)(STATS + (size_t)(row0 + tid) * 48); float s1 = 0.f, s2 = 0.f;
#pragma unroll
            for (int i = 0; i < 24; ++i) { const f32x4 v = sp[i]; s1 += v[0] + v[2]; s2 += v[1] + v[3]; }
            const float mean = s1 * (1.0f / 3072.0f), var = s2 * (1.0f / 3072.0f) - mean * mean; MU[tid] = mean; RS[tid] = rsqrtf(fmaxf(var, 0.f) + 1e-5f); }
        __syncthreads();
#pragma unroll
        for (int i = 0; i < 6; ++i) { const int id = tid + 512 * i, rest = id >> 6, cg = (rest % 6) * 8 + (id & 7), tp = (rest / 6) * 8 + ((id >> 3) & 7); const int c = cbase + 8 * cg, r0 = row0 + 2 * tp;
            const int pcol = (4 * ((tp >> 2) ^ (cg & 7)) + (tp & 3)) * 4;
            const u32x4 a = *(const u32x4*)(V + (size_t)r0 * SH + c), b = *(const u32x4*)(V + (size_t)(r0 + 1) * SH + c);
            const f32x4 g0 = *(const f32x4*)(lng + c), g1 = *(const f32x4*)(lng + c + 4), b0 = *(const f32x4*)(lnb + c), b1 = *(const f32x4*)(lnb + c + 4);
            const float mu0 = MU[2 * tp], rs0 = RS[2 * tp], mu1 = MU[2 * tp + 1], rs1 = RS[2 * tp + 1];
            const unsigned wa[4] = {a.x, a.y, a.z, a.w}, wb[4] = {b.x, b.y, b.z, b.w}; const float gg[8] = {g0[0], g0[1], g0[2], g0[3], g1[0], g1[1], g1[2], g1[3]}, bb[8] = {b0[0], b0[1], b0[2], b0[3], b1[0], b1[1], b1[2], b1[3]};
#pragma unroll
            for (int e = 0; e < 4; ++e) {
                const float x0 = (bflo(wa[e]) - mu0) * rs0 * gg[2 * e] + bb[2 * e], x1 = (bflo(wb[e]) - mu1) * rs1 * gg[2 * e] + bb[2 * e];
                const float y0 = (bfhi(wa[e]) - mu0) * rs0 * gg[2 * e + 1] + bb[2 * e + 1], y1 = (bfhi(wb[e]) - mu1) * rs1 * gg[2 * e + 1] + bb[2 * e + 1];
                *(LAS unsigned*)(lds + (8 * cg + 2 * e) * 272 + pcol) = pk(x0, x1); *(LAS unsigned*)(lds + (8 * cg + 2 * e + 1) * 272 + pcol) = pk(y0, y1); } }
        __syncthreads();
        bf16_t* orow = V + (size_t)(row0 + t0 + fr) * SH + cbase + 4 * fq;
#pragma unroll
        for (int cb = 0; cb < 24; ++cb) { f32x4 acc = (f32x4){0.f, 0.f, 0.f, 0.f};
#pragma unroll
            for (int ks = 0; ks < 4; ++ks) { const int r = 16 * cb + fr; const bf16x8 a = *(const LAS bf16x8*)(lds + r * 272 + (((4 * ks + fq) ^ ((r >> 3) & 7)) * 16)); acc = MFMA16(a, Wf[ks], acc); }
            u32x2 w; w.x = pk(acc[0] + bias, acc[1] + bias); w.y = pk(acc[2] + bias, acc[3] + bias); *(u32x2*)(orow + 16 * cb) = w; }
        __syncthreads();
    }
}

#define ON(k) (((PM) >> (k)) & 1)
enum { K_G1 = 0, K_G2, K_LN, K_G3, K_G45, K_ATT, K_GLAC, K_MIX0, K_G7, K_SGU, K_G8, K_MIX1, K_G5A, K_G5B, K_GLAA };
constexpr int NSTEPS = 20;
__device__ __forceinline__ void step_info(int st, int& kind, int& arg, bool& sync) {
    sync = true;
    switch (st) {
        case 0: kind = K_G1; arg = 0; break; case 1: kind = K_G2; arg = 0; break;
        case 2: kind = K_G3; arg = 0; break;
        case 3: kind = K_G45; arg = 0; sync = false; break; case 4: kind = K_G5A; arg = 0; sync = false; break; case 5: kind = K_G5B; arg = 0; sync = false; break; case 6: kind = K_GLAA; arg = 0; break;
        case 7: kind = K_ATT; arg = 0; break; case 8: kind = K_GLAC; arg = 0; break; case 9: kind = K_MIX0; arg = 0; break;
        case 10: kind = K_G1; arg = 1; break; case 11: kind = K_G2; arg = 1; break;
        case 12: kind = K_G1; arg = 2; break; case 13: kind = K_G2; arg = 2; break;
        case 14: kind = K_G7; arg = 0; break; case 15: kind = K_SGU; arg = 0; break; case 16: kind = K_G8; arg = 0; break; case 17: kind = K_MIX1; arg = 0; break;
        case 18: kind = K_G1; arg = 3; break; default: kind = K_G2; arg = 3; break;
    }
}

__device__ __forceinline__ void grid_barrier(unsigned* bar, unsigned target) {
    asm volatile("s_waitcnt vmcnt(0) lgkmcnt(0)" ::: "memory");
    __syncthreads();
    if (threadIdx.x == 0) {
        __builtin_amdgcn_fence(__ATOMIC_RELEASE, "agent");
        asm volatile("s_waitcnt vmcnt(0)" ::: "memory");
        __hip_atomic_fetch_add(bar, 1u, __ATOMIC_RELAXED, __HIP_MEMORY_SCOPE_AGENT);
        while (__hip_atomic_load(bar, __ATOMIC_RELAXED, __HIP_MEMORY_SCOPE_AGENT) < target) __builtin_amdgcn_s_sleep(1);
        __builtin_amdgcn_fence(__ATOMIC_ACQUIRE, "agent");
        asm volatile("s_waitcnt vmcnt(0)" ::: "memory");
    }
    __syncthreads();
}
#define GSYNC(base) do { ++nbar; grid_barrier((unsigned*)((base) + WS_BAR), nbar * gridDim.x); } while (0)
__global__ void __launch_bounds__(512, 2) mega(Params p) {
    extern __shared__ __attribute__((aligned(16))) unsigned char shm[];
    LAS unsigned char* lds = (LAS unsigned char*)shm;
    cg::grid_group grid = cg::this_grid();
    if (ON(15)) phase0(lds, p);
    unsigned nbar = 0;
    grid.sync(); __builtin_amdgcn_fence(__ATOMIC_ACQUIRE, "agent"); asm volatile("s_waitcnt vmcnt(0)" ::: "memory");
#pragma unroll 1
    for (int st = 0; st < NSTEPS; ++st) {
        size_t zoff = 0; asm volatile("" : "+s"(zoff));
        unsigned char* ws = p.ws + zoff; unsigned char* dout = (unsigned char*)p.out + zoff;
        bf16_t* XB = (bf16_t*)(ws + WS_XB); bf16_t* R = (bf16_t*)(ws + WS_R); float* PRE = (float*)dout;
        bf16_t* ST = (bf16_t*)(ws + WS_ST); float* DEC = (float*)(ws + WS_DEC); float* SSQ = (float*)(ws + WS_SSQ); f32x2* STATS = (f32x2*)(ws + WS_STATS);
        bf16_t* Qb = (bf16_t*)(dout + DO_Q); bf16_t* KN = (bf16_t*)(dout + DO_KN); bf16_t* VT = (bf16_t*)(dout + DO_VT); bf16_t* KR = (bf16_t*)(dout + DO_KR);
        const f32x2* ROPE = (const f32x2*)(ws + WS_ROPE); const float* SMp = (const float*)(ws + WS_SMALL);
        int kind, arg; bool dosync; step_info(st, kind, arg, dosync);
        switch (kind) {
            case K_G1: if (ON(K_G1)) { EpiSwiglu E; E.H = R; const int rep = ((DUP & 4) && arg == 0) ? 2 : 1; for (int rr = 0; rr < rep; ++rr) run_gemm(lds, XB, DM, (const bf16_t*)(ws + WS_FFN + (size_t)arg * 17301504), DM, MTOK, 2 * FH, DM, E); } break;
            case K_G2: case K_MIX0: case K_MIX1: if (ON(K_G2)) { EpiLn E;
                const bf16_t* Bt; int lda, K, inst; float cs;
                if (kind == K_G2) { Bt = (const bf16_t*)(ws + WS_FFN + (size_t)arg * 17301504 + 11534336); lda = FH; K = FH; cs = 0.5f; inst = arg == 0 ? 0 : arg == 1 ? 2 : arg == 2 ? 3 : 5; }
                else if (kind == K_MIX0) { Bt = (const bf16_t*)(ws + WS_WOUT); lda = LDP; K = DM; cs = 1.0f; inst = 1; }
                else { Bt = (const bf16_t*)(ws + WS_SOUT); lda = SH; K = SH; cs = 1.0f; inst = 4; }
                E.XB = XB; E.OUTF = inst == 5 ? PRE : nullptr; E.G = SMp + SM_LN + inst * 2048; E.B = E.G + 1024; E.cs = cs;
                E.SLOT = (unsigned long long*)(ws + WS_SLOT); E.CNT = (unsigned*)(ws + WS_CNT) + (size_t)inst * 384 * 2 * 16;
                run_gemm(lds, R, lda, Bt, K, MTOK, DM, K, E); } break;
            case K_G3: if (ON(K_G3)) { EpiWin E; E.P = R; E.SSQ = SSQ; run_gemm(lds, XB, DM, (const bf16_t*)(ws + WS_WIN), DM, MTOK, 2816, DM, E); } break;
            case K_G45: if (ON(K_G45)) { kr_pass(R, ROPE, KR);
                EpiQ E; E.Q = Qb; E.SSQ = SSQ; E.ROPE = ROPE; run_gemm(lds, R, LDP, (const bf16_t*)(ws + WS_UQ), 768, MTOK, 768, 768, E); } break;
            case K_G5A: if (ON(K_G5A)) { EpiKN E; E.KN = KN; E.SSQ = SSQ; run_gemm(lds, R + 768, LDP, (const bf16_t*)(ws + WS_UKN), 256, MTOK, 512, 256, E); } break;
            case K_G5B: if (ON(K_G5B)) { EpiVT E; E.VT = VT; E.SSQ = SSQ; run_gemm(lds, (const bf16_t*)(ws + WS_UV), 256, R + 768, LDP, 512, MTOK, 256, E); } break;
            case K_GLAA: if (ON(K_GLAA)) { __syncthreads(); gla_phaseA(lds, SMp, R, ST, DEC); if (DUP & 2) gla_phaseA(lds, SMp, R, ST, DEC); } break;
            case K_ATT: if (ON(K_ATT)) { attn_phase(lds, Qb, KN, KR, VT, R); if (DUP & 1) { __syncthreads(); attn_phase(lds, Qb, KN, KR, VT, R); } gla_scan(ST, DEC); } break;
            case K_GLAC: if (ON(K_GLAC)) { gla_phaseC(lds, SMp, R, ST); if (DUP & 2) gla_phaseC(lds, SMp, R, ST); } break;
            case K_G7: if (ON(K_G7)) { EpiSguV E; E.V = R; E.STATS = STATS; run_gemm(lds, XB, DM, (const bf16_t*)(ws + WS_SIN) + (size_t)SH * DM, DM, MTOK, SH, DM, E); } break;
            case K_SGU: if (ON(K_SGU)) { sgu_phase(lds, R, STATS, SMp + SM_LNG, SMp + SM_LNB, (const bf16_t*)(ws + WS_WS), SMp + SM_BS); } break;
            case K_G8: if (ON(K_G8)) { EpiSguU E; E.V = R; run_gemm(lds, XB, DM, (const bf16_t*)(ws + WS_SIN), DM, MTOK, SH, DM, E); } break;
            default: break;
        }
        if (dosync) GSYNC(ws);
    }
}

constexpr int LDS_BYTES = 131072;
extern "C" void kernel_launch(void* const* d_in, const int* in_sizes, int n_in, void* d_out, int out_size, void* d_ws, size_t ws_size, hipStream_t stream) {
    static int grid_blocks = 0;
    if (!grid_blocks) {
        int dev = 0, cus = 0, per_cu = 0;
        (void)hipGetDevice(&dev);
        (void)hipDeviceGetAttribute(&cus, hipDeviceAttributeMultiprocessorCount, dev);
        (void)hipFuncSetAttribute((const void*)mega, hipFuncAttributeMaxDynamicSharedMemorySize, LDS_BYTES);
        (void)hipOccupancyMaxActiveBlocksPerMultiprocessor(&per_cu, (const void*)mega, 512, LDS_BYTES);
        if (per_cu < 1) per_cu = 1;
        grid_blocks = cus * per_cu;
        if (grid_blocks > 256) grid_blocks = 256;
    }
    Params p{};
    for (int i = 0; i < 39; ++i) p.in[i] = (const float*)d_in[i];
    p.out = (float*)d_out; p.ws = (unsigned char*)d_ws;
    void* args[] = {&p};
    hipError_t e = hipLaunchCooperativeKernel((const void*)mega, dim3(grid_blocks), dim3(512), args, LDS_BYTES, stream);
    if (e != hipSuccess) fprintf(stderr, "cooperative launch failed: %s (grid %d)\n", hipGetErrorString(e), grid_blocks);
}
```

```cpp
#include <hip/hip_runtime.h>
#include <hip/hip_cooperative_groups.h>
#include <cstdio>
namespace cg = cooperative_groups;

#define LAS __attribute__((address_space(3)))
typedef unsigned short bf16_t;
typedef short bf16x8 __attribute__((ext_vector_type(8)));
typedef float f32x4 __attribute__((ext_vector_type(4)));
typedef float f32x2 __attribute__((ext_vector_type(2)));
typedef unsigned u32x4 __attribute__((ext_vector_type(4)));
typedef unsigned u32x2 __attribute__((ext_vector_type(2)));

#ifndef PM
#define PM 0xFFFF
#endif
#ifndef DUP
#define DUP 0
#endif
constexpr int MTOK = 98304, NPROMPT = 32768, DM = 1024, FH = 2816, LDP = 2624, SH = 3072;
constexpr size_t MiB = 1048576;
constexpr size_t WS_FFN = 0;
constexpr size_t WS_WIN = 66 * MiB;
constexpr size_t WS_UQ = WS_WIN + 5767168;
constexpr size_t WS_UKN = WS_UQ + 1179648;
constexpr size_t WS_UV = WS_UKN + 262144;
constexpr size_t WS_WOUT = WS_UV + 262144;
constexpr size_t WS_SIN = WS_WOUT + 2097152;
constexpr size_t WS_SOUT = WS_SIN + 12582912;
constexpr size_t WS_WS = WS_SOUT + 6291456;
constexpr size_t WS_ROPE = WS_WS + 262144;
constexpr size_t WS_SMALL = WS_ROPE + 524288;
constexpr int SM_LN = 0, SM_WGF = 12288, SM_BGF = 16384, SM_WGB = 16640, SM_BGB = 20736, SM_GN = 20992, SM_LNG = 21120, SM_LNB = 24192, SM_BS = 27264;
constexpr size_t WS_XB = 96 * MiB;
constexpr size_t WS_R = 288 * MiB;
constexpr size_t WS_ST = 780 * MiB;
constexpr size_t WS_DEC = 972 * MiB;
constexpr size_t WS_SSQ = 976 * MiB;
constexpr size_t WS_STATS = 864 * MiB;
constexpr size_t WS_BAR = 983 * MiB;
constexpr size_t WS_CNT = WS_BAR + 4096;
constexpr size_t BAR_ZERO_BYTES = 4096 + 6 * 384 * 2 * 64;
constexpr size_t WS_SLOT = 984 * MiB;
constexpr size_t DO_Q = 0, DO_KN = 144 * MiB, DO_VT = 240 * MiB, DO_KR = 336 * MiB;

struct Params { const float* in[39]; float* out; unsigned char* ws; };

__device__ __forceinline__ int ltid() { int t = threadIdx.x; asm volatile("" : "+v"(t)); return t; }
__device__ __forceinline__ int lbid() { int t = blockIdx.x; asm volatile("" : "+s"(t)); return t; }
__device__ __forceinline__ float bflo(unsigned w) { return __uint_as_float(w << 16); }
__device__ __forceinline__ float bfhi(unsigned w) { return __uint_as_float(w & 0xffff0000u); }
typedef __bf16 bf16v2 __attribute__((ext_vector_type(2)));
__device__ __forceinline__ unsigned pk(float lo, float hi) { const f32x2 v = {lo, hi}; const bf16v2 b = __builtin_convertvector(v, bf16v2); return __builtin_bit_cast(unsigned, b); }
__device__ __forceinline__ float fexp2(float x) { return __builtin_amdgcn_exp2f(x); }
__device__ __forceinline__ float frcp(float x) { return __builtin_amdgcn_rcpf(x); }
__device__ __forceinline__ float silu(float x) { return x * frcp(1.0f + fexp2(-1.4426950408889634f * x)); }
__device__ __forceinline__ f32x2 gelu_pk(f32x2 v) {
    const f32x2 av = __builtin_elementwise_abs(v), d = av * 0.2316418882f + 1.0f;
    f32x2 t; t.x = frcp(d.x); t.y = frcp(d.y);
    f32x2 q = t * 0.5307027145f + (-0.7265760135f); q = q * t + 0.7107068705f; q = q * t + (-0.142248368f); q = q * t + 0.127414796f; q = q * t;
    const f32x2 s = (v * v) * (-0.72134752044f);
    f32x2 e; e.x = fexp2(s.x); e.y = fexp2(s.y);
    const f32x2 m = v * (q * e), r = v - m;
    f32x2 o; o.x = v.x < 0.f ? m.x : r.x; o.y = v.y < 0.f ? m.y : r.y; return o;
}
__device__ __forceinline__ f32x4 gelu4(f32x4 v) { f32x2 a = gelu_pk((f32x2){v[0], v[1]}), b = gelu_pk((f32x2){v[2], v[3]}); return (f32x4){a.x, a.y, b.x, b.y}; }
__device__ __forceinline__ int tok_pos(int row) { return row < NPROMPT ? (row & 2047) : (row & 4095); }

namespace pg8 {
constexpr int BM = 256, BK = 64, HALF = 128, HTB = HALF * BK * 2, STAGE_BYTES = 8 * HTB, NXCD = 8, WGM = 8;
__device__ __forceinline__ int lds_byte(int r, int c) { const int st = (r >> 4) * 2 + (c >> 5), rr = r & 15, cc = c & 31, ob = rr * 64 + cc * 2; return st * 1024 + (ob ^ (((ob >> 9) & 1) << 5)); }
__device__ __forceinline__ void stage_rc(int b, int& R, int& C) { const int st = b / 1024, sb = b % 1024, swz = sb ^ (((sb >> 9) & 1) << 5); R = (st >> 1) * 16 + swz / 64; C = (st & 1) * 32 + (swz % 64) / 2; }
__device__ __forceinline__ int perm32(int rho) { const int n = rho >> 4, i = rho & 15; return 8 * (i >> 2) + 4 * n + (i & 3); }
struct Unit { int pm, pn; };
struct Gemm { const bf16_t* A; const bf16_t* Bt; int lda, ldb, M, N, K; };
struct StaticOrder {
    int nM, nN, nwg, G, c;
    __device__ void init(int M, int N, int G_, int c_) { nM = M / BM; nN = N / BM; nwg = nM * nN; G = G_; c = c_; }
    __device__ bool next(int i, Unit& u) const {
        const long L = (long)i * G + c; if (L >= nwg) return false;
        int wgid = (int)L; { const int q = nwg / NXCD, r = nwg % NXCD, xcd = wgid % NXCD, off = wgid / NXCD; wgid = (xcd < r ? xcd * (q + 1) : r * (q + 1) + (xcd - r) * q) + off; }
        const int nig = WGM * nN, gid = wgid / nig, fm = gid * WGM, gsz = (nM - fm) < WGM ? (nM - fm) : WGM;
        u.pm = fm + ((wgid % nig) % gsz); u.pn = (wgid % nig) / gsz; return true;
    }
};
template <class Epi>
__device__ __forceinline__ void gemm_phase(LAS unsigned char* lds, const Gemm g, const StaticOrder& S, const Epi& E) {
    const int tid = ltid(), wid = __builtin_amdgcn_readfirstlane(tid >> 6), lane = tid & 63, wr = wid >> 2, wc = wid & 3, fr = lane & 15, fq = lane >> 4;
    int K = g.K, lda = g.lda, ldb = g.ldb; asm volatile("" : "+s"(K), "+s"(lda), "+s"(ldb));
    const int nt = K / BK;
    unsigned voffA[2], voffB[2];
#pragma unroll
    for (int i = 0; i < 2; ++i) { int R, C; stage_rc(tid * 16 + i * 8192, R, C); const int Rb = Epi::PERM ? ((R & ~31) + perm32(R & 31)) : R;
        voffA[i] = (unsigned)(R * lda + C) * 2u; voffB[i] = (unsigned)(Rb * ldb + C) * 2u; }
    const size_t kstep = (size_t)(BK * 2);
    const size_t hstepA = (size_t)HALF * lda * 2, hstepB = (size_t)HALF * ldb * 2;
    const size_t tstepA = 2 * hstepA, tstepB = 2 * hstepB;
    const unsigned ldsw = (unsigned)wid * 1024u;
    const int aoff = lds_byte(wr * 64 + fr, fq * 8), boff = lds_byte(wc * 32 + fr, fq * 8);
#define PG8_SA(b, h) (((b) * 2 + (h)) * HTB)
#define PG8_SB(b, h) ((4 + (b) * 2 + (h)) * HTB)
#define PG8_STAGE(bufoff, gbase, voff) do { _Pragma("unroll") for (int _i = 0; _i < 2; ++_i) \
        __builtin_amdgcn_global_load_lds((const unsigned*)((const char*)(gbase) + (voff)[_i]), (LAS unsigned*)(lds + (bufoff) + ldsw + _i * 8192), 16, 0, 0); } while (0)
#define PG8_LDA(dst, b, h) do { _Pragma("unroll") for (int m = 0; m < 4; ++m) _Pragma("unroll") for (int k = 0; k < 2; ++k) dst[m][k] = *(const LAS bf16x8*)(lds + PG8_SA(b, h) + aoff + m * 2048 + k * 1024); } while (0)
#define PG8_LDB(dst, b, h) do { _Pragma("unroll") for (int n = 0; n < 2; ++n) _Pragma("unroll") for (int k = 0; k < 2; ++k) dst[n][k] = *(const LAS bf16x8*)(lds + PG8_SB(b, h) + boff + n * 2048 + k * 1024); } while (0)
#define PG8_MMA(ai, bj, At, Bt) do { __builtin_amdgcn_s_setprio(1); _Pragma("unroll") for (int m = 0; m < 4; ++m) _Pragma("unroll") for (int n = 0; n < 2; ++n) _Pragma("unroll") for (int k = 0; k < 2; ++k) \
        acc[ai][bj][m][n] = __builtin_amdgcn_mfma_f32_16x16x32_bf16(Bt[n][k], At[m][k], acc[ai][bj][m][n], 0, 0, 0); __builtin_amdgcn_s_setprio(0); } while (0)
#define PG8_WAIT_V(n) asm volatile("s_waitcnt vmcnt(" #n ")" ::: "memory")
#define PG8_WAIT_L(n) asm volatile("s_waitcnt lgkmcnt(" #n ")" ::: "memory")
#define PG8_BAR __builtin_amdgcn_s_barrier()
#define PG8_SCHED __builtin_amdgcn_sched_barrier(0)
    Unit cur, nxt; int ui = 0;
    if (!S.next(0, cur)) return;
    f32x4 acc[2][2][4][2];
#pragma unroll
    for (int a = 0; a < 2; ++a)
#pragma unroll
        for (int b = 0; b < 2; ++b)
#pragma unroll
            for (int m = 0; m < 4; ++m)
#pragma unroll
                for (int n = 0; n < 2; ++n) acc[a][b][m][n] = (f32x4){0.f, 0.f, 0.f, 0.f};
    bf16x8 At[4][2], B0[2][2], B1[2][2];
    const char* cA = (const char*)g.A + (size_t)cur.pm * tstepA; const char* cB = (const char*)g.Bt + (size_t)cur.pn * tstepB;
    PG8_STAGE(PG8_SB(0, 0), cB, voffB); PG8_STAGE(PG8_SA(0, 0), cA, voffA); PG8_STAGE(PG8_SB(0, 1), cB + hstepB, voffB); PG8_STAGE(PG8_SA(0, 1), cA + hstepA, voffA);
    if (wr == 1) PG8_BAR;
    PG8_WAIT_V(4); PG8_BAR;
    PG8_STAGE(PG8_SB(1, 0), cB + kstep, voffB); PG8_STAGE(PG8_SA(1, 0), cA + kstep, voffA); PG8_STAGE(PG8_SB(1, 1), cB + hstepB + kstep, voffB);
    PG8_WAIT_V(6); PG8_BAR;
    for (;;) {
        const bool has_next = S.next(ui + 1, nxt);
        const char* nA = has_next ? (const char*)g.A + (size_t)nxt.pm * tstepA : cA; const char* nB = has_next ? (const char*)g.Bt + (size_t)nxt.pn * tstepB : cB;
        for (int t = 0; t < nt; t += 2) {
            const bool last = (t == nt - 2);
            const char* a1 = cA + (size_t)(t + 1) * kstep;
            const char* a2 = last ? nA : cA + (size_t)(t + 2) * kstep; const char* b2 = last ? nB : cB + (size_t)(t + 2) * kstep;
            const char* a3 = a2 + kstep; const char* b3 = b2 + kstep;
            PG8_LDB(B0, 0, 0); PG8_SCHED; PG8_LDA(At, 0, 0); PG8_STAGE(PG8_SA(1, 1), a1 + hstepA, voffA);
            PG8_WAIT_L(8); PG8_BAR; PG8_WAIT_L(0); PG8_MMA(0, 0, At, B0); PG8_BAR; PG8_SCHED;
            PG8_LDB(B1, 0, 1); PG8_STAGE(PG8_SB(0, 0), b2, voffB);
            PG8_BAR; PG8_WAIT_L(0); PG8_MMA(0, 1, At, B1); PG8_BAR;
            PG8_LDA(At, 0, 1); PG8_STAGE(PG8_SA(0, 0), a2, voffA);
            PG8_BAR; PG8_WAIT_L(0); PG8_MMA(1, 0, At, B0); PG8_BAR; PG8_SCHED;
            PG8_STAGE(PG8_SB(0, 1), b2 + hstepB, voffB);
            PG8_WAIT_V(6); PG8_BAR; PG8_MMA(1, 1, At, B1); PG8_BAR;
            PG8_LDB(B0, 1, 0); PG8_SCHED; PG8_LDA(At, 1, 0); PG8_STAGE(PG8_SA(0, 1), a2 + hstepA, voffA);
            PG8_WAIT_L(8); PG8_BAR; PG8_WAIT_L(0); PG8_MMA(0, 0, At, B0); PG8_BAR; PG8_SCHED;
            PG8_LDB(B1, 1, 1); PG8_STAGE(PG8_SB(1, 0), b3, voffB);
            PG8_BAR; PG8_WAIT_L(0); PG8_MMA(0, 1, At, B1); PG8_BAR;
            PG8_LDA(At, 1, 1); PG8_STAGE(PG8_SA(1, 0), a3, voffA);
            PG8_BAR; PG8_WAIT_L(0); PG8_MMA(1, 0, At, B0); PG8_BAR; PG8_SCHED;
            PG8_STAGE(PG8_SB(1, 1), b3 + hstepB, voffB);
            PG8_WAIT_V(6); PG8_BAR; PG8_MMA(1, 1, At, B1); PG8_BAR;
        }
        E(acc, cur, wr, wc, fr, fq);
        if (!has_next) break;
#pragma unroll
        for (int a = 0; a < 2; ++a)
#pragma unroll
            for (int b = 0; b < 2; ++b)
#pragma unroll
                for (int m = 0; m < 4; ++m)
#pragma unroll
                    for (int n = 0; n < 2; ++n) acc[a][b][m][n] = (f32x4){0.f, 0.f, 0.f, 0.f};
        cur = nxt; cA = nA; cB = nB; ++ui;
    }
    PG8_WAIT_V(0);
    if (wr == 0) PG8_BAR;
    PG8_BAR;
#undef PG8_SA
#undef PG8_SB
#undef PG8_STAGE
#undef PG8_LDA
#undef PG8_LDB
#undef PG8_MMA
#undef PG8_WAIT_V
#undef PG8_WAIT_L
#undef PG8_BAR
#undef PG8_SCHED
}
}
using pg8::Unit;
typedef f32x4 AccT[2][2][4][2];

struct EpiSwiglu {
    static constexpr bool PERM = true; bf16_t* H;
    __device__ __forceinline__ void operator()(const AccT& acc, const Unit& u, int wr, int wc, int fr, int fq) const {
        const int row0 = u.pm * 256 + wr * 64 + fr, col0 = u.pn * 128 + wc * 32 + 8 * fq;
#pragma unroll
        for (int ai = 0; ai < 2; ++ai)
#pragma unroll
            for (int m = 0; m < 4; ++m) { const f32x4 g0 = acc[ai][0][m][0], g1 = acc[ai][0][m][1], u0 = acc[ai][1][m][0], u1 = acc[ai][1][m][1];
                u32x4 w; w.x = pk(silu(g0[0]) * u0[0], silu(g0[1]) * u0[1]); w.y = pk(silu(g0[2]) * u0[2], silu(g0[3]) * u0[3]);
                w.z = pk(silu(g1[0]) * u1[0], silu(g1[1]) * u1[1]); w.w = pk(silu(g1[2]) * u1[2], silu(g1[3]) * u1[3]);
                *(u32x4*)(H + (size_t)(row0 + ai * 128 + m * 16) * FH + col0) = w; }
    }
};
struct EpiPre {
    static constexpr bool PERM = false; const bf16_t* XB; float* PRE; float cs;
    __device__ __forceinline__ void operator()(const AccT& acc, const Unit& u, int wr, int wc, int fr, int fq) const {
        const int row0 = u.pm * 256 + wr * 64 + fr, col0 = u.pn * 256 + wc * 32 + 4 * fq;
#pragma unroll
        for (int ai = 0; ai < 2; ++ai)
#pragma unroll
            for (int m = 0; m < 4; ++m) { const size_t ro = (size_t)(row0 + ai * 128 + m * 16) * DM + col0;
#pragma unroll
                for (int bj = 0; bj < 2; ++bj)
#pragma unroll
                    for (int n = 0; n < 2; ++n) { const u32x2 xw = *(const u32x2*)(XB + ro + bj * 128 + n * 16); const f32x4 a = acc[ai][bj][m][n];
                        f32x4 o; o[0] = 1.41421356237f * bflo(xw.x) + cs * a[0]; o[1] = 1.41421356237f * bfhi(xw.x) + cs * a[1]; o[2] = 1.41421356237f * bflo(xw.y) + cs * a[2]; o[3] = 1.41421356237f * bfhi(xw.y) + cs * a[3];
                        *(f32x4*)(PRE + ro + bj * 128 + n * 16) = o; } }
    }
};
struct EpiLn {
    static constexpr bool PERM = true; bf16_t* XB; float* OUTF; const float* G; const float* B; float cs; unsigned long long* SLOT; unsigned* CNT;
    __device__ __forceinline__ void operator()(AccT& acc, const Unit& u, int wr, int wc, int fr, int fq) const {
        const int row0 = u.pm * 256 + wr * 64 + fr, col0 = u.pn * 256 + wc * 32 + 8 * fq; const float AL = 1.41421356237f;
#pragma unroll
        for (int ai = 0; ai < 2; ++ai) {
            u32x4 xw[4][2];
#pragma unroll
            for (int m = 0; m < 4; ++m)
#pragma unroll
                for (int bj = 0; bj < 2; ++bj) xw[m][bj] = *(const u32x4*)(XB + (size_t)(row0 + ai * 128 + m * 16) * DM + col0 + bj * 128);
#pragma unroll
            for (int m = 0; m < 4; ++m) { const int row = row0 + ai * 128 + m * 16; float s1 = 0.f, s2 = 0.f;
#pragma unroll
                for (int bj = 0; bj < 2; ++bj) { const u32x4 x = xw[m][bj]; const f32x4 a0 = acc[ai][bj][m][0], a1 = acc[ai][bj][m][1]; f32x4 v0, v1;
                    v0[0] = AL * bflo(x.x) + cs * a0[0]; v0[1] = AL * bfhi(x.x) + cs * a0[1]; v0[2] = AL * bflo(x.y) + cs * a0[2]; v0[3] = AL * bfhi(x.y) + cs * a0[3];
                    v1[0] = AL * bflo(x.z) + cs * a1[0]; v1[1] = AL * bfhi(x.z) + cs * a1[1]; v1[2] = AL * bflo(x.w) + cs * a1[2]; v1[3] = AL * bfhi(x.w) + cs * a1[3];
                    acc[ai][bj][m][0] = v0; acc[ai][bj][m][1] = v1;
                    s1 += ((v0[0] + v0[1]) + (v0[2] + v0[3])) + ((v1[0] + v1[1]) + (v1[2] + v1[3]));
                    s2 += (v0[0] * v0[0] + v0[1] * v0[1]) + (v0[2] * v0[2] + v0[3] * v0[3]) + (v1[0] * v1[0] + v1[1] * v1[1]) + (v1[2] * v1[2] + v1[3] * v1[3]); }
                s1 += __shfl_xor(s1, 16); s1 += __shfl_xor(s1, 32); s2 += __shfl_xor(s2, 16); s2 += __shfl_xor(s2, 32);
                if (fq == 0) __hip_atomic_store(SLOT + (size_t)row * 16 + u.pn * 4 + wc, ((unsigned long long)__float_as_uint(s2) << 32) | (unsigned long long)__float_as_uint(s1), __ATOMIC_RELAXED, __HIP_MEMORY_SCOPE_AGENT); }
            asm volatile("" ::: "memory");
        }
        asm volatile("s_waitcnt vmcnt(0)" ::: "memory");
        unsigned* cnt = CNT + ((size_t)u.pm * 2 + wr) * 16;
        if ((fr | fq) == 0) __hip_atomic_fetch_add(cnt, 1u, __ATOMIC_RELAXED, __HIP_MEMORY_SCOPE_AGENT);
        while ((unsigned)__builtin_amdgcn_readfirstlane((int)__hip_atomic_load(cnt, __ATOMIC_RELAXED, __HIP_MEMORY_SCOPE_AGENT)) < 16u) __builtin_amdgcn_s_sleep(1);
        __builtin_amdgcn_fence(__ATOMIC_ACQUIRE, "workgroup"); asm volatile("" ::: "memory");
        f32x4 gv[2][2], bv[2][2];
#pragma unroll
        for (int bt = 0; bt < 3; ++bt) { const int rb = bt * 3, nr = bt == 2 ? 2 : 3;
            unsigned long long sw[3][4];
#pragma unroll
            for (int k = 0; k < 3; ++k) if (k < nr) { const int r8 = rb + k; const unsigned long long* sp = SLOT + (size_t)(row0 + (r8 >> 2) * 128 + (r8 & 3) * 16) * 16 + 4 * fq;
#pragma unroll
                for (int i = 0; i < 4; ++i) sw[k][i] = __hip_atomic_load(sp + i, __ATOMIC_RELAXED, __HIP_MEMORY_SCOPE_AGENT); }
            if (bt == 0) {
#pragma unroll
                for (int bj = 0; bj < 2; ++bj)
#pragma unroll
                    for (int n = 0; n < 2; ++n) { gv[bj][n] = *(const f32x4*)(G + col0 + bj * 128 + 4 * n); bv[bj][n] = *(const f32x4*)(B + col0 + bj * 128 + 4 * n); } }
#pragma unroll
            for (int k = 0; k < 3; ++k) if (k < nr) { const int r8 = rb + k, ai = r8 >> 2, m = r8 & 3; const int row = row0 + ai * 128 + m * 16; float t1 = 0.f, t2 = 0.f;
#pragma unroll
                for (int i = 0; i < 4; ++i) { const unsigned long long w = sw[k][i]; t1 += __uint_as_float((unsigned)w); t2 += __uint_as_float((unsigned)(w >> 32)); }
                t1 += __shfl_xor(t1, 16); t1 += __shfl_xor(t1, 32); t2 += __shfl_xor(t2, 16); t2 += __shfl_xor(t2, 32);
                const float mean = t1 * (1.0f / 1024.0f), var = t2 * (1.0f / 1024.0f) - mean * mean, rstd = rsqrtf(fmaxf(var, 0.f) + 1e-5f);
#pragma unroll
                for (int bj = 0; bj < 2; ++bj) { const f32x4 y0 = (acc[ai][bj][m][0] - mean) * rstd * gv[bj][0] + bv[bj][0], y1 = (acc[ai][bj][m][1] - mean) * rstd * gv[bj][1] + bv[bj][1];
                    if (OUTF) { *(f32x4*)(OUTF + (size_t)row * DM + col0 + bj * 128) = y0; *(f32x4*)(OUTF + (size_t)row * DM + col0 + bj * 128 + 4) = y1; }
                    else { u32x4 w; w.x = pk(y0[0], y0[1]); w.y = pk(y0[2], y0[3]); w.z = pk(y1[0], y1[1]); w.w = pk(y1[2], y1[3]); *(u32x4*)(XB + (size_t)row * DM + col0 + bj * 128) = w; } } }
        }
    }
};
struct EpiWin {
    static constexpr bool PERM = true; bf16_t* P; float* SSQ;
    __device__ __forceinline__ void operator()(const AccT& acc, const Unit& u, int wr, int wc, int fr, int fq) const {
        const int row0 = u.pm * 256 + wr * 64 + fr, col0 = u.pn * 256 + wc * 32 + 8 * fq;
#pragma unroll
        for (int ai = 0; ai < 2; ++ai)
#pragma unroll
            for (int m = 0; m < 4; ++m) { const int row = row0 + ai * 128 + m * 16; float s = 0.f;
#pragma unroll
                for (int bj = 0; bj < 2; ++bj) { f32x4 v0 = acc[ai][bj][m][0], v1 = acc[ai][bj][m][1]; const int c = col0 + bj * 128;
                    s += (v0[0] * v0[0] + v0[1] * v0[1]) + (v0[2] * v0[2] + v0[3] * v0[3]) + (v1[0] * v1[0] + v1[1] * v1[1]) + (v1[2] * v1[2] + v1[3] * v1[3]);
                    if (c < LDP) { u32x4 w; w.x = pk(v0[0], v0[1]); w.y = pk(v0[2], v0[3]); w.z = pk(v1[0], v1[1]); w.w = pk(v1[2], v1[3]); *(u32x4*)(P + (size_t)row * LDP + c) = w; } }
                if (u.pn < 4) { s += __shfl_xor(s, 16); s += __shfl_xor(s, 32); if (fq == 0) SSQ[(size_t)row * 16 + u.pn * 4 + wc] = s; } }
    }
};
struct EpiQ {
    static constexpr bool PERM = false; bf16_t* Q; const float* SSQ; const f32x2* ROPE;
    __device__ __forceinline__ void operator()(const AccT& acc, const Unit& u, int wr, int wc, int fr, int fq) const {
        const int row0 = u.pm * 256 + wr * 64 + fr; const float QS = 0.10206207261596577f * 1.4426950408889634f;
#pragma unroll
        for (int ai = 0; ai < 2; ++ai) {
            f32x4 sq[4][3];
#pragma unroll
            for (int m = 0; m < 4; ++m)
#pragma unroll
                for (int k = 0; k < 3; ++k) sq[m][k] = *(const f32x4*)(SSQ + (size_t)(row0 + ai * 128 + m * 16) * 16 + 4 * k);
#pragma unroll
            for (int m = 0; m < 4; ++m) { const int row = row0 + ai * 128 + m * 16;
                const f32x4 s0 = sq[m][0], s1 = sq[m][1], s2 = sq[m][2];
                const float ss = ((s0[0] + s0[1]) + (s0[2] + s0[3])) + ((s1[0] + s1[1]) + (s1[2] + s1[3])) + ((s2[0] + s2[1]) + (s2[2] + s2[3]));
                const float rs = rsqrtf(ss * (1.0f / 768.0f) + 1e-6f) * QS; const int pos = tok_pos(row);
#pragma unroll
                for (int bj = 0; bj < 2; ++bj) { const int cg = u.pn * 256 + bj * 128 + wc * 32; f32x4 a0 = acc[ai][bj][m][0] * rs, a1 = acc[ai][bj][m][1] * rs;
                    if ((cg % 96) == 64) { const f32x4 t0 = *(const f32x4*)(ROPE + (size_t)pos * 16 + 4 * fq), t1 = *(const f32x4*)(ROPE + (size_t)pos * 16 + 4 * fq + 2);
                        const float cs[4] = {t0[0], t0[2], t1[0], t1[2]}, sn[4] = {t0[1], t0[3], t1[1], t1[3]}; f32x4 o0, o1;
#pragma unroll
                        for (int j = 0; j < 4; ++j) { o0[j] = a0[j] * cs[j] - a1[j] * sn[j]; o1[j] = a0[j] * sn[j] + a1[j] * cs[j]; }
                        a0 = o0; a1 = o1; }
                    u32x2 w0, w1; w0.x = pk(a0[0], a0[1]); w0.y = pk(a0[2], a0[3]); w1.x = pk(a1[0], a1[1]); w1.y = pk(a1[2], a1[3]);
                    *(u32x2*)(Q + (size_t)row * 768 + cg + 4 * fq) = w0; *(u32x2*)(Q + (size_t)row * 768 + cg + 16 + 4 * fq) = w1; }
                asm volatile("" ::: "memory"); }
        }
    }
};
struct EpiKN {
    static constexpr bool PERM = true; bf16_t* KN; const float* SSQ;
    __device__ __forceinline__ void operator()(const AccT& acc, const Unit& u, int wr, int wc, int fr, int fq) const {
        const int row0 = u.pm * 256 + wr * 64 + fr, col0 = u.pn * 256 + wc * 32 + 8 * fq;
        f32x4 s3[2][4];
#pragma unroll
        for (int ai = 0; ai < 2; ++ai)
#pragma unroll
            for (int m = 0; m < 4; ++m) s3[ai][m] = *(const f32x4*)(SSQ + (size_t)(row0 + ai * 128 + m * 16) * 16 + 12);
#pragma unroll
        for (int ai = 0; ai < 2; ++ai)
#pragma unroll
            for (int m = 0; m < 4; ++m) { const int row = row0 + ai * 128 + m * 16; const f32x4 q = s3[ai][m];
                const float rs = rsqrtf(((q[0] + q[1]) + (q[2] + q[3])) * (1.0f / 256.0f) + 1e-6f);
#pragma unroll
                for (int bj = 0; bj < 2; ++bj) { const f32x4 v0 = acc[ai][bj][m][0] * rs, v1 = acc[ai][bj][m][1] * rs;
                    u32x4 w; w.x = pk(v0[0], v0[1]); w.y = pk(v0[2], v0[3]); w.z = pk(v1[0], v1[1]); w.w = pk(v1[2], v1[3]); *(u32x4*)(KN + (size_t)row * 512 + col0 + bj * 128) = w; } }
    }
};
struct EpiVT {
    static constexpr bool PERM = true; bf16_t* VT; const float* SSQ;
    __device__ __forceinline__ void operator()(const AccT& acc, const Unit& u, int wr, int wc, int fr, int fq) const {
        const int f0 = u.pm * 256 + wr * 64 + fr, tok0 = u.pn * 256 + wc * 32 + 8 * fq;
#pragma unroll
        for (int bj = 0; bj < 2; ++bj) {
            float rs[8];
#pragma unroll
            for (int i = 0; i < 8; ++i) { const f32x4 s3 = *(const f32x4*)(SSQ + (size_t)(tok0 + bj * 128 + i) * 16 + 12); rs[i] = rsqrtf(((s3[0] + s3[1]) + (s3[2] + s3[3])) * (1.0f / 256.0f) + 1e-6f); }
            asm volatile("" ::: "memory");
#pragma unroll
            for (int ai = 0; ai < 2; ++ai)
#pragma unroll
                for (int m = 0; m < 4; ++m) { const int f = f0 + ai * 128 + m * 16; const f32x4 v0 = acc[ai][bj][m][0], v1 = acc[ai][bj][m][1];
                    u32x4 w; w.x = pk(v0[0] * rs[0], v0[1] * rs[1]); w.y = pk(v0[2] * rs[2], v0[3] * rs[3]); w.z = pk(v1[0] * rs[4], v1[1] * rs[5]); w.w = pk(v1[2] * rs[6], v1[3] * rs[7]);
                    *(u32x4*)(VT + (size_t)f * MTOK + tok0 + bj * 128) = w; }
            asm volatile("" ::: "memory");
        }
    }
};
struct EpiSguV {
    static constexpr bool PERM = true; bf16_t* V; f32x2* STATS;
    __device__ __forceinline__ void operator()(const AccT& acc, const Unit& u, int wr, int wc, int fr, int fq) const {
        const int row0 = u.pm * 256 + wr * 64 + fr, col0 = u.pn * 256 + wc * 32 + 8 * fq;
#pragma unroll
        for (int ai = 0; ai < 2; ++ai)
#pragma unroll
            for (int m = 0; m < 4; ++m) { const int row = row0 + ai * 128 + m * 16; float s1 = 0.f, s2 = 0.f;
#pragma unroll
                for (int bj = 0; bj < 2; ++bj) { const f32x4 v0 = gelu4(acc[ai][bj][m][0]), v1 = gelu4(acc[ai][bj][m][1]);
                    s1 += ((v0[0] + v0[1]) + (v0[2] + v0[3])) + ((v1[0] + v1[1]) + (v1[2] + v1[3]));
                    s2 += (v0[0] * v0[0] + v0[1] * v0[1]) + (v0[2] * v0[2] + v0[3] * v0[3]) + (v1[0] * v1[0] + v1[1] * v1[1]) + (v1[2] * v1[2] + v1[3] * v1[3]);
                    u32x4 w; w.x = pk(v0[0], v0[1]); w.y = pk(v0[2], v0[3]); w.z = pk(v1[0], v1[1]); w.w = pk(v1[2], v1[3]); *(u32x4*)(V + (size_t)row * SH + col0 + bj * 128) = w; }
                s1 += __shfl_xor(s1, 16); s1 += __shfl_xor(s1, 32); s2 += __shfl_xor(s2, 16); s2 += __shfl_xor(s2, 32);
                if (fq == 0) STATS[(size_t)row * 48 + u.pn * 4 + wc] = (f32x2){s1, s2}; }
    }
};
struct EpiSguU {
    static constexpr bool PERM = true; bf16_t* V;
    __device__ __forceinline__ void operator()(const AccT& acc, const Unit& u, int wr, int wc, int fr, int fq) const {
        const int row0 = u.pm * 256 + wr * 64 + fr, col0 = u.pn * 256 + wc * 32 + 8 * fq;
#pragma unroll
        for (int ai = 0; ai < 2; ++ai) {
            u32x4 vv[4][2];
#pragma unroll
            for (int m = 0; m < 4; ++m)
#pragma unroll
                for (int bj = 0; bj < 2; ++bj) vv[m][bj] = *(const u32x4*)(V + (size_t)(row0 + ai * 128 + m * 16) * SH + col0 + bj * 128);
#pragma unroll
            for (int m = 0; m < 4; ++m) { const int row = row0 + ai * 128 + m * 16;
#pragma unroll
                for (int bj = 0; bj < 2; ++bj) { bf16_t* ptr = V + (size_t)row * SH + col0 + bj * 128; const u32x4 x = vv[m][bj];
                    const f32x4 v0 = gelu4(acc[ai][bj][m][0]), v1 = gelu4(acc[ai][bj][m][1]);
                    u32x4 w; w.x = pk(v0[0] * bflo(x.x), v0[1] * bfhi(x.x)); w.y = pk(v0[2] * bflo(x.y), v0[3] * bfhi(x.y)); w.z = pk(v1[0] * bflo(x.z), v1[1] * bfhi(x.z)); w.w = pk(v1[2] * bflo(x.w), v1[3] * bfhi(x.w));
                    *(u32x4*)ptr = w; } }
            asm volatile("" ::: "memory");
        }
    }
};

template <class Epi> __device__ __forceinline__ void run_gemm(LAS unsigned char* lds, const bf16_t* A, int lda, const bf16_t* Bt, int ldb, int M, int N, int K, const Epi& E) {
    pg8::Gemm g; g.A = A; g.Bt = Bt; g.lda = lda; g.ldb = ldb; g.M = M; g.N = N; g.K = K;
    pg8::StaticOrder S; S.init(M, N, (int)gridDim.x, lbid());
    pg8::gemm_phase<Epi>(lds, g, S, E);
}

__device__ __forceinline__ int mapcol(int mode, int nd) {
    switch (mode) {
        case 1: { const int t = nd >> 8, w = nd & 255; return (w >= 128 ? FH : 0) + t * 128 + (w & 127); }
        case 2: return nd < LDP ? nd : -1;
        case 3: return (nd >> 6) * 128 + (nd & 63);
        case 4: return (nd >> 6) * 128 + 64 + (nd & 63);
        default: return nd;
    }
}
__device__ __forceinline__ void convert_T(LAS unsigned char* lds, const float* src, int ldsrc, int K, int Ndst, bf16_t* dst, int mode, const float* kscale) {
    LAS float* tile = (LAS float*)lds;
    const int tid = ltid(), ntk = K / 64, ntn = Ndst / 256;
    for (int idx = lbid(); idx < ntk * ntn; idx += gridDim.x) {
        const int tk = idx % ntk, tn = idx / ntk;
        const int r0 = tid >> 6, c4 = (tid & 63) * 4; const int ns = mapcol(mode, tn * 256 + c4);
        f32x4 v[8];
#pragma unroll
        for (int i = 0; i < 8; ++i) { const int k = tk * 64 + r0 + 8 * i; v[i] = (f32x4){0.f, 0.f, 0.f, 0.f}; if (ns >= 0) v[i] = *(const f32x4*)(src + (size_t)k * ldsrc + ns); if (kscale) v[i] = v[i] * kscale[k]; }
#pragma unroll
        for (int i = 0; i < 8; ++i) *(LAS f32x4*)(tile + (r0 + 8 * i) * 260 + c4) = v[i];
        __syncthreads();
        const int n = tid >> 1, kh = (tid & 1) * 32;
#pragma unroll
        for (int q = 0; q < 4; ++q) { float x[8];
#pragma unroll
            for (int i = 0; i < 8; ++i) x[i] = tile[(kh + 8 * q + i) * 260 + n];
            u32x4 w; w.x = pk(x[0], x[1]); w.y = pk(x[2], x[3]); w.z = pk(x[4], x[5]); w.w = pk(x[6], x[7]);
            *(u32x4*)(dst + (size_t)(tn * 256 + n) * K + tk * 64 + kh + 8 * q) = w; }
        __syncthreads();
    }
}
#define PIN(k) (p.in[lidx(k)])
__device__ __forceinline__ int lidx(int k) { asm volatile("" : "+s"(k)); return k; }
__device__ __forceinline__ void copyf(float* dst, const float* src, size_t n, size_t gt, size_t nth) { if (gt < n) dst[gt] = src[gt]; }
__device__ __forceinline__ void phase0(LAS unsigned char* lds, const Params& p) {
    unsigned char* ws = p.ws;
    const size_t gt = (size_t)lbid() * 512 + ltid(), nth = (size_t)gridDim.x * 512;
    { bf16_t* XB = (bf16_t*)(ws + WS_XB); const size_t n4 = (size_t)MTOK * DM / 4, np4 = (size_t)NPROMPT * DM / 4; const f32x4* xp = (const f32x4*)PIN(0); const f32x4* xs = (const f32x4*)PIN(1);
      size_t i = gt;
      for (; i + 3 * nth < n4; i += 4 * nth) { f32x4 v[4];
#pragma unroll
          for (int u = 0; u < 4; ++u) { const size_t j = i + u * nth; v[u] = j < np4 ? xp[j] : xs[j - np4]; }
#pragma unroll
          for (int u = 0; u < 4; ++u) { u32x2 w; w.x = pk(v[u][0], v[u][1]); w.y = pk(v[u][2], v[u][3]); ((u32x2*)XB)[i + u * nth] = w; } }
      for (; i < n4; i += nth) { const f32x4 v = i < np4 ? xp[i] : xs[i - np4]; u32x2 w; w.x = pk(v[0], v[1]); w.y = pk(v[2], v[3]); ((u32x2*)XB)[i] = w; } }
    { unsigned* z = (unsigned*)(ws + WS_BAR); for (size_t i = gt; i < BAR_ZERO_BYTES / 4; i += nth) z[i] = 0u; }
    { bf16_t* W = (bf16_t*)(ws + WS_WS); const float* wsrc = PIN(30); for (size_t i = gt; i < 8 * 128 * 128 / 2; i += nth) { ((unsigned*)W)[i] = pk(wsrc[2 * i], wsrc[2 * i + 1]); }
      f32x2* R = (f32x2*)(ws + WS_ROPE); for (size_t i = gt; i < 4096 * 16; i += nth) { const int pos = (int)(i >> 4), j = (int)(i & 15);
          const float inv = 1.0f / powf(10000.0f, (float)(2 * j) / 32.0f); const float ang = (float)pos * inv; R[i] = (f32x2){cosf(ang), sinf(ang)}; } }
    { float* SMp = (float*)(ws + WS_SMALL);
#pragma unroll 1
      for (int k = 0; k < 6; ++k) { const int gi = k == 0 ? 4 : k == 1 ? 17 : k == 2 ? 21 : k == 3 ? 25 : k == 4 ? 33 : 37; copyf(SMp + SM_LN + k * 2048, PIN(gi), 1024, gt, nth); copyf(SMp + SM_LN + k * 2048 + 1024, PIN(gi + 1), 1024, gt, nth); }
      copyf(SMp + SM_WGF, PIN(11), 4096, gt, nth); copyf(SMp + SM_WGB, PIN(13), 4096, gt, nth); copyf(SMp + SM_BGF, PIN(12), 256, gt, nth); copyf(SMp + SM_BGB, PIN(14), 256, gt, nth);
      copyf(SMp + SM_GN, PIN(15), 128, gt, nth); copyf(SMp + SM_LNG, PIN(28), 3072, gt, nth); copyf(SMp + SM_LNB, PIN(29), 3072, gt, nth); copyf(SMp + SM_BS, PIN(31), 1024, gt, nth); }
#pragma unroll 1
    for (int f = 0; f < 4; ++f) { const int gi = f == 0 ? 2 : f == 1 ? 19 : f == 2 ? 23 : 35;
        convert_T(lds, PIN(gi), 2 * FH, DM, 2 * FH, (bf16_t*)(ws + WS_FFN + (size_t)f * 17301504), 1, nullptr);
        convert_T(lds, PIN(gi + 1), DM, FH, DM, (bf16_t*)(ws + WS_FFN + (size_t)f * 17301504 + 11534336), 0, nullptr);
    }
    convert_T(lds, PIN(6), LDP, DM, 2816, (bf16_t*)(ws + WS_WIN), 2, nullptr);
    convert_T(lds, PIN(8), 768, 768, 768, (bf16_t*)(ws + WS_UQ), 0, PIN(7));
    convert_T(lds, PIN(10), 1024, 256, 512, (bf16_t*)(ws + WS_UKN), 3, PIN(9));
    convert_T(lds, PIN(10), 1024, 256, 512, (bf16_t*)(ws + WS_UV), 4, PIN(9));
    convert_T(lds, PIN(16), DM, DM, DM, (bf16_t*)(ws + WS_WOUT), 0, nullptr);
    convert_T(lds, PIN(27), 2 * SH, DM, 2 * SH, (bf16_t*)(ws + WS_SIN), 0, nullptr);
    convert_T(lds, PIN(32), DM, SH, DM, (bf16_t*)(ws + WS_SOUT), 0, nullptr);
}

__device__ __forceinline__ void ln_phase(const float* pre, const float* g, const float* b, bf16_t* xb, float* outf) {
    const int wid = ltid() >> 6, lane = ltid() & 63;
    f32x4 gv[4], bv[4];
#pragma unroll
    for (int i = 0; i < 4; ++i) { gv[i] = *(const f32x4*)(g + 4 * lane + 256 * i); bv[i] = *(const f32x4*)(b + 4 * lane + 256 * i); }
    const int nw = gridDim.x * 8;
    for (int row = lbid() * 8 + wid; row < MTOK; row += 2 * nw) {
        const int row2 = row + nw; const bool has2 = row2 < MTOK;
        const float* pr = pre + (size_t)row * DM; const float* pr2 = pre + (size_t)(has2 ? row2 : row) * DM; f32x4 v[4], w[4]; float s = 0.f, s2 = 0.f;
#pragma unroll
        for (int i = 0; i < 4; ++i) { v[i] = *(const f32x4*)(pr + 4 * lane + 256 * i); w[i] = *(const f32x4*)(pr2 + 4 * lane + 256 * i); }
#pragma unroll
        for (int i = 0; i < 4; ++i) { s += (v[i][0] + v[i][1]) + (v[i][2] + v[i][3]); s2 += (w[i][0] + w[i][1]) + (w[i][2] + w[i][3]); }
#pragma unroll
        for (int o = 32; o >= 1; o >>= 1) { s += __shfl_xor(s, o); s2 += __shfl_xor(s2, o); }
        const float mean = s * (1.0f / 1024.0f), mean2 = s2 * (1.0f / 1024.0f); float q = 0.f, q2 = 0.f;
#pragma unroll
        for (int i = 0; i < 4; ++i) { v[i] = v[i] - mean; q += (v[i][0] * v[i][0] + v[i][1] * v[i][1]) + (v[i][2] * v[i][2] + v[i][3] * v[i][3]);
                                      w[i] = w[i] - mean2; q2 += (w[i][0] * w[i][0] + w[i][1] * w[i][1]) + (w[i][2] * w[i][2] + w[i][3] * w[i][3]); }
#pragma unroll
        for (int o = 32; o >= 1; o >>= 1) { q += __shfl_xor(q, o); q2 += __shfl_xor(q2, o); }
        const float rstd = rsqrtf(q * (1.0f / 1024.0f) + 1e-5f), rstd2 = rsqrtf(q2 * (1.0f / 1024.0f) + 1e-5f);
#pragma unroll
        for (int i = 0; i < 4; ++i) { const f32x4 y = v[i] * rstd * gv[i] + bv[i];
            if (xb) { u32x2 t; t.x = pk(y[0], y[1]); t.y = pk(y[2], y[3]); *(u32x2*)(xb + (size_t)row * DM + 4 * lane + 256 * i) = t; }
            if (outf) *(f32x4*)(outf + (size_t)row * DM + 4 * lane + 256 * i) = y; }
        if (has2) {
#pragma unroll
            for (int i = 0; i < 4; ++i) { const f32x4 y = w[i] * rstd2 * gv[i] + bv[i];
                if (xb) { u32x2 t; t.x = pk(y[0], y[1]); t.y = pk(y[2], y[3]); *(u32x2*)(xb + (size_t)row2 * DM + 4 * lane + 256 * i) = t; }
                if (outf) *(f32x4*)(outf + (size_t)row2 * DM + 4 * lane + 256 * i) = y; } }
    }
}

__device__ __forceinline__ void kr_pass(const bf16_t* P, const f32x2* ROPE, bf16_t* KR) {
    const size_t gt = (size_t)lbid() * 512 + ltid(), nth = (size_t)gridDim.x * 512;
    for (size_t i = gt; i < (size_t)MTOK * 16; i += nth) { const int row = (int)(i >> 4), j = (int)(i & 15); const int pos = tok_pos(row);
        const bf16_t* pr = P + (size_t)row * LDP + 1024; const float x1 = bflo((unsigned)pr[j]), x2 = bflo((unsigned)pr[j + 16]); const f32x2 cs = ROPE[(size_t)pos * 16 + j];
        KR[(size_t)row * 32 + j] = (bf16_t)(pk(x1 * cs.x - x2 * cs.y, 0.f) & 0xffffu); KR[(size_t)row * 32 + 16 + j] = (bf16_t)(pk(x1 * cs.y + x2 * cs.x, 0.f) & 0xffffu); }
}

#define MFMA16(a, b, c) __builtin_amdgcn_mfma_f32_16x16x32_bf16((a), (b), (c), 0, 0, 0)
__device__ __forceinline__ bf16x8 mk8(u32x2 lo, u32x2 hi) { u32x4 w; w.x = lo.x; w.y = lo.y; w.z = hi.x; w.w = hi.y; return __builtin_bit_cast(bf16x8, w); }
__device__ __forceinline__ bf16x8 pack8(f32x4 a, f32x4 b) { u32x4 w; w.x = pk(a[0], a[1]); w.y = pk(a[2], a[3]); w.z = pk(b[0], b[1]); w.w = pk(b[2], b[3]); return __builtin_bit_cast(bf16x8, w); }

__device__ __forceinline__ void attn_phase(LAS unsigned char* lds, const bf16_t* Q, const bf16_t* KN, const bf16_t* KR, const bf16_t* VT, bf16_t* O) {
    const int tid = ltid(), wid = tid >> 6, lane = tid & 63, fr = lane & 15, fq = lane >> 4;
    const int G = gridDim.x; const int L = (G % 8 == 0) ? ((lbid() & 7) * (G >> 3) + (lbid() >> 3)) : lbid();
    constexpr int KBYTES = 128 * 208, BUF = KBYTES + 64 * 272;
    for (int it = L; it < 3072; it += G) {
        int h, S, row0, qb;
        if (it < 2048) { const int pair = it >> 4; qb = it & 15; h = pair & 7; S = 4096; row0 = NPROMPT + (pair >> 3) * 4096; }
        else { const int j = it - 2048, pair = j >> 3; qb = j & 7; h = pair & 7; S = 2048; row0 = (pair >> 3) * 2048; }
        const int qrow0 = row0 + qb * 256 + wid * 32;
        bf16x8 Qf[2][3];
#pragma unroll
        for (int qf = 0; qf < 2; ++qf)
#pragma unroll
            for (int ks = 0; ks < 3; ++ks) Qf[qf][ks] = *(const bf16x8*)(Q + (size_t)(qrow0 + 16 * qf + fr) * 768 + h * 96 + 32 * ks + 8 * fq);
        f32x4 Oacc[2][4];
#pragma unroll
        for (int qf = 0; qf < 2; ++qf)
#pragma unroll
            for (int nb = 0; nb < 4; ++nb) Oacc[qf][nb] = (f32x4){0.f, 0.f, 0.f, 0.f};
        float mi[2] = {-1e30f, -1e30f}, li[2] = {0.f, 0.f};
        const int nt = S / 128;
        const bf16_t* ksrc[3]; int kstep[3], kdst[3]; const bf16_t* vsrc[2]; int vdst[2];
#pragma unroll
        for (int i = 0; i < 3; ++i) { const int pp = tid + 512 * i, key = pp / 12, part = pp % 12;
            ksrc[i] = part < 8 ? KN + (size_t)(row0 + key) * 512 + h * 64 + part * 8 : KR + (size_t)(row0 + key) * 32 + (part - 8) * 8;
            kstep[i] = part < 8 ? 128 * 512 : 128 * 32; kdst[i] = key * 208 + part * 16; }
#pragma unroll
        for (int i = 0; i < 2; ++i) { const int pp = tid + 512 * i, dv = pp >> 4, seg = pp & 15;
            vsrc[i] = VT + (size_t)(h * 64 + dv) * MTOK + row0 + seg * 8; vdst[i] = KBYTES + dv * 272 + seg * 16; }
        u32x4 rk[3], rv[2];
#pragma unroll
        for (int i = 0; i < 3; ++i) rk[i] = *(const u32x4*)ksrc[i];
#pragma unroll
        for (int i = 0; i < 2; ++i) rv[i] = *(const u32x4*)vsrc[i];
#pragma unroll
        for (int i = 0; i < 3; ++i) *(LAS u32x4*)(lds + kdst[i]) = rk[i];
#pragma unroll
        for (int i = 0; i < 2; ++i) *(LAS u32x4*)(lds + vdst[i]) = rv[i];
        __syncthreads();
        for (int t = 0; t < nt; ++t) {
            const bool pf = (t + 1 < nt);
            if (pf) {
#pragma unroll
                for (int i = 0; i < 3; ++i) rk[i] = *(const u32x4*)(ksrc[i] + (size_t)(t + 1) * kstep[i]);
#pragma unroll
                for (int i = 0; i < 2; ++i) rv[i] = *(const u32x4*)(vsrc[i] + (size_t)(t + 1) * 128);
            }
#pragma unroll 1
            for (int sub = 0; sub < 2; ++sub) {
                LAS unsigned char* kb_ = lds + (t & 1) * BUF + sub * (64 * 208); LAS unsigned char* vb_ = lds + (t & 1) * BUF + KBYTES + sub * 128;
                bf16x8 Pf[2][2];
                {
                    bf16x8 Kf[4][3];
#pragma unroll
                    for (int kb = 0; kb < 4; ++kb)
#pragma unroll
                        for (int ks = 0; ks < 3; ++ks) Kf[kb][ks] = *(const LAS bf16x8*)(kb_ + (16 * kb + fr) * 208 + (32 * ks + 8 * fq) * 2);
#pragma unroll
                    for (int qf = 0; qf < 2; ++qf) {
                        f32x4 s[4];
#pragma unroll
                        for (int kb = 0; kb < 4; ++kb) { s[kb] = (f32x4){0.f, 0.f, 0.f, 0.f};
#pragma unroll
                            for (int ks = 0; ks < 3; ++ks) s[kb] = MFMA16(Kf[kb][ks], Qf[qf][ks], s[kb]); }
                        float mx = -1e30f;
#pragma unroll
                        for (int kb = 0; kb < 4; ++kb) mx = fmaxf(mx, fmaxf(fmaxf(s[kb][0], s[kb][1]), fmaxf(s[kb][2], s[kb][3])));
                        mx = fmaxf(mx, __shfl_xor(mx, 16)); mx = fmaxf(mx, __shfl_xor(mx, 32));
                        const float mn = fmaxf(mi[qf], mx), al = fexp2(mi[qf] - mn); mi[qf] = mn;
                        float ps = 0.f;
#pragma unroll
                        for (int kb = 0; kb < 4; ++kb)
#pragma unroll
                            for (int j = 0; j < 4; ++j) { const float pv = fexp2(s[kb][j] - mn); s[kb][j] = pv; ps += pv; }
                        li[qf] = li[qf] * al + ps;
#pragma unroll
                        for (int nb = 0; nb < 4; ++nb) Oacc[qf][nb] = Oacc[qf][nb] * al;
                        Pf[qf][0] = pack8(s[0], s[1]); Pf[qf][1] = pack8(s[2], s[3]);
                    }
                }
#pragma unroll
                for (int nb = 0; nb < 4; ++nb)
#pragma unroll
                    for (int c = 0; c < 2; ++c) {
                        const u32x2 lo = *(const LAS u32x2*)(vb_ + (16 * nb + fr) * 272 + (32 * c + 4 * fq) * 2), hi = *(const LAS u32x2*)(vb_ + (16 * nb + fr) * 272 + (32 * c + 16 + 4 * fq) * 2);
                        const bf16x8 Vf = mk8(lo, hi);
#pragma unroll
                        for (int qf = 0; qf < 2; ++qf) Oacc[qf][nb] = MFMA16(Vf, Pf[qf][c], Oacc[qf][nb]);
                    }
            }
            if (pf) { LAS unsigned char* nb_ = lds + ((t + 1) & 1) * BUF;
#pragma unroll
                for (int i = 0; i < 3; ++i) *(LAS u32x4*)(nb_ + kdst[i]) = rk[i];
#pragma unroll
                for (int i = 0; i < 2; ++i) *(LAS u32x4*)(nb_ + vdst[i]) = rv[i]; }
            __syncthreads();
        }
#pragma unroll
        for (int qf = 0; qf < 2; ++qf) { float l = li[qf]; l += __shfl_xor(l, 16); l += __shfl_xor(l, 32); const float inv = 1.0f / l; const int row = qrow0 + 16 * qf + fr;
#pragma unroll
            for (int nb = 0; nb < 4; ++nb) { const f32x4 o = Oacc[qf][nb] * inv; u32x2 w; w.x = pk(o[0], o[1]); w.y = pk(o[2], o[3]); *(u32x2*)(O + (size_t)row * LDP + h * 64 + 16 * nb + 4 * fq) = w; } }
    }
}

constexpr int GL_QF = 0, GL_KF = 9216, GL_QB = 18432, GL_KB = 27648, GL_KSF = 36864, GL_KSB = 46080, GL_VT = 55296, GL_RED = 73728;
constexpr int GL_W = 74752;
__device__ __forceinline__ void gla_stage_w(LAS unsigned char* lds, const float* SMp) {
    const int tid = ltid(); LAS float* w = (LAS float*)(lds + GL_W);
    for (int i = tid; i < 4096; i += 512) { w[i] = SMp[SM_WGF + i]; w[4096 + i] = SMp[SM_WGB + i]; }
    if (tid < 256) { w[8192 + tid] = SMp[SM_BGF + tid]; w[8448 + tid] = SMp[SM_BGB + tid]; }
    __syncthreads();
}
__device__ __forceinline__ float dpp_add(float x, float v, const int ctrl, const int row_mask) {
    return x; }
#define DPP_STEP(x, ctrl, rmask) x = x + __int_as_float(__builtin_amdgcn_update_dpp(0, __float_as_int(x), ctrl, rmask, 0xf, false))
__device__ __forceinline__ float wave_incl_scan(float x, int lane) {
    DPP_STEP(x, 0x111, 0xf); DPP_STEP(x, 0x112, 0xf); DPP_STEP(x, 0x114, 0xf); DPP_STEP(x, 0x118, 0xf);
    DPP_STEP(x, 0x142, 0xa); DPP_STEP(x, 0x143, 0xc);
    return x;
}
__device__ __forceinline__ float logsig(float x) { return fminf(x, 0.f) - __logf(1.0f + __expf(-fabsf(x))); }
__device__ __forceinline__ void gla_prep(LAS unsigned char* lds, const bf16_t* P, int c, int h, float* DEC, bool wdec) {
    const int tid = ltid(), wid = tid >> 6, lane = tid & 63;
    const bf16_t* prow = P + (size_t)(c * 64 + lane) * LDP;
    float zf[16], zb[16];
    { const u32x4 a = *(const u32x4*)(prow + 2592), b = *(const u32x4*)(prow + 2600), c2 = *(const u32x4*)(prow + 2608), d = *(const u32x4*)(prow + 2616);
      const unsigned wa[8] = {a.x, a.y, a.z, a.w, b.x, b.y, b.z, b.w}, wb[8] = {c2.x, c2.y, c2.z, c2.w, d.x, d.y, d.z, d.w};
#pragma unroll
      for (int i = 0; i < 8; ++i) { zf[2 * i] = bflo(wa[i]); zf[2 * i + 1] = bfhi(wa[i]); zb[2 * i] = bflo(wb[i]); zb[2 * i + 1] = bfhi(wb[i]); } }
    float qv[8], kv[8];
    { const u32x4 a = *(const u32x4*)(prow + 1056 + h * 64 + 8 * wid), b = *(const u32x4*)(prow + 1312 + h * 64 + 8 * wid);
      const unsigned wa[4] = {a.x, a.y, a.z, a.w}, wb[4] = {b.x, b.y, b.z, b.w};
#pragma unroll
      for (int i = 0; i < 4; ++i) { qv[2 * i] = bflo(wa[i]) * 0.125f; qv[2 * i + 1] = bfhi(wa[i]) * 0.125f; kv[2 * i] = bflo(wb[i]); kv[2 * i + 1] = bfhi(wb[i]); } }
    float af[8], ab[8];
    { const LAS float* wl = (const LAS float*)(lds + GL_W) + h * 64 + 8 * wid;
      const f32x4 b0 = *(const LAS f32x4*)(wl + 8192), b1 = *(const LAS f32x4*)(wl + 8196), b2 = *(const LAS f32x4*)(wl + 8448), b3 = *(const LAS f32x4*)(wl + 8452);
#pragma unroll
      for (int i = 0; i < 4; ++i) { af[i] = b0[i]; af[4 + i] = b1[i]; ab[i] = b2[i]; ab[4 + i] = b3[i]; }
#pragma unroll
      for (int r = 0; r < 16; ++r) { const f32x4 f0 = *(const LAS f32x4*)(wl + r * 256), f1 = *(const LAS f32x4*)(wl + r * 256 + 4), g0 = *(const LAS f32x4*)(wl + 4096 + r * 256), g1 = *(const LAS f32x4*)(wl + 4096 + r * 256 + 4);
#pragma unroll
          for (int i = 0; i < 4; ++i) { af[i] += zf[r] * f0[i]; af[4 + i] += zf[r] * f1[i]; ab[i] += zb[r] * g0[i]; ab[4 + i] += zb[r] * g1[i]; } } }
    float oqf[8], okf[8], oqb[8], okb[8]; float tsf = 0.f, tsb = 0.f;
#pragma unroll
    for (int dd = 0; dd < 8; ++dd) {
        const int d = 8 * wid + dd;
        const float laf = logsig(af[dd]) * 0.0625f, lab = logsig(ab[dd]) * 0.0625f;
        const float pf = wave_incl_scan(laf, lane), pb = wave_incl_scan(lab, lane);
        const float totf = __shfl(pf, 63), totb = __shfl(pb, 63);
        const float sb = totb - pb + lab;
        if (!wdec) {
            oqf[dd] = qv[dd] * __expf(pf); okf[dd] = kv[dd] * __expf(-pf);
            oqb[dd] = qv[dd] * __expf(sb); okb[dd] = kv[dd] * __expf(-sb);
        } else {
            const float ksf = kv[dd] * __expf(totf - pf), ksb = kv[dd] * __expf(totb - sb);
            *(LAS bf16_t*)(lds + GL_KSF + (d * 72 + lane) * 2) = (bf16_t)(pk(ksf, 0.f) & 0xffffu);
            *(LAS bf16_t*)(lds + GL_KSB + (d * 72 + lane) * 2) = (bf16_t)(pk(ksb, 0.f) & 0xffffu);
            tsf = (lane == dd) ? totf : tsf; tsb = (lane == dd) ? totb : tsb;
        }
    }
    if (wdec && lane < 8) { DEC[((size_t)(c * 4 + h) * 2 + 0) * 64 + 8 * wid + lane] = __expf(tsf); DEC[((size_t)(c * 4 + h) * 2 + 1) * 64 + 8 * wid + lane] = __expf(tsb); }
    if (!wdec) { u32x4 w; const int off = (lane * 72 + 8 * wid) * 2;
      w.x = pk(oqf[0], oqf[1]); w.y = pk(oqf[2], oqf[3]); w.z = pk(oqf[4], oqf[5]); w.w = pk(oqf[6], oqf[7]); *(LAS u32x4*)(lds + GL_QF + off) = w;
      w.x = pk(okf[0], okf[1]); w.y = pk(okf[2], okf[3]); w.z = pk(okf[4], okf[5]); w.w = pk(okf[6], okf[7]); *(LAS u32x4*)(lds + GL_KF + off) = w;
      w.x = pk(oqb[0], oqb[1]); w.y = pk(oqb[2], oqb[3]); w.z = pk(oqb[4], oqb[5]); w.w = pk(oqb[6], oqb[7]); *(LAS u32x4*)(lds + GL_QB + off) = w;
      w.x = pk(okb[0], okb[1]); w.y = pk(okb[2], okb[3]); w.z = pk(okb[4], okb[5]); w.w = pk(okb[6], okb[7]); *(LAS u32x4*)(lds + GL_KB + off) = w; }
    { const int tp = tid >> 4, eg = tid & 15; const bf16_t* v0 = P + (size_t)(c * 64 + 2 * tp) * LDP + 1568 + h * 128 + 8 * eg;
      const u32x4 a = *(const u32x4*)v0, b = *(const u32x4*)(v0 + LDP); const unsigned wa[4] = {a.x, a.y, a.z, a.w}, wb[4] = {b.x, b.y, b.z, b.w};
      const int pcol = (4 * ((tp >> 2) ^ (eg & 7)) + (tp & 3)) * 4;
#pragma unroll
      for (int i = 0; i < 4; ++i) { *(LAS unsigned*)(lds + GL_VT + (8 * eg + 2 * i) * 144 + pcol) = (wa[i] & 0xffffu) | (wb[i] << 16);
                                    *(LAS unsigned*)(lds + GL_VT + (8 * eg + 2 * i + 1) * 144 + pcol) = (wa[i] >> 16) | (wb[i] & 0xffff0000u); } }
    __syncthreads();
}
__device__ __forceinline__ void gla_phaseA(LAS unsigned char* lds, const float* SMp, const bf16_t* P, bf16_t* ST, float* DEC) {
    const int tid = ltid(), wid = tid >> 6, lane = tid & 63, fr = lane & 15, fq = lane >> 4;
    gla_stage_w(lds, SMp);
    for (int it = lbid(); it < 1536 * 4; it += gridDim.x) {
        const int c = it >> 2, h = it & 3;
        gla_prep(lds, P, c, h, DEC, true);
        const int dir = wid >> 2, db = wid & 3; const int KS = dir ? GL_KSB : GL_KSF;
        bf16x8 a[2];
#pragma unroll
        for (int ks = 0; ks < 2; ++ks) a[ks] = *(const LAS bf16x8*)(lds + KS + ((16 * db + fr) * 72 + 32 * ks + 8 * fq) * 2);
        bf16_t* st = ST + ((size_t)(c * 4 + h) * 2 + dir) * 8192;
#pragma unroll
        for (int eb = 0; eb < 8; ++eb) { f32x4 acc = (f32x4){0.f, 0.f, 0.f, 0.f};
#pragma unroll
            for (int ks = 0; ks < 2; ++ks) { const int r = 16 * eb + fr; const bf16x8 b = *(const LAS bf16x8*)(lds + GL_VT + r * 144 + (((4 * ks + fq) ^ ((r >> 3) & 7)) * 16)); acc = MFMA16(a[ks], b, acc); }
            u32x2 w; w.x = pk(acc[0], acc[1]); w.y = pk(acc[2], acc[3]); *(u32x2*)(st + (16 * eb + fr) * 64 + 16 * db + 4 * fq) = w; }
        __syncthreads();
    }
}
__device__ __forceinline__ void gla_scan(bf16_t* ST, const float* DEC) {
    const int total = 32 * 8192;
    for (int tix = lbid() * 512 + ltid(); tix < total; tix += gridDim.x * 512) {
        const int piece = tix & 1023, dir = (tix >> 10) & 1, h = (tix >> 11) & 3, b = tix >> 13;
        const int N = b < 16 ? 32 : 64, c0 = b < 16 ? b * 32 : 512 + (b - 16) * 64, d0 = (piece & 7) * 8;
        float S[8];
#pragma unroll
        for (int i = 0; i < 8; ++i) S[i] = 0.f;
        for (int n = 0; n < N; n += 4) {
            u32x4 raw[4]; f32x4 e0[4], e1[4]; u32x4* ptr[4];
#pragma unroll
            for (int u = 0; u < 4; ++u) { const int c = dir ? c0 + N - 1 - (n + u) : c0 + n + u; const size_t base = (size_t)(c * 4 + h) * 2 + dir;
                ptr[u] = (u32x4*)(ST + base * 8192 + piece * 8); raw[u] = *ptr[u]; e0[u] = *(const f32x4*)(DEC + base * 64 + d0); e1[u] = *(const f32x4*)(DEC + base * 64 + d0 + 4); }
#pragma unroll
            for (int u = 0; u < 4; ++u) {
                u32x4 w; w.x = pk(S[0], S[1]); w.y = pk(S[2], S[3]); w.z = pk(S[4], S[5]); w.w = pk(S[6], S[7]); *ptr[u] = w;
                S[0] = e0[u][0] * S[0] + bflo(raw[u].x); S[1] = e0[u][1] * S[1] + bfhi(raw[u].x); S[2] = e0[u][2] * S[2] + bflo(raw[u].y); S[3] = e0[u][3] * S[3] + bfhi(raw[u].y);
                S[4] = e1[u][0] * S[4] + bflo(raw[u].z); S[5] = e1[u][1] * S[5] + bfhi(raw[u].z); S[6] = e1[u][2] * S[6] + bflo(raw[u].w); S[7] = e1[u][3] * S[7] + bfhi(raw[u].w); }
        }
    }
}
__device__ __forceinline__ void gla_phaseC(LAS unsigned char* lds, const float* SMp, bf16_t* P, const bf16_t* ST) {
    const int tid = ltid(), wid = tid >> 6, lane = tid & 63, fr = lane & 15, fq = lane >> 4;
    const float* gnorm = SMp + SM_GN;
    gla_stage_w(lds, SMp);
    for (int it = lbid(); it < 1536 * 4; it += gridDim.x) {
        const int c = it >> 2, h = it & 3;
        gla_prep(lds, P, c, h, nullptr, false);
        const int tb = wid & 3, eh = wid >> 2;
        f32x4 acc[4];
#pragma unroll
        for (int i = 0; i < 4; ++i) acc[i] = (f32x4){0.f, 0.f, 0.f, 0.f};
#pragma unroll
        for (int dir = 0; dir < 2; ++dir) {
            const int Qs = dir ? GL_QB : GL_QF, Ks = dir ? GL_KB : GL_KF;
            bf16x8 qf[2];
#pragma unroll
            for (int ks = 0; ks < 2; ++ks) qf[ks] = *(const LAS bf16x8*)(lds + Qs + ((16 * tb + fr) * 72 + 32 * ks + 8 * fq) * 2);
            f32x4 as[4];
#pragma unroll
            for (int sb = 0; sb < 4; ++sb) { as[sb] = (f32x4){0.f, 0.f, 0.f, 0.f};
#pragma unroll
                for (int ks = 0; ks < 2; ++ks) { const bf16x8 kf = *(const LAS bf16x8*)(lds + Ks + ((16 * sb + fr) * 72 + 32 * ks + 8 * fq) * 2); as[sb] = MFMA16(kf, qf[ks], as[sb]); }
#pragma unroll
                for (int j = 0; j < 4; ++j) { const int si = 16 * sb + 4 * fq + j, ti = 16 * tb + fr; const bool keep = dir ? (si > ti) : (si <= ti); as[sb][j] = keep ? as[sb][j] : 0.f; } }
            bf16x8 Pf[2]; Pf[0] = pack8(as[0], as[1]); Pf[1] = pack8(as[2], as[3]);
            const bf16_t* st = ST + ((size_t)(c * 4 + h) * 2 + dir) * 8192;
#pragma unroll
            for (int i = 0; i < 4; ++i) { const int e0 = 16 * (4 * eh + i) + fr;
#pragma unroll
                for (int cc = 0; cc < 2; ++cc) { const int sw = (e0 >> 3) & 7; const u32x2 lo = *(const LAS u32x2*)(lds + GL_VT + e0 * 144 + (((4 * cc + (fq >> 1)) ^ sw) * 16) + 8 * (fq & 1)), hi = *(const LAS u32x2*)(lds + GL_VT + e0 * 144 + (((4 * cc + 2 + (fq >> 1)) ^ sw) * 16) + 8 * (fq & 1));
                    acc[i] = MFMA16(mk8(lo, hi), Pf[cc], acc[i]); }
#pragma unroll
                for (int ks = 0; ks < 2; ++ks) { const bf16x8 sf = *(const bf16x8*)(st + e0 * 64 + 32 * ks + 8 * fq); acc[i] = MFMA16(sf, qf[ks], acc[i]); } }
        }
        float ss = 0.f;
#pragma unroll
        for (int i = 0; i < 4; ++i) ss += (acc[i][0] * acc[i][0] + acc[i][1] * acc[i][1]) + (acc[i][2] * acc[i][2] + acc[i][3] * acc[i][3]);
        ss += __shfl_xor(ss, 16); ss += __shfl_xor(ss, 32);
        LAS float* red = (LAS float*)(lds + GL_RED);
        if (fq == 0) red[eh * 64 + 16 * tb + fr] = ss;
        __syncthreads();
        const float tot = red[16 * tb + fr] + red[64 + 16 * tb + fr];
        const float rs = rsqrtf(tot * (1.0f / 128.0f) + 1e-6f);
        const int row = c * 64 + 16 * tb + fr; bf16_t* prow = P + (size_t)row * LDP;
#pragma unroll
        for (int i = 0; i < 4; ++i) { const int e = 16 * (4 * eh + i) + 4 * fq; const f32x4 g = *(const f32x4*)(gnorm + e); const u32x2 rr = *(const u32x2*)(prow + 2080 + h * 128 + e);
            const float o0 = acc[i][0] * rs * g[0] * silu(bflo(rr.x)), o1 = acc[i][1] * rs * g[1] * silu(bfhi(rr.x)), o2 = acc[i][2] * rs * g[2] * silu(bflo(rr.y)), o3 = acc[i][3] * rs * g[3] * silu(bfhi(rr.y));
            u32x2 w; w.x = pk(o0, o1); w.y = pk(o2, o3); *(u32x2*)(prow + 512 + h * 128 + e) = w; }
        __syncthreads();
    }
}

__device__ __forceinline__ void sgu_phase(LAS unsigned char* lds, bf16_t* V, const f32x2* STATS, const float* lng, const float* lnb, const bf16_t* Ws, const float* bs) {
    const int tid = ltid(), wid = tid >> 6, lane = tid & 63, fr = lane & 15, fq = lane >> 4;
    LAS float* MU = (LAS float*)(lds + 104448); LAS float* RS = (LAS float*)(lds + 104960);
    for (int unit = lbid(); unit < 6144; unit += gridDim.x) {
        const int ck = unit >> 3, g = unit & 7, cbase = g * 384, row0 = ck * 128;
        const int t0 = 16 * wid;
        bf16x8 Wf[4];
#pragma unroll
        for (int ks = 0; ks < 4; ++ks) Wf[ks] = *(const bf16x8*)(Ws + (size_t)(g * 128 + t0 + fr) * 128 + 32 * ks + 8 * fq);
        const float bias = bs[g * 128 + t0 + fr];
        if (tid < 128) { const f32x4* sp = (const f32x4*)(STATS + (size_t)(row0 + tid) * 48); float s1 = 0.f, s2 = 0.f;
#pragma unroll
            for (int i = 0; i < 24; ++i) { const f32x4 v = sp[i]; s1 += v[0] + v[2]; s2 += v[1] + v[3]; }
            const float mean = s1 * (1.0f / 3072.0f), var = s2 * (1.0f / 3072.0f) - mean * mean; MU[tid] = mean; RS[tid] = rsqrtf(fmaxf(var, 0.f) + 1e-5f); }
        __syncthreads();
#pragma unroll
        for (int i = 0; i < 6; ++i) { const int id = tid + 512 * i, rest = id >> 6, cg = (rest % 6) * 8 + (id & 7), tp = (rest / 6) * 8 + ((id >> 3) & 7); const int c = cbase + 8 * cg, r0 = row0 + 2 * tp;
            const int pcol = (4 * ((tp >> 2) ^ (cg & 7)) + (tp & 3)) * 4;
            const u32x4 a = *(const u32x4*)(V + (size_t)r0 * SH + c), b = *(const u32x4*)(V + (size_t)(r0 + 1) * SH + c);
            const f32x4 g0 = *(const f32x4*)(lng + c), g1 = *(const f32x4*)(lng + c + 4), b0 = *(const f32x4*)(lnb + c), b1 = *(const f32x4*)(lnb + c + 4);
            const float mu0 = MU[2 * tp], rs0 = RS[2 * tp], mu1 = MU[2 * tp + 1], rs1 = RS[2 * tp + 1];
            const unsigned wa[4] = {a.x, a.y, a.z, a.w}, wb[4] = {b.x, b.y, b.z, b.w}; const float gg[8] = {g0[0], g0[1], g0[2], g0[3], g1[0], g1[1], g1[2], g1[3]}, bb[8] = {b0[0], b0[1], b0[2], b0[3], b1[0], b1[1], b1[2], b1[3]};
#pragma unroll
            for (int e = 0; e < 4; ++e) {
                const float x0 = (bflo(wa[e]) - mu0) * rs0 * gg[2 * e] + bb[2 * e], x1 = (bflo(wb[e]) - mu1) * rs1 * gg[2 * e] + bb[2 * e];
                const float y0 = (bfhi(wa[e]) - mu0) * rs0 * gg[2 * e + 1] + bb[2 * e + 1], y1 = (bfhi(wb[e]) - mu1) * rs1 * gg[2 * e + 1] + bb[2 * e + 1];
                *(LAS unsigned*)(lds + (8 * cg + 2 * e) * 272 + pcol) = pk(x0, x1); *(LAS unsigned*)(lds + (8 * cg + 2 * e + 1) * 272 + pcol) = pk(y0, y1); } }
        __syncthreads();
        bf16_t* orow = V + (size_t)(row0 + t0 + fr) * SH + cbase + 4 * fq;
#pragma unroll
        for (int cb = 0; cb < 24; ++cb) { f32x4 acc = (f32x4){0.f, 0.f, 0.f, 0.f};
#pragma unroll
            for (int ks = 0; ks < 4; ++ks) { const int r = 16 * cb + fr; const bf16x8 a = *(const LAS bf16x8*)(lds + r * 272 + (((4 * ks + fq) ^ ((r >> 3) & 7)) * 16)); acc = MFMA16(a, Wf[ks], acc); }
            u32x2 w; w.x = pk(acc[0] + bias, acc[1] + bias); w.y = pk(acc[2] + bias, acc[3] + bias); *(u32x2*)(orow + 16 * cb) = w; }
        __syncthreads();
    }
}

#define ON(k) (((PM) >> (k)) & 1)
enum { K_G1 = 0, K_G2, K_LN, K_G3, K_G45, K_ATT, K_GLAC, K_MIX0, K_G7, K_SGU, K_G8, K_MIX1, K_G5A, K_G5B, K_GLAA };
constexpr int NSTEPS = 20;
__device__ __forceinline__ void step_info(int st, int& kind, int& arg, bool& sync) {
    sync = true;
    switch (st) {
        case 0: kind = K_G1; arg = 0; break; case 1: kind = K_G2; arg = 0; break;
        case 2: kind = K_G3; arg = 0; break;
        case 3: kind = K_G45; arg = 0; sync = false; break; case 4: kind = K_G5A; arg = 0; sync = false; break; case 5: kind = K_G5B; arg = 0; sync = false; break; case 6: kind = K_GLAA; arg = 0; break;
        case 7: kind = K_ATT; arg = 0; break; case 8: kind = K_GLAC; arg = 0; break; case 9: kind = K_MIX0; arg = 0; break;
        case 10: kind = K_G1; arg = 1; break; case 11: kind = K_G2; arg = 1; break;
        case 12: kind = K_G1; arg = 2; break; case 13: kind = K_G2; arg = 2; break;
        case 14: kind = K_G7; arg = 0; break; case 15: kind = K_SGU; arg = 0; break; case 16: kind = K_G8; arg = 0; break; case 17: kind = K_MIX1; arg = 0; break;
        case 18: kind = K_G1; arg = 3; break; default: kind = K_G2; arg = 3; break;
    }
}

__device__ __forceinline__ void grid_barrier(unsigned* bar, unsigned target) {
    asm volatile("s_waitcnt vmcnt(0) lgkmcnt(0)" ::: "memory");
    __syncthreads();
    if (threadIdx.x == 0) {
        __builtin_amdgcn_fence(__ATOMIC_RELEASE, "agent");
        asm volatile("s_waitcnt vmcnt(0)" ::: "memory");
        __hip_atomic_fetch_add(bar, 1u, __ATOMIC_RELAXED, __HIP_MEMORY_SCOPE_AGENT);
        while (__hip_atomic_load(bar, __ATOMIC_RELAXED, __HIP_MEMORY_SCOPE_AGENT) < target) __builtin_amdgcn_s_sleep(1);
        __builtin_amdgcn_fence(__ATOMIC_ACQUIRE, "agent");
        asm volatile("s_waitcnt vmcnt(0)" ::: "memory");
    }
    __syncthreads();
}
#define GSYNC(base) do { ++nbar; grid_barrier((unsigned*)((base) + WS_BAR), nbar * gridDim.x); } while (0)
__global__ void __launch_bounds__(512, 2) mega(Params p) {
    extern __shared__ __attribute__((aligned(16))) unsigned char shm[];
    LAS unsigned char* lds = (LAS unsigned char*)shm;
    cg::grid_group grid = cg::this_grid();
    if (ON(15)) phase0(lds, p);
    unsigned nbar = 0;
    grid.sync(); __builtin_amdgcn_fence(__ATOMIC_ACQUIRE, "agent"); asm volatile("s_waitcnt vmcnt(0)" ::: "memory");
#pragma unroll 1
    for (int st = 0; st < NSTEPS; ++st) {
        size_t zoff = 0; asm volatile("" : "+s"(zoff));
        unsigned char* ws = p.ws + zoff; unsigned char* dout = (unsigned char*)p.out + zoff;
        bf16_t* XB = (bf16_t*)(ws + WS_XB); bf16_t* R = (bf16_t*)(ws + WS_R); float* PRE = (float*)dout;
        bf16_t* ST = (bf16_t*)(ws + WS_ST); float* DEC = (float*)(ws + WS_DEC); float* SSQ = (float*)(ws + WS_SSQ); f32x2* STATS = (f32x2*)(ws + WS_STATS);
        bf16_t* Qb = (bf16_t*)(dout + DO_Q); bf16_t* KN = (bf16_t*)(dout + DO_KN); bf16_t* VT = (bf16_t*)(dout + DO_VT); bf16_t* KR = (bf16_t*)(dout + DO_KR);
        const f32x2* ROPE = (const f32x2*)(ws + WS_ROPE); const float* SMp = (const float*)(ws + WS_SMALL);
        int kind, arg; bool dosync; step_info(st, kind, arg, dosync);
        switch (kind) {
            case K_G1: if (ON(K_G1)) { EpiSwiglu E; E.H = R; const int rep = ((DUP & 4) && arg == 0) ? 2 : 1; for (int rr = 0; rr < rep; ++rr) run_gemm(lds, XB, DM, (const bf16_t*)(ws + WS_FFN + (size_t)arg * 17301504), DM, MTOK, 2 * FH, DM, E); } break;
            case K_G2: case K_MIX0: case K_MIX1: if (ON(K_G2)) { EpiLn E;
                const bf16_t* Bt; int lda, K, inst; float cs;
                if (kind == K_G2) { Bt = (const bf16_t*)(ws + WS_FFN + (size_t)arg * 17301504 + 11534336); lda = FH; K = FH; cs = 0.5f; inst = arg == 0 ? 0 : arg == 1 ? 2 : arg == 2 ? 3 : 5; }
                else if (kind == K_MIX0) { Bt = (const bf16_t*)(ws + WS_WOUT); lda = LDP; K = DM; cs = 1.0f; inst = 1; }
                else { Bt = (const bf16_t*)(ws + WS_SOUT); lda = SH; K = SH; cs = 1.0f; inst = 4; }
                E.XB = XB; E.OUTF = inst == 5 ? PRE : nullptr; E.G = SMp + SM_LN + inst * 2048; E.B = E.G + 1024; E.cs = cs;
                E.SLOT = (unsigned long long*)(ws + WS_SLOT); E.CNT = (unsigned*)(ws + WS_CNT) + (size_t)inst * 384 * 2 * 16;
                run_gemm(lds, R, lda, Bt, K, MTOK, DM, K, E); } break;
            case K_G3: if (ON(K_G3)) { EpiWin E; E.P = R; E.SSQ = SSQ; run_gemm(lds, XB, DM, (const bf16_t*)(ws + WS_WIN), DM, MTOK, 2816, DM, E); } break;
            case K_G45: if (ON(K_G45)) { kr_pass(R, ROPE, KR);
                EpiQ E; E.Q = Qb; E.SSQ = SSQ; E.ROPE = ROPE; run_gemm(lds, R, LDP, (const bf16_t*)(ws + WS_UQ), 768, MTOK, 768, 768, E); } break;
            case K_G5A: if (ON(K_G5A)) { EpiKN E; E.KN = KN; E.SSQ = SSQ; run_gemm(lds, R + 768, LDP, (const bf16_t*)(ws + WS_UKN), 256, MTOK, 512, 256, E); } break;
            case K_G5B: if (ON(K_G5B)) { EpiVT E; E.VT = VT; E.SSQ = SSQ; run_gemm(lds, (const bf16_t*)(ws + WS_UV), 256, R + 768, LDP, 512, MTOK, 256, E); } break;
            case K_GLAA: if (ON(K_GLAA)) { __syncthreads(); gla_phaseA(lds, SMp, R, ST, DEC); if (DUP & 2) gla_phaseA(lds, SMp, R, ST, DEC); } break;
            case K_ATT: if (ON(K_ATT)) { attn_phase(lds, Qb, KN, KR, VT, R); if (DUP & 1) { __syncthreads(); attn_phase(lds, Qb, KN, KR, VT, R); } gla_scan(ST, DEC); } break;
            case K_GLAC: if (ON(K_GLAC)) { gla_phaseC(lds, SMp, R, ST); if (DUP & 2) gla_phaseC(lds, SMp, R, ST); } break;
            case K_G7: if (ON(K_G7)) { EpiSguV E; E.V = R; E.STATS = STATS; run_gemm(lds, XB, DM, (const bf16_t*)(ws + WS_SIN) + (size_t)SH * DM, DM, MTOK, SH, DM, E); } break;
            case K_SGU: if (ON(K_SGU)) { sgu_phase(lds, R, STATS, SMp + SM_LNG, SMp + SM_LNB, (const bf16_t*)(ws + WS_WS), SMp + SM_BS); } break;
            case K_G8: if (ON(K_G8)) { EpiSguU E; E.V = R; run_gemm(lds, XB, DM, (const bf16_t*)(ws + WS_SIN), DM, MTOK, SH, DM, E); } break;
            default: break;
        }
        if (dosync) GSYNC(ws);
    }
}

constexpr int LDS_BYTES = 131072;
extern "C" void kernel_launch(void* const* d_in, const int* in_sizes, int n_in, void* d_out, int out_size, void* d_ws, size_t ws_size, hipStream_t stream) {
    static int grid_blocks = 0;
    if (!grid_blocks) {
        int dev = 0, cus = 0, per_cu = 0;
        (void)hipGetDevice(&dev);
        (void)hipDeviceGetAttribute(&cus, hipDeviceAttributeMultiprocessorCount, dev);
        (void)hipFuncSetAttribute((const void*)mega, hipFuncAttributeMaxDynamicSharedMemorySize, LDS_BYTES);
        (void)hipOccupancyMaxActiveBlocksPerMultiprocessor(&per_cu, (const void*)mega, 512, LDS_BYTES);
        if (per_cu < 1) per_cu = 1;
        grid_blocks = cus * per_cu;
        if (grid_blocks > 256) grid_blocks = 256;
    }
    Params p{};
    for (int i = 0; i < 39; ++i) p.in[i] = (const float*)d_in[i];
    p.out = (float*)d_out; p.ws = (unsigned char*)d_ws;
    void* args[] = {&p};
    hipError_t e = hipLaunchCooperativeKernel((const void*)mega, dim3(grid_blocks), dim3(512), args, LDS_BYTES, stream);
    if (e != hipSuccess) fprintf(stderr, "cooperative launch failed: %s (grid %d)\n", hipGetErrorString(e), grid_blocks);
}
```
